# Optimizing an MI355X kernel written in HIP

```python
import math
import jax, jax.numpy as jnp
from jax import lax
import numpy as np

D_MODEL = 1024
BATCH = 8
SEQ = 4096
DEPTH = 4

GRID_W = 64
CTX_LEN = 256
N_MIXERS = 4
N_CONV = len(range(0, DEPTH, N_MIXERS))
N_DIFF = len(range(1, DEPTH, N_MIXERS))
N_CHUNK = len(range(2, DEPTH, N_MIXERS))
N_SWA = len(range(3, DEPTH, N_MIXERS))
N_DENSE = len(range(0, DEPTH, 2))
N_MOE = len(range(1, DEPTH, 2))

HEAD_DIM = 64
ROPE_HALF = HEAD_DIM // 2
ROPE_BASE = 10000.0
Q_BLOCK = 128
DIFF_HEADS = D_MODEL // (2 * HEAD_DIM)
SWA_Q_HEADS = D_MODEL // HEAD_DIM
SWA_KV_HEADS = 4
SWA_GROUP = SWA_Q_HEADS // SWA_KV_HEADS
SWA_WINDOW = 128
CHUNK = 128
CM_WIDTH = 2 * D_MODEL
CM_GROUPS = 8
FFN_DIM = 2816
N_EXPERTS = 8
TOP_K = 2
MOE_BLOCK = 256
EPS = 1e-6

kernel_name = "hybrid_interleaved_diffusion_backbone"


def rms_norm(x, g):
    xf = x.astype(jnp.float32)
    y = xf * lax.rsqrt(jnp.mean(xf * xf, axis=-1, keepdims=True) + EPS)
    return (y * g.astype(jnp.float32)).astype(x.dtype)


def adaln(cvec, w, b):
    mod = jax.nn.silu(cvec) @ w + b
    return jnp.split(mod[..., None, :], 6, axis=-1)


def modulate(xn, shift, scale):
    return xn * (1 + scale) + shift


def axial_angles(seq_len):
    rows = seq_len // GRID_W
    row = jnp.repeat(jnp.arange(rows), GRID_W).astype(jnp.float32)
    col = jnp.tile(jnp.arange(GRID_W), rows).astype(jnp.float32)
    n_freq = ROPE_HALF // 2
    inv = ROPE_BASE ** (-jnp.arange(n_freq, dtype=jnp.float32) / n_freq)
    return row[:, None] * inv, col[:, None] * inv


def rope_1d(x, ang):
    cos = jnp.cos(ang)[None, :, None, :]
    sin = jnp.sin(ang)[None, :, None, :]
    x1, x2 = jnp.split(x.astype(jnp.float32), 2, axis=-1)
    return jnp.concatenate([x1 * cos - x2 * sin, x1 * sin + x2 * cos], axis=-1).astype(x.dtype)


def rope_2d(x, angles):
    ang_row, ang_col = angles
    return jnp.concatenate([rope_1d(x[..., :ROPE_HALF], ang_row),
                            rope_1d(x[..., ROPE_HALF:], ang_col)], axis=-1)


def short_conv_seq(a, w_in, w_conv, w_out):
    bg, cg, xv = jnp.split(a @ w_in, 3, axis=-1)
    y = cg * xv
    yp = jnp.pad(y, ((0, 0), (1, 1), (0, 0)))
    conv = w_conv[0] * yp[:, :-2] + w_conv[1] * yp[:, 1:-1] + w_conv[2] * yp[:, 2:]
    return (bg * conv) @ w_out


def short_conv_mixer(a_lat, a_ctx, w_in, w_conv, w_out, ctx_out):
    y_lat = short_conv_seq(a_lat, w_in, w_conv, w_out)
    y_ctx = short_conv_seq(a_ctx, w_in, w_conv, w_out) if ctx_out else None
    return y_lat, y_ctx


def diff_core(q, k, v, lam):
    logits = jnp.einsum('bqhd,bkhd->bhqk', q, k, preferred_element_type=jnp.float32) * (HEAD_DIM ** -0.5)
    p = jax.nn.softmax(logits, axis=-1)
    b_, h2, nq, nk = p.shape
    p = p.reshape(b_, h2 // 2, 2, nq, nk)
    w = p[:, :, 0] - lam * p[:, :, 1]
    return jnp.einsum('bhqk,bkhe->bqhe', w.astype(v.dtype), v)


def diff_attn_mixer(a_lat, a_ctx, w_qkv, w_out, q_g, k_g, lam_p, sub_g, layer, angles, ctx_out):
    lam_init = 0.8 - 0.6 * math.exp(-0.3 * layer)
    lp = lam_p.astype(jnp.float32)
    lam = jnp.exp(jnp.sum(lp[0] * lp[1])) - jnp.exp(jnp.sum(lp[2] * lp[3])) + lam_init

    def proj(a):
        b_, s_, _ = a.shape
        q, k, v = jnp.split(a @ w_qkv, 3, axis=-1)
        q = rms_norm(q.reshape(b_, s_, 2 * DIFF_HEADS, HEAD_DIM), q_g)
        k = rms_norm(k.reshape(b_, s_, 2 * DIFF_HEADS, HEAD_DIM), k_g)
        return q, k, v.reshape(b_, s_, DIFF_HEADS, 2 * HEAD_DIM)

    def finish(o):
        o = rms_norm(o, sub_g) * (1 - lam_init)
        return o.reshape(o.shape[0], o.shape[1], -1) @ w_out

    q_l, k_l, v_l = proj(a_lat)
    q_l = rope_2d(q_l, angles)
    k_l = rope_2d(k_l, angles)
    q_c, k_c, v_c = proj(a_ctx)
    k_all = jnp.concatenate([k_c, k_l], axis=1)
    v_all = jnp.concatenate([v_c, v_l], axis=1)
    b_, s_ = a_lat.shape[:2]
    nb = s_ // Q_BLOCK
    q_blocks = q_l.reshape(b_, nb, Q_BLOCK, 2 * DIFF_HEADS, HEAD_DIM).swapaxes(0, 1)
    o = lax.map(lambda qb: diff_core(qb, k_all, v_all, lam), q_blocks)
    o = o.swapaxes(0, 1).reshape(b_, s_, DIFF_HEADS, 2 * HEAD_DIM)
    y_lat = finish(o)
    y_ctx = finish(diff_core(q_c, k_c, v_c, lam)) if ctx_out else None
    return y_lat, y_ctx


def chunk_mlp_seq(a, w_in, b_in, v_g, w_s, b_s, w_out):
    b_, s_, _ = a.shape
    z = jax.nn.gelu(a @ w_in + b_in)
    u, v = jnp.split(z, 2, axis=-1)
    v = rms_norm(v, v_g).reshape(b_, s_ // CHUNK, CHUNK, CM_GROUPS, CM_WIDTH // CM_GROUPS)
    sv = jnp.einsum('gpq,bnqgc->bnpgc', w_s, v) + b_s.T[:, :, None]
    return (u * sv.reshape(b_, s_, CM_WIDTH)) @ w_out


def chunk_mlp_mixer(a_lat, a_ctx, w_in, b_in, v_g, w_s, b_s, w_out, ctx_out):
    y_lat = chunk_mlp_seq(a_lat, w_in, b_in, v_g, w_s, b_s, w_out)
    y_ctx = chunk_mlp_seq(a_ctx, w_in, b_in, v_g, w_s, b_s, w_out) if ctx_out else None
    return y_lat, y_ctx


def sink_attend(q, ks, vs, masks, sink):
    logits = []
    for k, m in zip(ks, masks):
        l = jnp.einsum('bqhgd,bkhd->bhgqk', q, k, preferred_element_type=jnp.float32) * (HEAD_DIM ** -0.5)
        if m is not None:
            l = jnp.where(m, l, -jnp.inf)
        logits.append(l)
    b_, nq = q.shape[0], q.shape[1]
    sink_col = jnp.broadcast_to(sink.astype(jnp.float32)[None, :, :, None, None],
                                (b_, SWA_KV_HEADS, SWA_GROUP, nq, 1))
    p = jax.nn.softmax(jnp.concatenate(logits + [sink_col], axis=-1), axis=-1)
    outs = []
    off = 0
    for v in vs:
        n = v.shape[1]
        outs.append(jnp.einsum('bhgqk,bkhd->bqhgd', p[..., off:off + n].astype(v.dtype), v))
        off += n
    return sum(outs)


def swa_mixer(a_lat, a_ctx, w_qkv, w_out, q_g, k_g, sink, angles, ctx_out):
    qd = SWA_Q_HEADS * HEAD_DIM
    kvd = SWA_KV_HEADS * HEAD_DIM
    sink_kg = sink.reshape(SWA_KV_HEADS, SWA_GROUP)

    def proj(a, rotate):
        b_, s_, _ = a.shape
        qkv = a @ w_qkv
        q = rms_norm(qkv[..., :qd].reshape(b_, s_, SWA_Q_HEADS, HEAD_DIM), q_g)
        k = rms_norm(qkv[..., qd:qd + kvd].reshape(b_, s_, SWA_KV_HEADS, HEAD_DIM), k_g)
        v = qkv[..., qd + kvd:].reshape(b_, s_, SWA_KV_HEADS, HEAD_DIM)
        if rotate:
            q = rope_2d(q, angles)
            k = rope_2d(k, angles)
        return q.reshape(b_, s_, SWA_KV_HEADS, SWA_GROUP, HEAD_DIM), k, v

    q_l, k_l, v_l = proj(a_lat, True)
    q_c, k_c, v_c = proj(a_ctx, False)
    b_, s_ = a_lat.shape[:2]
    nb = s_ // Q_BLOCK
    band = Q_BLOCK + 2 * SWA_WINDOW
    pad = ((0, 0), (SWA_WINDOW, SWA_WINDOW), (0, 0), (0, 0))
    k_pad = jnp.pad(k_l, pad)
    v_pad = jnp.pad(v_l, pad)
    rel = jnp.arange(band)[None, :] - jnp.arange(Q_BLOCK)[:, None]
    in_band = (rel >= 0) & (rel <= 2 * SWA_WINDOW)
    q_blocks = q_l.reshape(b_, nb, Q_BLOCK, SWA_KV_HEADS, SWA_GROUP, HEAD_DIM).swapaxes(0, 1)
    starts = jnp.arange(nb) * Q_BLOCK

    def block(args):
        qb, st = args
        kb = lax.dynamic_slice_in_dim(k_pad, st, band, axis=1)
        vb = lax.dynamic_slice_in_dim(v_pad, st, band, axis=1)
        key_pos = st - SWA_WINDOW + jnp.arange(band)
        mask = in_band & ((key_pos >= 0) & (key_pos < s_))[None, :]
        return sink_attend(qb, [k_c, kb], [v_c, vb], [None, mask], sink_kg)

    o = lax.map(block, (q_blocks, starts)).swapaxes(0, 1).reshape(b_, s_, qd)
    y_lat = o @ w_out
    y_ctx = None
    if ctx_out:
        oc = sink_attend(q_c, [k_c], [v_c], [None], sink_kg)
        y_ctx = oc.reshape(oc.shape[0], oc.shape[1], qd) @ w_out
    return y_lat, y_ctx


def swiglu(a, w1, w3, w2):
    return (jax.nn.silu(a @ w1) * (a @ w3)) @ w2


def moe_ffn(a, w_r, b_r, w1, w3, w2):
    t, d = a.shape
    logits = (a @ w_r).astype(jnp.float32) + b_r.astype(jnp.float32)
    top_v, top_i = lax.top_k(logits, TOP_K)
    gates = jax.nn.softmax(top_v, axis=-1)
    n_assign = t * TOP_K
    expert = top_i.reshape(-1).astype(jnp.int32)
    token = jnp.arange(n_assign, dtype=jnp.int32) // TOP_K
    gate = gates.reshape(-1)
    order = jnp.argsort(expert)
    s_exp, s_tok, s_gate = expert[order], token[order], gate[order]
    counts = jnp.bincount(expert, length=N_EXPERTS).astype(jnp.int32)
    padded = (counts + MOE_BLOCK - 1) // MOE_BLOCK * MOE_BLOCK
    pad_end = jnp.cumsum(padded)
    pad_start = pad_end - padded
    grp_start = jnp.cumsum(counts) - counts
    dest = pad_start[s_exp] + jnp.arange(n_assign, dtype=jnp.int32) - grp_start[s_exp]
    n_blocks = n_assign // MOE_BLOCK + N_EXPERTS
    n_slots = n_blocks * MOE_BLOCK
    slot_tok = jnp.full((n_slots,), t, jnp.int32).at[dest].set(s_tok)
    slot_gate = jnp.zeros((n_slots,), jnp.float32).at[dest].set(s_gate)
    blk_exp = jnp.minimum(jnp.searchsorted(pad_end, jnp.arange(n_blocks, dtype=jnp.int32) * MOE_BLOCK, side='right'),
                          N_EXPERTS - 1)
    a_pad = jnp.concatenate([a, jnp.zeros((1, d), a.dtype)], axis=0)
    xs = a_pad[slot_tok].reshape(n_blocks, MOE_BLOCK, d)
    ys = lax.map(lambda args: swiglu(args[0], w1[args[1]], w3[args[1]], w2[args[1]]), (xs, blk_exp))
    ys = ys.reshape(n_slots, d) * slot_gate[:, None].astype(a.dtype)
    return jnp.zeros_like(a_pad).at[slot_tok].add(ys)[:t]


def setup_inputs(seed: int = 0) -> dict:
    key = jax.random.key(seed)
    ks = iter(jax.random.split(key, 48))
    f32 = jnp.float32
    D = D_MODEL

    def nrm(shape, fan_in):
        return jax.random.normal(next(ks), shape, f32) * (fan_in ** -0.5)

    def gain(shape):
        return 1.0 + 0.1 * jax.random.normal(next(ks), shape, f32)

    def small(shape, s):
        return s * jax.random.normal(next(ks), shape, f32)

    inp = {}
    inp["x"] = jax.random.normal(next(ks), (BATCH, SEQ, D), f32)
    inp["c"] = jax.random.normal(next(ks), (BATCH, D), f32)
    inp["ctx"] = jax.random.normal(next(ks), (BATCH, CTX_LEN, D), f32)
    inp["c_ctx"] = jax.random.normal(next(ks), (D,), f32)
    inp["ada_w"] = 0.5 * nrm((DEPTH, D, 6 * D), D)
    inp["ada_b"] = small((DEPTH, 6 * D), 0.02)
    inp["norm_mix_g"] = gain((DEPTH, D))
    inp["norm_ffn_g"] = gain((DEPTH, D))
    inp["sc_in_w"] = nrm((N_CONV, D, 3 * D), D)
    inp["sc_conv_w"] = nrm((N_CONV, 3, D), 3)
    inp["sc_out_w"] = nrm((N_CONV, D, D), D)
    inp["da_qkv_w"] = nrm((N_DIFF, D, 3 * D), D)
    inp["da_out_w"] = nrm((N_DIFF, D, D), D)
    inp["da_q_norm_g"] = gain((N_DIFF, HEAD_DIM))
    inp["da_k_norm_g"] = gain((N_DIFF, HEAD_DIM))
    inp["da_lambda"] = small((N_DIFF, 4, HEAD_DIM), 0.1)
    inp["da_sub_norm_g"] = gain((N_DIFF, 2 * HEAD_DIM))
    inp["cm_in_w"] = nrm((N_CHUNK, D, 2 * CM_WIDTH), D)
    inp["cm_in_b"] = small((N_CHUNK, 2 * CM_WIDTH), 0.02)
    inp["cm_v_norm_g"] = gain((N_CHUNK, CM_WIDTH))
    inp["cm_ws"] = nrm((N_CHUNK, CM_GROUPS, CHUNK, CHUNK), CHUNK)
    inp["cm_bs"] = small((N_CHUNK, CM_GROUPS, CHUNK), 0.1)
    inp["cm_out_w"] = nrm((N_CHUNK, CM_WIDTH, D), CM_WIDTH)
    inp["sw_qkv_w"] = nrm((N_SWA, D, (SWA_Q_HEADS + 2 * SWA_KV_HEADS) * HEAD_DIM), D)
    inp["sw_out_w"] = nrm((N_SWA, SWA_Q_HEADS * HEAD_DIM, D), SWA_Q_HEADS * HEAD_DIM)
    inp["sw_q_norm_g"] = gain((N_SWA, HEAD_DIM))
    inp["sw_k_norm_g"] = gain((N_SWA, HEAD_DIM))
    inp["sw_sink"] = small((N_SWA, SWA_Q_HEADS), 1.0)
    inp["ffn_w1"] = nrm((N_DENSE, D, FFN_DIM), D)
    inp["ffn_w3"] = nrm((N_DENSE, D, FFN_DIM), D)
    inp["ffn_w2"] = nrm((N_DENSE, FFN_DIM, D), FFN_DIM)
    inp["moe_router_w"] = nrm((N_MOE, D, N_EXPERTS), D)
    inp["moe_router_b"] = small((N_MOE, N_EXPERTS), 0.01)
    inp["moe_w1"] = nrm((N_MOE, N_EXPERTS, D, FFN_DIM), D)
    inp["moe_w3"] = nrm((N_MOE, N_EXPERTS, D, FFN_DIM), D)
    inp["moe_w2"] = nrm((N_MOE, N_EXPERTS, FFN_DIM, D), FFN_DIM)
    return inp


def reference(x, c, ctx, c_ctx, ada_w, ada_b, norm_mix_g, norm_ffn_g,
              sc_in_w, sc_conv_w, sc_out_w,
              da_qkv_w, da_out_w, da_q_norm_g, da_k_norm_g, da_lambda, da_sub_norm_g,
              cm_in_w, cm_in_b, cm_v_norm_g, cm_ws, cm_bs, cm_out_w,
              sw_qkv_w, sw_out_w, sw_q_norm_g, sw_k_norm_g, sw_sink,
              ffn_w1, ffn_w3, ffn_w2,
              moe_router_w, moe_router_b, moe_w1, moe_w3, moe_w2):
    angles = axial_angles(x.shape[1])
    h, hc = x, ctx
    for i in range(DEPTH):
        ctx_out = i < DEPTH - 1
        sh1, sc1, g1, sh2, sc2, g2 = adaln(c, ada_w[i], ada_b[i])
        csh1, csc1, cg1, csh2, csc2, cg2 = adaln(c_ctx, ada_w[i], ada_b[i])
        a = modulate(rms_norm(h, norm_mix_g[i]), sh1, sc1)
        ac = modulate(rms_norm(hc, norm_mix_g[i]), csh1, csc1)
        kind, j = i % N_MIXERS, i // N_MIXERS
        if kind == 0:
            y, yc = short_conv_mixer(a, ac, sc_in_w[j], sc_conv_w[j], sc_out_w[j], ctx_out)
        elif kind == 1:
            y, yc = diff_attn_mixer(a, ac, da_qkv_w[j], da_out_w[j], da_q_norm_g[j], da_k_norm_g[j],
                                    da_lambda[j], da_sub_norm_g[j], i, angles, ctx_out)
        elif kind == 2:
            y, yc = chunk_mlp_mixer(a, ac, cm_in_w[j], cm_in_b[j], cm_v_norm_g[j], cm_ws[j], cm_bs[j],
                                    cm_out_w[j], ctx_out)
        else:
            y, yc = swa_mixer(a, ac, sw_qkv_w[j], sw_out_w[j], sw_q_norm_g[j], sw_k_norm_g[j],
                              sw_sink[j], angles, ctx_out)
        h = h + g1 * y
        if ctx_out:
            hc = hc + cg1 * yc
        a = modulate(rms_norm(h, norm_ffn_g[i]), sh2, sc2)
        f = i // 2
        if i % 2 == 0:
            h = h + g2 * swiglu(a, ffn_w1[f], ffn_w3[f], ffn_w2[f])
            if ctx_out:
                ac = modulate(rms_norm(hc, norm_ffn_g[i]), csh2, csc2)
                hc = hc + cg2 * swiglu(ac, ffn_w1[f], ffn_w3[f], ffn_w2[f])
        else:
            b_, s_, d_ = a.shape
            if ctx_out:
                ac = modulate(rms_norm(hc, norm_ffn_g[i]), csh2, csc2)
                flat = jnp.concatenate([a.reshape(-1, d_), ac.reshape(-1, d_)], axis=0)
                out = moe_ffn(flat, moe_router_w[f], moe_router_b[f], moe_w1[f], moe_w3[f], moe_w2[f])
                h = h + g2 * out[:b_ * s_].reshape(b_, s_, d_)
                hc = hc + cg2 * out[b_ * s_:].reshape(hc.shape)
            else:
                out = moe_ffn(a.reshape(-1, d_), moe_router_w[f], moe_router_b[f], moe_w1[f], moe_w3[f], moe_w2[f])
                h = h + g2 * out.reshape(b_, s_, d_)
    return h
```

```cpp
#include <hip/hip_runtime.h>
#include <cstdio>
#include <cstdint>
#include <cmath>
#ifndef MK_NGRP
#define MK_NGRP 1
#endif
#define MK_TLAT (32768 / MK_NGRP)
namespace pg8 {
#define PG8_LAS __attribute__((address_space(3)))
typedef unsigned short bf16_t;
typedef short bf16x8 __attribute__((ext_vector_type(8)));
typedef float f32x4 __attribute__((ext_vector_type(4)));
typedef unsigned u32x4 __attribute__((ext_vector_type(4)));
constexpr int BM = 256, BK = 64, HALF = 128, HTB = HALF * BK * 2  , STAGE_BYTES = 8 * HTB, NXCD = 8, WGM = 4;

__host__ __device__ __forceinline__ int lds_byte(int r, int c) { const int st = (r >> 4) * 2 + (c >> 5), rr = r & 15, cc = c & 31, ob = rr * 64 + cc * 2; return st * 1024 + (ob ^ (((ob >> 9) & 1) << 5)); }
__host__ __device__ __forceinline__ void stage_rc(int b, int& R, int& C) { const int st = b / 1024, sb = b % 1024, swz = sb ^ (((sb >> 9) & 1) << 5); R = (st >> 1) * 16 + swz / 64; C = (st & 1) * 32 + (swz % 64) / 2; }
__host__ __device__ __forceinline__ int perm32(int rho) { const int n = rho >> 4, i = rho & 15; return 8 * (i >> 2) + 4 * n + (i & 3); }

struct Unit { int pm, pn; };
struct Gemm { const bf16_t* A; const bf16_t* Bt; int M, N, K; };

struct StaticOrder {
    int nM, nN, nwg, G, c;
    __host__ __device__ void init(int M, int N, int G_, int c_) { nM = M / BM; nN = N / BM; nwg = nM * nN; G = G_; c = c_; }
    __host__ __device__ bool next(int i, Unit& u) const {
        const long L = (long)i * G + c; if (L >= nwg) return false;
        int wgid = (int)L; { const int q = nwg / NXCD, r = nwg % NXCD, xcd = wgid % NXCD, off = wgid / NXCD; wgid = (xcd < r ? xcd * (q + 1) : r * (q + 1) + (xcd - r) * q) + off; }
        const int nig = WGM * nN, gid = wgid / nig, fm = gid * WGM, gsz = (nM - fm) < WGM ? (nM - fm) : WGM;
        u.pm = fm + ((wgid % nig) % gsz); u.pn = (wgid % nig) / gsz; return true;
    }
    __device__ __forceinline__ void a_ready(const Unit&) const {}
    __device__ __forceinline__ void done(const Unit&) const {}
};

__device__ __forceinline__ unsigned cvt_pk_bf16(float lo, float hi) { unsigned r; asm volatile("v_cvt_pk_bf16_f32 %0, %1, %2" : "=v"(r) : "v"(lo), "v"(hi)); return r; }
typedef int i32x4_ __attribute__((ext_vector_type(4)));
constexpr float F8_SA = 16.f, F8_SW13 = 32.f, F8_SH = 4.f, F8_SW2 = 64.f, F8_SAU = 8.f;
__device__ __forceinline__ unsigned cvt_pk_fp8x4(float a, float b, float c, float d) {
    a = __builtin_amdgcn_fmed3f(a, -448.f, 448.f); b = __builtin_amdgcn_fmed3f(b, -448.f, 448.f); c = __builtin_amdgcn_fmed3f(c, -448.f, 448.f); d = __builtin_amdgcn_fmed3f(d, -448.f, 448.f);
    unsigned w = 0u; w = (unsigned)__builtin_amdgcn_cvt_pk_fp8_f32(a, b, (int)w, false); w = (unsigned)__builtin_amdgcn_cvt_pk_fp8_f32(c, d, (int)w, true); return w; }
__device__ __forceinline__ float bf_lo(unsigned u) { return __builtin_bit_cast(float, u << 16); }
__device__ __forceinline__ float bf_hi(unsigned u) { return __builtin_bit_cast(float, u & 0xffff0000u); }

typedef float f32x2 __attribute__((ext_vector_type(2)));
__device__ __forceinline__ float gelu_tanh1(float x) {
    const float u = 0.7978845608028654f * (x + 0.044715f * x * x * x);
    const float e = __builtin_amdgcn_exp2f(-2.8853900817779268f * u);
    return x * __builtin_amdgcn_rcpf(1.0f + e);
}
__device__ __forceinline__ float silu1(float x) { return x * __builtin_amdgcn_rcpf(1.0f + __builtin_amdgcn_exp2f(-1.4426950408889634f * x)); }
__device__ __forceinline__ void swiglu8(const float (&g)[8], const float (&u)[8], const float c1, const float K, float (&h)[8]) {
    float t[8], p[8];
#pragma unroll
    for (int j = 0; j < 8; ++j) t[j] = g[j] * c1;
    __builtin_amdgcn_sched_barrier(0);
#pragma unroll
    for (int j = 0; j < 8; ++j) t[j] = __builtin_amdgcn_exp2f(t[j]);
#pragma unroll
    for (int j = 0; j < 8; ++j) p[j] = g[j] * u[j];
    __builtin_amdgcn_sched_barrier(0);
#pragma unroll
    for (int j = 0; j < 8; ++j) t[j] = __builtin_fmaf(t[j], K, K);
    __builtin_amdgcn_sched_barrier(0);
#pragma unroll
    for (int j = 0; j < 8; ++j) t[j] = __builtin_amdgcn_rcpf(t[j]);
    __builtin_amdgcn_sched_barrier(0);
#pragma unroll
    for (int j = 0; j < 8; ++j) h[j] = p[j] * t[j];
}

__device__ __forceinline__ float row_rstd16(const float* ssq, int row) {
    const f32x4* p = (const f32x4*)(ssq + (size_t)row * 32); const f32x4 a = p[0], b = p[1], c = p[2], d = p[3];
    const float t = ((a.x + a.y) + (a.z + a.w)) + ((b.x + b.y) + (b.z + b.w)) + ((c.x + c.y) + (c.z + c.w)) + ((d.x + d.y) + (d.z + d.w));
    return 1.0f / sqrtf(t * (1.0f / 1024.0f) + 1e-6f);
}
template <int ACT> struct EpiStore {
    static constexpr bool PERM = true, AFTER_DRAIN = false;
    bf16_t* O; int ldc; const float* bias; float* ssq; int ssq_pn0;
    __device__ __forceinline__ void operator()(const f32x4 (&acc)[2][2][4][2], const Unit& u, int wr, int wc, int fr, int fq) const {
        const int row0 = u.pm * BM + wr * 64 + fr; const int col0 = u.pn * BM + wc * 32 + 8 * fq;
        f32x4 bv[2][2];
#pragma unroll
        for (int bj = 0; bj < 2; ++bj)
#pragma unroll
            for (int n = 0; n < 2; ++n) bv[bj][n] = bias ? *(const f32x4*)(bias + col0 + bj * HALF + 4 * n) : (f32x4){0.f, 0.f, 0.f, 0.f};
#pragma unroll
        for (int ai = 0; ai < 2; ++ai)
#pragma unroll
            for (int m = 0; m < 4; ++m) { bf16_t* rowp = O + (size_t)(row0 + ai * HALF + m * 16) * ldc + col0; float ss = 0.f;
#pragma unroll
                for (int bj = 0; bj < 2; ++bj) { f32x4 v0 = acc[ai][bj][m][0] + bv[bj][0], v1 = acc[ai][bj][m][1] + bv[bj][1];
                    if (ACT == 1) {
#pragma unroll
                        for (int i = 0; i < 4; ++i) { v0[i] = gelu_tanh1(v0[i]); v1[i] = gelu_tanh1(v1[i]); }
#pragma unroll
                        for (int i = 0; i < 4; ++i) ss += v0[i] * v0[i] + v1[i] * v1[i];
                    }
                    u32x4 w; w.x = cvt_pk_bf16(v0[0], v0[1]); w.y = cvt_pk_bf16(v0[2], v0[3]); w.z = cvt_pk_bf16(v1[0], v1[1]); w.w = cvt_pk_bf16(v1[2], v1[3]);
                    *(u32x4*)(rowp + bj * HALF) = w; }
                if (ACT == 1) { ss += __shfl_xor(ss, 16); ss += __shfl_xor(ss, 32);
                    if (u.pn >= ssq_pn0 && fq == 0) ssq[(size_t)(row0 + ai * HALF + m * 16) * 32 + (u.pn - ssq_pn0) * 4 + wc] = ss; }
            }
    }
};

struct EpiConvIn {
    static constexpr bool PERM = true, AFTER_DRAIN = false;
    bf16_t* O;
    __device__ __forceinline__ void operator()(const f32x4 (&acc)[2][2][4][2], const Unit& u, int wr, int wc, int fr, int fq) const {
        const int row0 = u.pm * BM + wr * 64 + fr;
        if (u.pn < 4) { const int col0 = u.pn * BM + wc * 32 + 8 * fq;
#pragma unroll
            for (int ai = 0; ai < 2; ++ai)
#pragma unroll
                for (int m = 0; m < 4; ++m) { bf16_t* rowp = O + (size_t)(row0 + ai * HALF + m * 16) * 2048 + col0;
#pragma unroll
                    for (int bj = 0; bj < 2; ++bj) { const f32x4 v0 = acc[ai][bj][m][0], v1 = acc[ai][bj][m][1];
                        u32x4 w; w.x = cvt_pk_bf16(v0[0], v0[1]); w.y = cvt_pk_bf16(v0[2], v0[3]); w.z = cvt_pk_bf16(v1[0], v1[1]); w.w = cvt_pk_bf16(v1[2], v1[3]);
                        *(u32x4*)(rowp + bj * HALF) = w; } }
        } else { const int col0 = 1024 + (u.pn - 4) * HALF + wc * 32 + 8 * fq;
#pragma unroll
            for (int ai = 0; ai < 2; ++ai)
#pragma unroll
                for (int m = 0; m < 4; ++m) { const f32x4 v0 = acc[ai][0][m][0] * acc[ai][1][m][0], v1 = acc[ai][0][m][1] * acc[ai][1][m][1];
                    u32x4 w; w.x = cvt_pk_bf16(v0[0], v0[1]); w.y = cvt_pk_bf16(v0[2], v0[3]); w.z = cvt_pk_bf16(v1[0], v1[1]); w.w = cvt_pk_bf16(v1[2], v1[3]);
                    *(u32x4*)(O + (size_t)(row0 + ai * HALF + m * 16) * 2048 + col0) = w; }
        }
    }
};

struct EpiQKV {
    static constexpr bool PERM = true, AFTER_DRAIN = false;
    bf16_t* O; int ldc; const float* ssq; const float* bias  ; int N; int nq_t, nk_t; const float* qg; const float* kg; const float* RT; float qscale; int b0;
    __device__ __forceinline__ void operator()(const f32x4 (&acc)[2][2][4][2], const Unit& u, int wr, int wc, int fr, int fq) const {
        const int prow = u.pm * BM; const bool lat = prow < MK_TLAT; const int cidx = lat ? b0 + (prow >> 12) : 8;
        const int rl0 = wr * 64 + fr; const int ncol0 = u.pn * BM + wc * 32 + 8 * fq;
        const float* bp = bias + (size_t)cidx * N + ncol0;
        f32x4 bv[2][2];
#pragma unroll
        for (int bj = 0; bj < 2; ++bj)
#pragma unroll
            for (int n = 0; n < 2; ++n) bv[bj][n] = *(const f32x4*)(bp + bj * HALF + 4 * n);
        const bool isq = u.pn < nq_t, isqk = u.pn < nq_t + nk_t;
        f32x4 gg[2][2];
        if (isqk) { const float* gp = isq ? qg : kg; const float sc = isq ? qscale : 1.0f;
#pragma unroll
            for (int bj = 0; bj < 2; ++bj)
#pragma unroll
                for (int n = 0; n < 2; ++n) gg[bj][n] = *(const f32x4*)(gp + bj * 32 + 16 * n + 4 * fq) * sc; }
        typedef unsigned u32x2q __attribute__((ext_vector_type(2)));
#pragma unroll
        for (int ai = 0; ai < 2; ++ai) {
            f32x4 csR, snR;
            if (isqk && lat) { const int posr = ((prow + wr * 64 + ai * HALF) & 4095) >> 6;
                const f32x4 t0 = *(const f32x4*)(RT + 2 * (posr * 16 + 4 * fq)), t1 = *(const f32x4*)(RT + 2 * (posr * 16 + 4 * fq) + 4);
                csR = (f32x4){t0.x, t0.z, t1.x, t1.z}; snR = (f32x4){t0.y, t0.w, t1.y, t1.w}; }
#pragma unroll
            for (int m = 0; m < 4; ++m) { const int row = prow + rl0 + ai * HALF + m * 16;
                const float rs = row_rstd16(ssq, row);
                f32x4 v[2][2]; float ss = 0.f;
#pragma unroll
                for (int bj = 0; bj < 2; ++bj)
#pragma unroll
                    for (int n = 0; n < 2; ++n) { v[bj][n] = acc[ai][bj][m][n] * rs + bv[bj][n]; ss += (v[bj][n].x * v[bj][n].x + v[bj][n].y * v[bj][n].y) + (v[bj][n].z * v[bj][n].z + v[bj][n].w * v[bj][n].w); }
                if (isqk) {
                    ss += __shfl_xor(ss, 16); ss += __shfl_xor(ss, 32);
                    const float rh = 1.0f / sqrtf(ss * (1.0f / 64.0f) + 1e-6f);
#pragma unroll
                    for (int bj = 0; bj < 2; ++bj)
#pragma unroll
                        for (int n = 0; n < 2; ++n) v[bj][n] = v[bj][n] * rh * gg[bj][n];
                    if (lat) {
                        { const f32x4 x1 = v[0][0], x2 = v[0][1]; v[0][0] = x1 * csR - x2 * snR; v[0][1] = x1 * snR + x2 * csR; }
                        { const int posc = fr + 16 * m;
                          const f32x4 t0 = *(const f32x4*)(RT + 2 * (posc * 16 + 4 * fq)), t1 = *(const f32x4*)(RT + 2 * (posc * 16 + 4 * fq) + 4);
                          const f32x4 cs = (f32x4){t0.x, t0.z, t1.x, t1.z}, sn = (f32x4){t0.y, t0.w, t1.y, t1.w};
                          const f32x4 x1 = v[1][0], x2 = v[1][1]; v[1][0] = x1 * cs - x2 * sn; v[1][1] = x1 * sn + x2 * cs; }
                    }
                    bf16_t* rowp = O + (size_t)row * ldc + u.pn * BM + wc * 64 + 4 * fq;
#pragma unroll
                    for (int bj = 0; bj < 2; ++bj)
#pragma unroll
                        for (int n = 0; n < 2; ++n) { u32x2q w; w.x = cvt_pk_bf16(v[bj][n][0], v[bj][n][1]); w.y = cvt_pk_bf16(v[bj][n][2], v[bj][n][3]); *(u32x2q*)(rowp + bj * 32 + 16 * n) = w; }
                } else {
                    bf16_t* rowp = O + (size_t)row * ldc + ncol0;
#pragma unroll
                    for (int bj = 0; bj < 2; ++bj) { u32x4 w; w.x = cvt_pk_bf16(v[bj][0][0], v[bj][0][1]); w.y = cvt_pk_bf16(v[bj][0][2], v[bj][0][3]); w.z = cvt_pk_bf16(v[bj][1][0], v[bj][1][1]); w.w = cvt_pk_bf16(v[bj][1][2], v[bj][1][3]);
                        *(u32x4*)(rowp + bj * HALF) = w; }
                }
            }
        }
    }
};

template <bool NIN, bool A8 = false> struct EpiSwiGLU {
    static constexpr bool PERM = true, AFTER_DRAIN = false;
    bf16_t* O; int ldo; const float* ssq; const float* bias  ; int b0;
    __device__ __forceinline__ void operator()(const f32x4 (&acc)[2][2][4][2], const Unit& u, int wr, int wc, int fr, int fq) const {
        const int row0 = u.pm * BM + wr * 64 + fr; const int col0 = (u.pn % 22) * HALF + wc * 32 + 8 * fq;
        f32x4 bv[2][2];
        if (NIN) { const int prow = u.pm * BM; const int cidx = prow < MK_TLAT ? b0 + (prow >> 12) : 8; const float* bp = bias + (size_t)cidx * 5632 + u.pn * BM + wc * 32 + 8 * fq;
#pragma unroll
            for (int bj = 0; bj < 2; ++bj)
#pragma unroll
                for (int n = 0; n < 2; ++n) bv[bj][n] = *(const f32x4*)(bp + bj * HALF + 4 * n); }
#pragma unroll
        for (int ai = 0; ai < 2; ++ai)
#pragma unroll
            for (int m = 0; m < 4; ++m) { const int row = row0 + ai * HALF + m * 16; bf16_t* rowp = O + (size_t)row * ldo + col0;
                float rs = 1.0f; if (NIN) rs = row_rstd16(ssq, row); if (A8) rs *= 1.0f / (F8_SAU * F8_SW13);
                float h[8], gg[8], uu[8];
#pragma unroll
                for (int n = 0; n < 2; ++n)
#pragma unroll
                    for (int i = 0; i < 4; ++i) { float gt = acc[ai][0][m][n][i], up = acc[ai][1][m][n][i]; if (NIN) { gt = gt * rs + bv[0][n][i]; up = up * rs + bv[1][n][i]; } gg[4 * n + i] = gt; uu[4 * n + i] = up; }
                swiglu8(gg, uu, -1.4426950408889634f, 1.0f, h);
                u32x4 w; w.x = cvt_pk_bf16(h[0], h[1]); w.y = cvt_pk_bf16(h[2], h[3]); w.z = cvt_pk_bf16(h[4], h[5]); w.w = cvt_pk_bf16(h[6], h[7]);
                *(u32x4*)rowp = w; }
    }
};

template <bool NIN, bool G8 = true> struct EpiSwiGLU8 {
    static constexpr bool PERM = true, AFTER_DRAIN = false;
    unsigned char* O; const float* ssq; const float* bias  ; int b0;
    static constexpr int ldo = 2816; static constexpr float in_scale = G8 ? 1.0f / ((NIN ? F8_SAU : F8_SA) * F8_SW13) : 1.0f, out_scale = F8_SH;
    __device__ __forceinline__ void operator()(const f32x4 (&acc)[2][2][4][2], const Unit& u, int wr, int wc, int fr, int fq) const {
        const int row0 = u.pm * BM + wr * 64 + fr; const int col0 = (u.pn % 22) * HALF + wc * 32 + 8 * fq;
        f32x4 bv[2][2];
        if (NIN) { const int prow = u.pm * BM; const int cidx = prow < MK_TLAT ? b0 + (prow >> 12) : 8; const float* bp = bias + (size_t)cidx * 5632 + u.pn * BM + wc * 32 + 8 * fq;
#pragma unroll
            for (int bj = 0; bj < 2; ++bj)
#pragma unroll
                for (int n = 0; n < 2; ++n) bv[bj][n] = *(const f32x4*)(bp + bj * HALF + 4 * n); }
#pragma unroll
        for (int ai = 0; ai < 2; ++ai)
#pragma unroll
            for (int m = 0; m < 4; ++m) { const int row = row0 + ai * HALF + m * 16;
                float rs = in_scale; if (NIN) rs = row_rstd16(ssq, row) * in_scale;
                float h[8], gg[8], uu[8];
#pragma unroll
                for (int n = 0; n < 2; ++n)
#pragma unroll
                    for (int i = 0; i < 4; ++i) { float gt = acc[ai][0][m][n][i], up = acc[ai][1][m][n][i]; if (NIN) { gt = gt * rs + bv[0][n][i]; up = up * rs + bv[1][n][i]; } gg[4 * n + i] = gt; uu[4 * n + i] = up; }
                if (NIN) swiglu8(gg, uu, -1.4426950408889634f, 1.0f / out_scale, h);
                else swiglu8(gg, uu, -1.4426950408889634f * in_scale, 1.0f / (in_scale * in_scale * out_scale), h);
                unsigned w0 = cvt_pk_fp8x4(h[0], h[1], h[2], h[3]), w1 = cvt_pk_fp8x4(h[4], h[5], h[6], h[7]);
                typedef unsigned u32x2_ __attribute__((ext_vector_type(2)));
                *(u32x2_*)(O + (size_t)row * ldo + col0) = (u32x2_){w0, w1}; }
    }
};

template <bool NEXT, bool SRC32, bool N8 = false, bool A8S = false> struct EpiResid {
    static constexpr bool PERM = true, AFTER_DRAIN = false; static constexpr float ascale = A8S ? 1.0f / (F8_SH * F8_SW2) : 1.0f;
    static constexpr int HP = 2048;
    const void* src_lat; const void* src_ctx; bf16_t* dst_lat; bf16_t* dst_ctx; const float* gate;
    bf16_t* An; const float* gn; const float* scn; float* ssq; int b0;
    __device__ __forceinline__ void operator()(const f32x4 (&acc)[2][2][4][2], const Unit& u, int wr, int wc, int fr, int fq) const {
        const int prow = u.pm * BM; const bool lat = prow < MK_TLAT; const int cidx = lat ? b0 + (prow >> 12) : 8;
        const float* s32 = lat ? (const float*)src_lat + (size_t)prow * 1024 : (const float*)src_ctx + (size_t)(prow - MK_TLAT) * 1024;
        const bf16_t* s16 = lat ? (const bf16_t*)src_lat + (size_t)prow * HP : (const bf16_t*)src_ctx + (size_t)(prow - MK_TLAT) * HP;
        bf16_t* d = lat ? dst_lat + (size_t)prow * HP : dst_ctx + (size_t)(prow - MK_TLAT) * HP;
        const int rl0 = wr * 64 + fr; const int col0 = u.pn * BM + wc * 32 + 8 * fq;
        const float* g = gate + (size_t)cidx * 6144 + col0;
        float ss[2][4];
#pragma unroll
        for (int ai = 0; ai < 2; ++ai)
#pragma unroll
            for (int m = 0; m < 4; ++m) ss[ai][m] = 0.f;
#pragma unroll
        for (int bj = 0; bj < 2; ++bj) {
            asm volatile("" ::: "memory");
            f32x4 gv[2], Gn[2];
#pragma unroll
            for (int n = 0; n < 2; ++n) { gv[n] = *(const f32x4*)(g + bj * HALF + 4 * n); if (A8S) gv[n] = gv[n] * ascale;
                if (NEXT) { Gn[n] = *(const f32x4*)(gn + col0 + bj * HALF + 4 * n) * (*(const f32x4*)(scn + (size_t)cidx * 6144 + col0 + bj * HALF + 4 * n) + 1.0f); if (N8) Gn[n] = Gn[n] * F8_SAU; } }
#pragma unroll
            for (int ai = 0; ai < 2; ++ai)
#pragma unroll
                for (int m = 0; m < 4; ++m) { if ((m & 1) == 0) asm volatile("" ::: "memory");
                    const int rl = rl0 + ai * HALF + m * 16; f32x4 hn[2];
                    if (SRC32) { const size_t ro = (size_t)rl * 1024 + col0 + bj * HALF; hn[0] = *(const f32x4*)(s32 + ro); hn[1] = *(const f32x4*)(s32 + ro + 4); }
                    else { const u32x4 p = *(const u32x4*)(s16 + (size_t)rl * HP + col0 + bj * HALF);
                        hn[0] = f32x4{bf_lo(p.x), bf_hi(p.x), bf_lo(p.y), bf_hi(p.y)}; hn[1] = f32x4{bf_lo(p.z), bf_hi(p.z), bf_lo(p.w), bf_hi(p.w)}; }
#pragma unroll
                    for (int n = 0; n < 2; ++n) hn[n] = hn[n] + gv[n] * acc[ai][bj][m][n];
                    { u32x4 w; w.x = cvt_pk_bf16(hn[0][0], hn[0][1]); w.y = cvt_pk_bf16(hn[0][2], hn[0][3]); w.z = cvt_pk_bf16(hn[1][0], hn[1][1]); w.w = cvt_pk_bf16(hn[1][2], hn[1][3]);
                      *(u32x4*)(d + (size_t)rl * HP + col0 + bj * HALF) = w; }
                    if (NEXT) { ss[ai][m] += (hn[0].x * hn[0].x + hn[0].y * hn[0].y) + (hn[0].z * hn[0].z + hn[0].w * hn[0].w) + (hn[1].x * hn[1].x + hn[1].y * hn[1].y) + (hn[1].z * hn[1].z + hn[1].w * hn[1].w);
                        const f32x4 a0 = hn[0] * Gn[0], a1 = hn[1] * Gn[1];
                        if (N8) { typedef unsigned u32x2_ __attribute__((ext_vector_type(2)));
                            *(u32x2_*)((unsigned char*)An + (size_t)(prow + rl) * 1024 + col0 + bj * HALF) = (u32x2_){cvt_pk_fp8x4(a0[0], a0[1], a0[2], a0[3]), cvt_pk_fp8x4(a1[0], a1[1], a1[2], a1[3])}; }
                        else { u32x4 w; w.x = cvt_pk_bf16(a0[0], a0[1]); w.y = cvt_pk_bf16(a0[2], a0[3]); w.z = cvt_pk_bf16(a1[0], a1[1]); w.w = cvt_pk_bf16(a1[2], a1[3]);
                            *(u32x4*)(An + (size_t)(prow + rl) * 1024 + col0 + bj * HALF) = w; } } }
        }
        if (NEXT) {
#pragma unroll
            for (int ai = 0; ai < 2; ++ai)
#pragma unroll
                for (int m = 0; m < 4; ++m) { float t = ss[ai][m]; t += __shfl_xor(t, 16); t += __shfl_xor(t, 32); if (fq == 0) ssq[(size_t)(prow + rl0 + ai * HALF + m * 16) * 32 + u.pn * 4 + wc] = t; }
        }
    }
};

template <bool F8S> struct EpiMoeDown {
    static constexpr bool PERM = true, AFTER_DRAIN = false; static constexpr float scale = F8S ? 1.0f / (F8_SH * F8_SW2) : 1.0f;
    bf16_t* Y; const float* slot_gate;
    __device__ __forceinline__ void operator()(const f32x4 (&acc)[2][2][4][2], const Unit& u, int wr, int wc, int fr, int fq) const {
        const int row0 = u.pm * BM + wr * 64 + fr; const int col0 = (u.pn & 3) * BM + wc * 32 + 8 * fq;
#pragma unroll
        for (int ai = 0; ai < 2; ++ai)
#pragma unroll
            for (int m = 0; m < 4; ++m) { const int row = row0 + ai * HALF + m * 16; const float sg = slot_gate[row] * scale; bf16_t* rowp = Y + (size_t)row * 1024 + col0;
#pragma unroll
                for (int bj = 0; bj < 2; ++bj) { const f32x4 v0 = acc[ai][bj][m][0] * sg, v1 = acc[ai][bj][m][1] * sg;
                    u32x4 w; w.x = cvt_pk_bf16(v0[0], v0[1]); w.y = cvt_pk_bf16(v0[2], v0[3]); w.z = cvt_pk_bf16(v1[0], v1[1]); w.w = cvt_pk_bf16(v1[2], v1[3]);
                    *(u32x4*)(rowp + bj * HALF) = w; } }
    }
};

struct GridOrder {
    int nM, nN, nwg, G, c;
    __device__ void init(int nM_, int nN_, int G_, int c_) { nM = nM_; nN = nN_; nwg = nM * nN; G = G_; c = c_; }
    __device__ bool next(int i, Unit& u) const {
        const long L = (long)i * G + c; if (L >= nwg) return false;
        int wgid = (int)L; { const int q = nwg / NXCD, r = nwg % NXCD, xcd = wgid % NXCD, off = wgid / NXCD; wgid = (xcd < r ? xcd * (q + 1) : r * (q + 1) + (xcd - r) * q) + off; }
        const int nig = WGM * nN, gid = wgid / nig, fm = gid * WGM, gsz = (nM - fm) < WGM ? (nM - fm) : WGM;
        u.pm = fm + ((wgid % nig) % gsz); u.pn = (wgid % nig) / gsz; return true;
    }
    __device__ __forceinline__ void a_ready(const Unit&) const {}
    __device__ __forceinline__ void done(const Unit&) const {}
};
struct MoeOrder {
    GridOrder g; const PG8_LAS int* pexp; int nNe;
    __device__ bool next(int i, Unit& u) const { if (!g.next(i, u)) return false; u.pn += pexp[u.pm] * nNe; return true; }
    __device__ __forceinline__ void a_ready(const Unit&) const {}
    __device__ __forceinline__ void done(const Unit&) const {}
};
template <int NNE> struct MoeOrderC {
    int nM, c; const PG8_LAS int* pexp;
    __device__ bool next(int i, Unit& u) const {
        const int nwg = nM * NNE; const long L = (long)i * 256 + c; if (L >= nwg) return false;
        int wgid = (int)L; { const int q = nwg / NXCD, r = nwg % NXCD, xcd = wgid % NXCD, off = wgid / NXCD; wgid = (xcd < r ? xcd * (q + 1) : r * (q + 1) + (xcd - r) * q) + off; }
        constexpr int nig = WGM * NNE; const int gid = wgid / nig, fm = gid * WGM, gsz = (nM - fm) < WGM ? (nM - fm) : WGM;
        u.pm = fm + ((wgid % nig) % gsz); u.pn = (wgid % nig) / gsz; u.pn += pexp[u.pm] * NNE; return true;
    }
    __device__ __forceinline__ void a_ready(const Unit&) const {}
    __device__ __forceinline__ void done(const Unit&) const {}
};
__device__ __forceinline__ const char* sgpr_ptr(const char* p) { const unsigned long long v = (unsigned long long)p; const unsigned lo = __builtin_amdgcn_readfirstlane((unsigned)v), hi = __builtin_amdgcn_readfirstlane((unsigned)(v >> 32)); return (const char*)(((unsigned long long)hi << 32) | lo); }
template <class Epi, class Sched, bool ALIGN_EPI = false, bool SP2 = false, bool F8 = false>
__device__ __forceinline__ void gemm_phase(PG8_LAS unsigned char* lds, const Gemm g, const Sched& S, const Epi& E) {
    int tid_ = threadIdx.x; asm volatile("" : "+v"(tid_));
    const int tid = tid_, wid = __builtin_amdgcn_readfirstlane(tid >> 6), lane = tid & 63, wr = wid >> 2, wc = wid & 3, fr = lane & 15, fq = lane >> 4;
    const int K = g.K, nt = K / BK;
    unsigned voffA[2], voffB[2];
#pragma unroll
    for (int i = 0; i < 2; ++i) { int R, C; stage_rc(tid * 16 + i * 8192, R, C); const int Rb = Epi::PERM ? ((R & ~31) + perm32(R & 31)) : R;
        voffA[i] = (unsigned)(R * K + C) * 2u; voffB[i] = (unsigned)(Rb * K + C) * 2u; }
    const size_t kstep = (size_t)(BK * 2);
    const size_t hstep = (size_t)HALF * K * 2;
    const size_t tstep = 2 * hstep;
    const unsigned ldsw = (unsigned)wid * 1024u;
    const int aoff = lds_byte(wr * 64 + fr, fq * 8), boff = lds_byte(wc * 32 + fr, fq * 8);
#define PG8_SA(b, h) (((b) * 2 + (h)) * HTB)
#define PG8_SB(b, h) ((4 + (b) * 2 + (h)) * HTB)
#define PG8_STAGE(bufoff, gbase, voff) do { _Pragma("unroll") for (int _i = 0; _i < 2; ++_i) { unsigned _vo = (voff)[_i]; asm volatile("" : "+v"(_vo)); unsigned _lw = ldsw; asm volatile("" : "+s"(_lw)); \
        __builtin_amdgcn_global_load_lds((const unsigned*)((const char*)(gbase) + _vo), (PG8_LAS unsigned*)(lds + (bufoff) + _lw + _i * 8192), 16, 0, 0); } } while (0)
#define PG8_LDA(dst, b, h) do { _Pragma("unroll") for (int m = 0; m < 4; ++m) _Pragma("unroll") for (int k = 0; k < 2; ++k) dst[m][k] = *(const PG8_LAS bf16x8*)(lds + PG8_SA(b, h) + aoff + m * 2048 + k * 1024); } while (0)
#define PG8_LDB(dst, b, h) do { _Pragma("unroll") for (int n = 0; n < 2; ++n) _Pragma("unroll") for (int k = 0; k < 2; ++k) dst[n][k] = *(const PG8_LAS bf16x8*)(lds + PG8_SB(b, h) + boff + n * 2048 + k * 1024); } while (0)
#define PG8_CAT8(x0, x1) __builtin_shufflevector(__builtin_bit_cast(i32x4_, x0), __builtin_bit_cast(i32x4_, x1), 0, 1, 2, 3, 4, 5, 6, 7)
#define PG8_MMA(ai, bj, At, Bt) do { __builtin_amdgcn_s_setprio(1); if constexpr (F8) { _Pragma("unroll") for (int m = 0; m < 4; ++m) _Pragma("unroll") for (int n = 0; n < 2; ++n) \
        acc[ai][bj][m][n] = __builtin_amdgcn_mfma_scale_f32_16x16x128_f8f6f4(PG8_CAT8(Bt[n][0], Bt[n][1]), PG8_CAT8(At[m][0], At[m][1]), acc[ai][bj][m][n], 0, 0, 0, 0, 0, 0); } else { \
        _Pragma("unroll") for (int m = 0; m < 4; ++m) _Pragma("unroll") for (int n = 0; n < 2; ++n) _Pragma("unroll") for (int k = 0; k < 2; ++k) \
        acc[ai][bj][m][n] = __builtin_amdgcn_mfma_f32_16x16x32_bf16(Bt[n][k], At[m][k], acc[ai][bj][m][n], 0, 0, 0); } __builtin_amdgcn_s_setprio(0); } while (0)
#define PG8_WAIT_V(n) asm volatile("s_waitcnt vmcnt(" #n ")" ::: "memory")
#define PG8_WAIT_L(n) asm volatile("s_waitcnt lgkmcnt(" #n ")" ::: "memory")
#define PG8_BAR __builtin_amdgcn_s_barrier()
#define PG8_SCHED __builtin_amdgcn_sched_barrier(0)
    Unit cur, nxt; int ui = 0;
    if (!S.next(0, cur)) return;
    f32x4 acc[2][2][4][2];
#pragma unroll
    for (int a = 0; a < 2; ++a)
#pragma unroll
        for (int b = 0; b < 2; ++b)
#pragma unroll
            for (int m = 0; m < 4; ++m)
#pragma unroll
                for (int n = 0; n < 2; ++n) acc[a][b][m][n] = (f32x4){0.f, 0.f, 0.f, 0.f};
    bf16x8 At[4][2], B0[2][2], B1[2][2];
    const char* cA = (const char*)g.A + (size_t)cur.pm * tstep; const char* cB = (const char*)g.Bt + (size_t)cur.pn * tstep;
    S.a_ready(cur);
    if constexpr (SP2) {
        PG8_STAGE(PG8_SB(0, 0), cB, voffB); PG8_STAGE(PG8_SB(0, 1), cB + hstep, voffB); PG8_STAGE(PG8_SA(0, 0), cA, voffA); PG8_STAGE(PG8_SA(0, 1), cA + hstep, voffA);
        if (wr == 1) PG8_BAR;
        PG8_WAIT_V(2); PG8_BAR;
        PG8_STAGE(PG8_SB(1, 0), cB + kstep, voffB); PG8_STAGE(PG8_SA(1, 0), cA + kstep, voffA); PG8_STAGE(PG8_SB(1, 1), cB + hstep + kstep, voffB);
        PG8_WAIT_V(6); PG8_BAR;
    } else {
        PG8_STAGE(PG8_SB(0, 0), cB, voffB); PG8_STAGE(PG8_SA(0, 0), cA, voffA); PG8_STAGE(PG8_SB(0, 1), cB + hstep, voffB); PG8_STAGE(PG8_SA(0, 1), cA + hstep, voffA);
        if (wr == 1) PG8_BAR;
        PG8_WAIT_V(4); PG8_BAR;
        PG8_STAGE(PG8_SB(1, 0), cB + kstep, voffB); PG8_STAGE(PG8_SA(1, 0), cA + kstep, voffA); PG8_STAGE(PG8_SB(1, 1), cB + hstep + kstep, voffB);
        PG8_WAIT_V(6); PG8_BAR;
    }
    for (;;) {
        const bool has_next = S.next(ui + 1, nxt);
        const char* nA = has_next ? (const char*)g.A + (size_t)nxt.pm * tstep : cA; const char* nB = has_next ? (const char*)g.Bt + (size_t)nxt.pn * tstep : cB;
        for (int t = 0; t < nt; t += 2) {
            const bool last = (t == nt - 2);
            const char* a1 = cA + (size_t)(t + 1) * kstep;
            const char* a2 = last ? nA : cA + (size_t)(t + 2) * kstep; const char* b2 = last ? nB : cB + (size_t)(t + 2) * kstep;
            const char* a3 = a2 + kstep; const char* b3 = b2 + kstep;
            if (last && has_next) S.a_ready(nxt);
            if constexpr (SP2) {
            PG8_LDB(B0, 0, 0); PG8_LDB(B1, 0, 1); PG8_SCHED; PG8_LDA(At, 0, 0); PG8_STAGE(PG8_SA(1, 1), a1 + hstep, voffA);
            PG8_WAIT_V(8); PG8_WAIT_L(0); PG8_BAR; PG8_MMA(0, 0, At, B0); PG8_MMA(0, 1, At, B1); PG8_BAR; PG8_SCHED;
            PG8_LDA(At, 0, 1); PG8_STAGE(PG8_SB(0, 0), b2, voffB); PG8_STAGE(PG8_SB(0, 1), b2 + hstep, voffB); PG8_STAGE(PG8_SA(0, 0), a2, voffA);
            PG8_WAIT_V(8); PG8_WAIT_L(0); PG8_BAR; PG8_MMA(1, 0, At, B0); PG8_MMA(1, 1, At, B1); PG8_BAR; PG8_SCHED;
            PG8_LDB(B0, 1, 0); PG8_LDB(B1, 1, 1); PG8_SCHED; PG8_LDA(At, 1, 0); PG8_STAGE(PG8_SA(0, 1), a2 + hstep, voffA);
            PG8_WAIT_V(8); PG8_WAIT_L(0); PG8_BAR; PG8_MMA(0, 0, At, B0); PG8_MMA(0, 1, At, B1); PG8_BAR; PG8_SCHED;
            PG8_LDA(At, 1, 1); PG8_STAGE(PG8_SB(1, 0), b3, voffB); PG8_STAGE(PG8_SB(1, 1), b3 + hstep, voffB); PG8_STAGE(PG8_SA(1, 0), a3, voffA);
            PG8_WAIT_V(8); PG8_WAIT_L(0); PG8_BAR; PG8_MMA(1, 0, At, B0); PG8_MMA(1, 1, At, B1); PG8_BAR; PG8_SCHED;
            } else {
            PG8_LDB(B0, 0, 0); PG8_SCHED; PG8_LDA(At, 0, 0); PG8_STAGE(PG8_SA(1, 1), a1 + hstep, voffA);
            PG8_WAIT_L(8); PG8_BAR; PG8_WAIT_L(0); PG8_MMA(0, 0, At, B0); PG8_BAR; PG8_SCHED;
            PG8_LDB(B1, 0, 1); PG8_STAGE(PG8_SB(0, 0), b2, voffB);
            PG8_BAR; PG8_WAIT_L(0); PG8_MMA(0, 1, At, B1); PG8_BAR;
            PG8_LDA(At, 0, 1); PG8_STAGE(PG8_SA(0, 0), a2, voffA);
            PG8_BAR; PG8_WAIT_L(0); PG8_MMA(1, 0, At, B0); PG8_BAR; PG8_SCHED;
            PG8_STAGE(PG8_SB(0, 1), b2 + hstep, voffB);
            PG8_WAIT_V(6); PG8_BAR; PG8_MMA(1, 1, At, B1); PG8_BAR;
            PG8_LDB(B0, 1, 0); PG8_SCHED; PG8_LDA(At, 1, 0); PG8_STAGE(PG8_SA(0, 1), a2 + hstep, voffA);
            PG8_WAIT_L(8); PG8_BAR; PG8_WAIT_L(0); PG8_MMA(0, 0, At, B0); PG8_BAR; PG8_SCHED;
            PG8_LDB(B1, 1, 1); PG8_STAGE(PG8_SB(1, 0), b3, voffB);
            PG8_BAR; PG8_WAIT_L(0); PG8_MMA(0, 1, At, B1); PG8_BAR;
            PG8_LDA(At, 1, 1); PG8_STAGE(PG8_SA(1, 0), a3, voffA);
            PG8_BAR; PG8_WAIT_L(0); PG8_MMA(1, 0, At, B0); PG8_BAR; PG8_SCHED;
            PG8_STAGE(PG8_SB(1, 1), b3 + hstep, voffB);
            PG8_WAIT_V(6); PG8_BAR; PG8_MMA(1, 1, At, B1); PG8_BAR;
            }
        }
        if constexpr (ALIGN_EPI) { if (wr == 0) PG8_BAR; }
        if constexpr (!Epi::AFTER_DRAIN) { E(acc, cur, wr, wc, fr, fq); S.done(cur); }
        if (!has_next) break;
#pragma unroll
        for (int a = 0; a < 2; ++a)
#pragma unroll
            for (int b = 0; b < 2; ++b)
#pragma unroll
                for (int m = 0; m < 4; ++m)
#pragma unroll
                    for (int n = 0; n < 2; ++n) acc[a][b][m][n] = (f32x4){0.f, 0.f, 0.f, 0.f};
        cur = nxt; cA = nA; cB = nB; ++ui;
        if constexpr (ALIGN_EPI) { if (wr == 1) PG8_BAR; }
    }
    PG8_WAIT_V(0);
    if constexpr (!ALIGN_EPI) { if (wr == 0) PG8_BAR; }
    PG8_BAR;
    if constexpr (Epi::AFTER_DRAIN) { E.fused(acc, cur, wr, wc, fr, fq, lds, wid, lane); S.done(cur); }
#undef PG8_SA
#undef PG8_SB
#undef PG8_STAGE
#undef PG8_LDA
#undef PG8_LDB
#undef PG8_MMA
#undef PG8_CAT8
#undef PG8_WAIT_V
#undef PG8_WAIT_L
#undef PG8_BAR
#undef PG8_SCHED
}
}

#define GAS __attribute__((address_space(1)))
#define LAS __attribute__((address_space(3)))
typedef unsigned short bf16;
typedef unsigned v4u __attribute__((ext_vector_type(4)));
typedef unsigned v2u __attribute__((ext_vector_type(2)));
typedef float f32x4 __attribute__((ext_vector_type(4)));
typedef float f32x16 __attribute__((ext_vector_type(16)));
typedef short bf16x8 __attribute__((ext_vector_type(8)));
typedef short s16x4 __attribute__((ext_vector_type(4)));
typedef GAS unsigned gu32;
#define RLX_AGENT __ATOMIC_RELAXED, __HIP_MEMORY_SCOPE_AGENT
#define LDS_WAIT() asm volatile("s_waitcnt lgkmcnt(0)" ::: "memory")

#ifndef MK_NGRP
#define MK_NGRP 1
#endif
constexpr int D = 1024, NGRP = MK_NGRP, NB = 8 / NGRP, SEQ = 4096, CTXL = 256, TLAT = NB * SEQ, TCTX = NB * CTXL, TTOT = TLAT + TCTX;
constexpr int FF = 2816, NE = 8, MAXSLOT = 73728 / NGRP;
constexpr float EPS = 1e-6f;
constexpr int NWAVES = 8, NTHR = 512, GG = 256 / NGRP;
constexpr float LOG2E = 1.4426950408889634f;
constexpr float QSCALE = 0.125f * LOG2E;

enum { I_X = 0, I_C, I_CTX, I_CCTX, I_ADAW, I_ADAB, I_NMIX, I_NFFN, I_SCIN, I_SCCONV, I_SCOUT, I_DAQKV, I_DAOUT, I_DAQG, I_DAKG, I_DALAM, I_DASUB,
       I_CMIN, I_CMINB, I_CMVG, I_CMWS, I_CMBS, I_CMOUT, I_SWQKV, I_SWOUT, I_SWQG, I_SWKG, I_SWSINK, I_W1, I_W3, I_W2, I_RW, I_RB, I_MW1, I_MW3, I_MW2, N_IN };

constexpr size_t MiB = 1u << 20;
constexpr size_t WS_CTL = 0, CTL_ZERO_BYTES = 1 * MiB;
constexpr size_t WS_ZERO = 256 * 1024;
constexpr size_t WS_MOD = 1 * MiB;
constexpr size_t WS_RT = 2 * MiB;
constexpr size_t WS_WSB = 2 * MiB + 65536;
constexpr size_t WS_BIAS = 3 * MiB;
constexpr size_t BIAS_P6 = WS_BIAS, BIAS_P9 = BIAS_P6 + 9 * 5632 * 4, BIAS_P22 = BIAS_P9 + 9 * 3072 * 4, BIAS_P25 = BIAS_P22 + 9 * 5632 * 4;
constexpr size_t T_TOKG = (size_t)TTOT * 4, T_TOKS = T_TOKG + (size_t)TTOT * 8, T_SGATE = T_TOKS + (size_t)TTOT * 8, T_WGCNT = T_SGATE + (size_t)MAXSLOT * 4, T_PANEL = T_WGCNT + (size_t)GG * 32, T_END = T_PANEL + 4096;
static_assert(T_END <= 1 * MiB, "per-group token tables");
constexpr size_t WS_TOK = 4 * MiB, TOK_STRIDE = 1 * MiB;
constexpr size_t WS_SSQ = 6 * MiB, SSQ_STRIDE = (size_t)TTOT * 32 * 4;
constexpr size_t WS_HC = 11 * MiB;
constexpr size_t WS_W = 19 * MiB;
constexpr size_t W_SCIN = WS_W, W_SCOUT = W_SCIN + 6 * MiB, W_DAQKV = W_SCOUT + 2 * MiB, W_DAOUT = W_DAQKV + 6 * MiB, W_CMIN = W_DAOUT + 2 * MiB, W_CMOUT = W_CMIN + 8 * MiB,
                 W_SWQKV = W_CMOUT + 4 * MiB, W_SWOUT = W_SWQKV + 3 * MiB, W_F13 = W_SWOUT + 2 * MiB  , W_F2 = W_F13 + 22 * MiB  , W_MOE = W_F2 + 11 * MiB,
                 W_MOE_STRIDE = 132 * MiB  , W_END = W_MOE + 2 * W_MOE_STRIDE;
static_assert(W_END == 349 * MiB, "weight map");
static_assert(WS_ZERO + 512 * 1024 <= CTL_ZERO_BYTES && BIAS_P25 + 9 * 1536 * 4 <= WS_TOK && WS_SSQ + NGRP * SSQ_STRIDE <= WS_HC && WS_HC + (size_t)NGRP * TCTX * 4096 <= WS_W, "small-buffer map");
constexpr size_t WS_S = 349 * MiB, S_STRIDE = (size_t)MAXSLOT * 1024 * 2;
constexpr size_t WS_H = WS_S + NGRP * S_STRIDE, H_STRIDE = (size_t)MAXSLOT * 2816 * 2;
constexpr size_t A_IN_H = (size_t)TTOT * 4096 * 2;
constexpr size_t WS_END = WS_H + NGRP * H_STRIDE;
static_assert(WS_END == 889 * MiB && (size_t)TTOT * 4096 * 2 <= A_IN_H && A_IN_H + (size_t)TTOT * 1024 * 2 <= H_STRIDE && (size_t)TTOT * 2048 * 2 <= S_STRIDE, "ws map");

constexpr int CW_BAR = 4096;
constexpr int CW_FLAG_DENSE = 64, CW_FLAG_MOE = 128;

constexpr int RING_BYTES = 131072;
constexpr int PERS_OFF = RING_BYTES;
constexpr int MISC_OFF = PERS_OFF + 4096;
constexpr int LDS_BYTES = 147456;

__device__ __forceinline__ unsigned f2bf(float f) { unsigned u = __builtin_bit_cast(unsigned, f); return (u + 0x7fffu + ((u >> 16) & 1u)) >> 16; }
__device__ __forceinline__ unsigned pk2(float lo, float hi) { unsigned r; asm volatile("v_cvt_pk_bf16_f32 %0, %1, %2" : "=v"(r) : "v"(lo), "v"(hi)); return r; }
__device__ __forceinline__ float bflo(unsigned u) { return __builtin_bit_cast(float, u << 16); }
__device__ __forceinline__ float bfhi(unsigned u) { return __builtin_bit_cast(float, u & 0xffff0000u); }
constexpr int HPITCH = 2048;
__device__ __forceinline__ float wave_sum(float v) {
#pragma unroll
    for (int o = 1; o < 64; o <<= 1) v += __shfl_xor(v, o);
    return v;
}
#define XB_TMO      128
#define XB_XCNT(j)  (256  + 64 * (j))
#define XB_XSUB(j)  (1280 + 64 * (j))
#define XB_XGEN(j)  (2304 + 64 * (j))
#define XB_TOP      3328
#define XB_TOPGEN   3392
#define XCD_BAR_WORDS 3456
#define XB_SPIN_CAP (1u << 18)

__device__ __forceinline__ unsigned xb_ld(unsigned* p)              { return __hip_atomic_load(p, __ATOMIC_RELAXED, __HIP_MEMORY_SCOPE_AGENT); }
__device__ __forceinline__ unsigned xb_add(unsigned* p, unsigned v) { return __hip_atomic_fetch_add(p, v, __ATOMIC_RELAXED, __HIP_MEMORY_SCOPE_AGENT); }
__device__ __forceinline__ unsigned xb_xcc_id() { return (unsigned)__builtin_amdgcn_s_getreg((3 << 11) | 20) & 0xFu; }
#define XB_SPIN(cond, bar) do { unsigned _sp = 0; while (cond) { __builtin_amdgcn_s_sleep(1); \
    if ((++_sp & 255u) == 0u) { if (xb_ld(&(bar)[XB_TMO])) break; if (_sp > XB_SPIN_CAP) { atomicAdd(&(bar)[XB_TMO], 1u); break; } } } } while (0)

struct XcdBarrier {
    unsigned* bar; unsigned x; unsigned gsz;
    volatile LAS unsigned* st;
};

__device__ __forceinline__ XcdBarrier xcd_barrier_post(unsigned* bar, volatile LAS unsigned* st, unsigned gsz) {
    XcdBarrier b; b.bar = bar; b.x = xb_xcc_id(); b.st = st; b.gsz = gsz;
    if (threadIdx.x == 0) (void)xb_add(&bar[XB_XCNT(b.x)], 1u);
    return b;
}
__device__ __forceinline__ void xcd_barrier_complete(unsigned* bar, unsigned x, unsigned& nloc, unsigned& nx, unsigned G) {
    unsigned sum, cnt, mine, sp = 0u;
    for (;;) {
        sum = 0u; cnt = 0u; mine = 0u;
#pragma unroll
        for (unsigned j = 0; j < 16; ++j) { const unsigned c = xb_ld(&bar[XB_XCNT(j)]); sum += c; cnt += (c > 0u) ? 1u : 0u; mine = (j == x) ? c : mine; }
        if (sum == G) break;
        __builtin_amdgcn_s_sleep(1);
        if ((++sp & 255u) == 0u) { if (xb_ld(&bar[XB_TMO])) break; if (sp > XB_SPIN_CAP) { atomicAdd(&bar[XB_TMO], 1u); break; } }
    }
    nloc = mine > 0u ? mine : 1u; nx = cnt > 0u ? cnt : 1u;
}

__device__ __forceinline__ void xcd_barrier(const XcdBarrier& b) {
    asm volatile("s_waitcnt vmcnt(0)" ::: "memory");
    __syncthreads();
    if (threadIdx.x == 0) {
        unsigned* bar = b.bar;
        __builtin_amdgcn_s_waitcnt(0);
        unsigned nloc = b.st[0], nx = b.st[1];
        if (nloc == 0u) { xcd_barrier_complete(bar, b.x, nloc, nx, b.gsz); b.st[0] = nloc; b.st[1] = nx; }
        const unsigned old = xb_add(&bar[XB_XSUB(b.x)], 1u);
        const unsigned gen = old / nloc;
        if (old + 1u == (gen + 1u) * nloc) {
            __builtin_amdgcn_fence(__ATOMIC_RELEASE, "agent");
            asm volatile("s_waitcnt vmcnt(0)" ::: "memory");
            const unsigned og = xb_add(&bar[XB_TOP], 1u);
            const unsigned tg = og / nx;
            if (og + 1u == (tg + 1u) * nx) xb_add(&bar[XB_TOPGEN], 1u);
            else XB_SPIN(xb_ld(&bar[XB_TOPGEN]) == tg, bar);
            __builtin_amdgcn_fence(__ATOMIC_ACQUIRE, "agent");
            xb_add(&bar[XB_XGEN(b.x)], 1u);
            asm volatile("s_waitcnt vmcnt(0)" ::: "memory");
        } else {
            XB_SPIN(xb_ld(&bar[XB_XGEN(b.x)]) == gen, bar);
            __builtin_amdgcn_fence(__ATOMIC_ACQUIRE, "agent");
            asm volatile("s_waitcnt vmcnt(0)" ::: "memory");
        }
    }
    __syncthreads();
}

struct Args { const float* in[N_IN]; float* out; unsigned char* ws; int ph_lo, ph_hi; };
struct Grp {
    const float* x; const float* ctx; float* out; float* hc; bf16* A; bf16* S; bf16* H;
    int* toke; float* tokg; int* toks; float* sgate; int* wgcnt; int* panel; float* ssq; int b0;
};

template <bool RP = false> __device__ __forceinline__ void transpose_item(const float* __restrict__ W, int K, int N, bf16* WT, int k0, int n0, int drow0, LAS float* scr, int lane) {
    { f32x4 v[8]; const int r8 = lane >> 3, c4 = lane & 7;
#pragma unroll
      for (int i = 0; i < 8; ++i) v[i] = *(const f32x4*)(W + (size_t)(k0 + 8 * i + r8) * N + n0 + 4 * c4);
#pragma unroll
      for (int i = 0; i < 8; ++i) { LAS float* d = scr + (8 * i + r8) * 33 + 4 * c4; d[0] = v[i].x; d[1] = v[i].y; d[2] = v[i].z; d[3] = v[i].w; } }
    LDS_WAIT(); asm volatile("" ::: "memory");
    const int c = lane & 7;
#pragma unroll
    for (int j = 0; j < 4; ++j) { const int n = (lane >> 3) + 8 * j; const LAS float* s = scr + (8 * c) * 33 + n;
        v4u o; o.x = f2bf(s[0 * 33]) | (f2bf(s[1 * 33]) << 16); o.y = f2bf(s[2 * 33]) | (f2bf(s[3 * 33]) << 16); o.z = f2bf(s[4 * 33]) | (f2bf(s[5 * 33]) << 16); o.w = f2bf(s[6 * 33]) | (f2bf(s[7 * 33]) << 16);
        const int dn = RP ? (8 * ((n & 15) >> 2) + 4 * (n >> 4) + (n & 3)) : n;
        *(GAS v4u*)(WT + (size_t)(drow0 + dn) * K + k0 + 8 * c) = o; }
    LDS_WAIT(); asm volatile("" ::: "memory");
}
__device__ __forceinline__ void transpose_item8(const float* __restrict__ W, int K, int N, unsigned char* WT8, int k0, int n0, int drow0, float sc, LAS float* scr, int lane) {
    { f32x4 v[8]; const int r8 = lane >> 3, c4 = lane & 7;
#pragma unroll
      for (int i = 0; i < 8; ++i) v[i] = *(const f32x4*)(W + (size_t)(k0 + 8 * i + r8) * N + n0 + 4 * c4);
#pragma unroll
      for (int i = 0; i < 8; ++i) { LAS float* d = scr + (8 * i + r8) * 33 + 4 * c4; d[0] = v[i].x; d[1] = v[i].y; d[2] = v[i].z; d[3] = v[i].w; } }
    LDS_WAIT(); asm volatile("" ::: "memory");
    const int c = lane & 7;
#pragma unroll
    for (int j = 0; j < 4; ++j) { const int n = (lane >> 3) + 8 * j; const LAS float* s = scr + (8 * c) * 33 + n;
        v2u o; o.x = pg8::cvt_pk_fp8x4(s[0 * 33] * sc, s[1 * 33] * sc, s[2 * 33] * sc, s[3 * 33] * sc); o.y = pg8::cvt_pk_fp8x4(s[4 * 33] * sc, s[5 * 33] * sc, s[6 * 33] * sc, s[7 * 33] * sc);
        *(GAS v2u*)(WT8 + (size_t)(drow0 + n) * K + k0 + 8 * c) = o; }
    LDS_WAIT(); asm volatile("" ::: "memory");
}
template <int MODE> __device__ __forceinline__ void conv_item8(const float* W, int K, int N, unsigned char* WT8, int r, float sc, LAS float* scr, int lane) {
    const int nblk = N / 32, kb = r / nblk, nb = r % nblk, n0 = nb * 32;
    const int drow = (MODE == 0) ? n0 : ((n0 >> 7) * 256 + (n0 & 127) + (MODE == 2 ? 128 : 0));
    transpose_item8(W, K, N, WT8, kb * 64, n0, drow, sc, scr, lane);
}
template <int MODE> __device__ __forceinline__ void conv_item(const float* W, int K, int N, bf16* WT, int r, LAS float* scr, int lane, int nqk = 0) {
    const int nblk = N / 32, kb = r / nblk, nb = r % nblk, n0 = nb * 32;
    int drow = (MODE == 0) ? n0 : ((n0 >> 7) * 256 + (n0 & 127) + (MODE == 2 ? 128 : 0));
    if (MODE == 4) drow = (n0 < 1024) ? n0 : (1024 + (((n0 - 1024) & 1023) >> 7) * 256 + (n0 >= 2048 ? 128 : 0) + (n0 & 127));
    if (MODE == 3) { drow = (n0 < nqk) ? ((n0 >> 8) * 256 + ((n0 >> 5) & 1) * 128 + ((n0 >> 6) & 3) * 32) : n0;
        if (n0 < nqk) { transpose_item<true>(W, K, N, WT, kb * 64, n0, drow, scr, lane); return; } }
    transpose_item(W, K, N, WT, kb * 64, n0, drow, scr, lane);
}
constexpr bool D0_IN8 = false, D0_H8 = true;
constexpr bool D2_8 = true;
constexpr bool MOE8_L[2] = {true, true};
using pg8::F8_SA; using pg8::F8_SW13; using pg8::F8_SW2; using pg8::F8_SAU;
__device__ __forceinline__ void conv_moe(const Args& a, int f, LAS unsigned char* lds, int gw, int ngw, int wave, int lane, int it_lo = 0, int it_hi = NE * 3 * 1408) {
    LAS float* scr = (LAS float*)(lds + wave * 16384);
    constexpr int PER = 1408;
    bf16* w13 = (bf16*)(a.ws + W_MOE + (size_t)f * W_MOE_STRIDE); bf16* w2 = (bf16*)(a.ws + W_MOE + (size_t)f * W_MOE_STRIDE + 88 * MiB);
    for (int it = it_lo + gw; it < it_hi; it += ngw) {
        const int e = it / (3 * PER), rem = it % (3 * PER), which = rem / PER, r = rem % PER;
        const size_t eo = ((size_t)f * NE + e) * 1024 * 2816;
        if (MOE8_L[f]) {
            unsigned char* w13b = (unsigned char*)w13; unsigned char* w2b = (unsigned char*)w2;
            if (which == 0)      conv_item8<1>(a.in[I_MW1] + eo, 1024, 2816, w13b + (size_t)e * 5632 * 1024, r, F8_SW13, scr, lane);
            else if (which == 1) conv_item8<2>(a.in[I_MW3] + eo, 1024, 2816, w13b + (size_t)e * 5632 * 1024, r, F8_SW13, scr, lane);
            else                 conv_item8<0>(a.in[I_MW2] + eo, 2816, 1024, w2b + (size_t)e * 1024 * 2816, r, F8_SW2, scr, lane);
            continue; }
        if (which == 0)      conv_item<1>(a.in[I_MW1] + eo, 1024, 2816, w13 + (size_t)e * 5632 * 1024, r, scr, lane);
        else if (which == 1) conv_item<2>(a.in[I_MW3] + eo, 1024, 2816, w13 + (size_t)e * 5632 * 1024, r, scr, lane);
        else                 conv_item<0>(a.in[I_MW2] + eo, 2816, 1024, w2 + (size_t)e * 1024 * 2816, r, scr, lane);
    }
}
__device__ __forceinline__ void conv_dense(const Args& a, LAS unsigned char* lds, int gw, int ngw, int wave, int lane) {
    LAS float* scr = (LAS float*)(lds + wave * 16384);
    constexpr int N_SCIN = 16 * 96, N_1K = 16 * 32, N_CMIN = 16 * 128, N_CMOUT = 32 * 32, N_SWQKV = 16 * 48, N_FF = 1408;
    constexpr int TOTAL = N_SCIN + N_1K + N_SCIN + N_1K + N_CMIN + N_CMOUT + N_SWQKV + N_1K + 6 * N_FF;
    unsigned char* ws = a.ws;
    for (int it = gw; it < TOTAL; it += ngw) {
        int r = it;
        if (r < N_SCIN) { conv_item<4>(a.in[I_SCIN], 1024, 3072, (bf16*)(ws + W_SCIN), r, scr, lane); continue; } r -= N_SCIN;
        if (r < N_1K) { conv_item<0>(a.in[I_SCOUT], 1024, 1024, (bf16*)(ws + W_SCOUT), r, scr, lane); continue; } r -= N_1K;
        if (r < N_SCIN) { conv_item<3>(a.in[I_DAQKV], 1024, 3072, (bf16*)(ws + W_DAQKV), r, scr, lane, 2048); continue; } r -= N_SCIN;
        if (r < N_1K) { conv_item<0>(a.in[I_DAOUT], 1024, 1024, (bf16*)(ws + W_DAOUT), r, scr, lane); continue; } r -= N_1K;
        if (r < N_CMIN) { conv_item<0>(a.in[I_CMIN], 1024, 4096, (bf16*)(ws + W_CMIN), r, scr, lane); continue; } r -= N_CMIN;
        if (r < N_CMOUT) { conv_item<0>(a.in[I_CMOUT], 2048, 1024, (bf16*)(ws + W_CMOUT), r, scr, lane); continue; } r -= N_CMOUT;
        if (r < N_SWQKV) { conv_item<3>(a.in[I_SWQKV], 1024, 1536, (bf16*)(ws + W_SWQKV), r, scr, lane, 1280); continue; } r -= N_SWQKV;
        if (r < N_1K) { conv_item<0>(a.in[I_SWOUT], 1024, 1024, (bf16*)(ws + W_SWOUT), r, scr, lane); continue; } r -= N_1K;
        const int f = r / (3 * N_FF), rem = r % (3 * N_FF), which = rem / N_FF, rr = rem % N_FF; const size_t fo = (size_t)f * 1024 * 2816;
        if ((which < 2) ? (f == 0 ? D0_IN8 : D2_8) : (f == 0 ? D0_H8 : D2_8)) {
            unsigned char* w13b = ws + W_F13 + (size_t)f * 5632 * 1024 * 2; unsigned char* w2b = ws + W_F2 + (size_t)f * 1024 * 2816 * 2;
            if (which == 0)      conv_item8<1>(a.in[I_W1] + fo, 1024, 2816, w13b, rr, F8_SW13, scr, lane);
            else if (which == 1) conv_item8<2>(a.in[I_W3] + fo, 1024, 2816, w13b, rr, F8_SW13, scr, lane);
            else                 conv_item8<0>(a.in[I_W2] + fo, 2816, 1024, w2b, rr, F8_SW2, scr, lane);
            continue; }
        if (which == 0)      conv_item<1>(a.in[I_W1] + fo, 1024, 2816, (bf16*)(ws + W_F13) + (size_t)f * 5632 * 1024, rr, scr, lane);
        else if (which == 1) conv_item<2>(a.in[I_W3] + fo, 1024, 2816, (bf16*)(ws + W_F13) + (size_t)f * 5632 * 1024, rr, scr, lane);
        else                 conv_item<0>(a.in[I_W2] + fo, 2816, 1024, (bf16*)(ws + W_F2) + (size_t)f * 1024 * 2816, rr, scr, lane);
    }
}
__device__ __forceinline__ void adaln_phase(const Args& a, LAS unsigned char* lds, int vcu, int G, int tid) {
    LAS float* sl = (LAS float*)lds;
    LAS float* red = sl + 9 * 1024;
    for (int i = tid; i < 9 * 1024; i += NTHR) { const float cv = (i < 8192) ? a.in[I_C][i] : a.in[I_CCTX][i - 8192]; sl[i] = cv / (1.0f + __expf(-cv)); }
    __syncthreads();
    float* MOD = (float*)(a.ws + WS_MOD);
    const int c4 = tid & 63, kg = tid >> 6;
    for (int u = vcu; u < 4 * 24; u += G) {
        const int l = u / 24, n0 = (u % 24) * 256;
        const float* w = a.in[I_ADAW] + (size_t)l * 1024 * 6144 + n0 + 4 * c4;
        f32x4 acc[9];
#pragma unroll
        for (int ci = 0; ci < 9; ++ci) acc[ci] = (f32x4){0.f, 0.f, 0.f, 0.f};
#pragma unroll 1
        for (int k0 = kg * 128; k0 < kg * 128 + 128; k0 += 8) { f32x4 wv[8];
#pragma unroll
            for (int j = 0; j < 8; ++j) wv[j] = *(const f32x4*)(w + (size_t)(k0 + j) * 6144);
#pragma unroll
            for (int j = 0; j < 8; ++j)
#pragma unroll
                for (int ci = 0; ci < 9; ++ci) acc[ci] += wv[j] * sl[ci * 1024 + k0 + j]; }
#pragma unroll
        for (int ci = 0; ci < 9; ++ci) *(LAS f32x4*)(red + (kg * 9 + ci) * 256 + 4 * c4) = acc[ci];
        __syncthreads();
        for (int o = tid; o < 9 * 256; o += NTHR) { const int ci = o >> 8, cc = o & 255; float s = a.in[I_ADAB][l * 6144 + n0 + cc];
#pragma unroll
            for (int k2 = 0; k2 < 8; ++k2) s += red[(k2 * 9 + ci) * 256 + cc];
            MOD[(size_t)(l * 9 + ci) * 6144 + n0 + cc] = s; }
        __syncthreads();
    }
}
__device__ __forceinline__ void rope_table(const Args& a, int tid) {
    float* RT = (float*)(a.ws + WS_RT);
    for (int i = tid; i < 1024; i += NTHR) {
        const int p = i >> 4, f = i & 15;
        double inv = 1.0; for (int j = 0; j < f; ++j) inv *= 0.56234132519034908;
        const float ang = (float)p * (float)inv;
        const double x = (double)ang;
        const double kq = __builtin_rint(x * 0.63661977236758134);
        const double r = (x - kq * 1.5707963267948966) - kq * 6.123233995736766e-17;
        const double r2 = r * r;
        double sn = 1.0, cs = 1.0;
        sn = 1.0 - r2 / (18.0 * 19.0) * sn; sn = 1.0 - r2 / (16.0 * 17.0) * sn; sn = 1.0 - r2 / (14.0 * 15.0) * sn; sn = 1.0 - r2 / (12.0 * 13.0) * sn; sn = 1.0 - r2 / (10.0 * 11.0) * sn;
        sn = 1.0 - r2 / (8.0 * 9.0) * sn; sn = 1.0 - r2 / (6.0 * 7.0) * sn; sn = 1.0 - r2 / (4.0 * 5.0) * sn; sn = 1.0 - r2 / (2.0 * 3.0) * sn; sn *= r;
        cs = 1.0 - r2 / (17.0 * 18.0) * cs; cs = 1.0 - r2 / (15.0 * 16.0) * cs; cs = 1.0 - r2 / (13.0 * 14.0) * cs; cs = 1.0 - r2 / (11.0 * 12.0) * cs; cs = 1.0 - r2 / (9.0 * 10.0) * cs;
        cs = 1.0 - r2 / (7.0 * 8.0) * cs; cs = 1.0 - r2 / (5.0 * 6.0) * cs; cs = 1.0 - r2 / (3.0 * 4.0) * cs; cs = 1.0 - r2 / (1.0 * 2.0) * cs;
        const int q = ((int)kq) & 3;
        const double c = (q == 0) ? cs : (q == 1) ? -sn : (q == 2) ? -cs : sn;
        const double s = (q == 0) ? sn : (q == 1) ? cs : (q == 2) ? -sn : -cs;
        RT[2 * i] = (float)c; RT[2 * i + 1] = (float)s;
    }
}

__device__ __forceinline__ void bias_rows(const bf16* Wt, int N, const float* sh  , float* B, int first, int gw, int ngw, int lane) {
    for (int n = gw - first; n < N; n += ngw) { if (n < 0) continue;
        const v4u w0 = ((const v4u*)(Wt + (size_t)n * 1024))[lane], w1 = ((const v4u*)(Wt + (size_t)n * 1024))[lane + 64];
        const float wf[16] = {bflo(w0.x), bfhi(w0.x), bflo(w0.y), bfhi(w0.y), bflo(w0.z), bfhi(w0.z), bflo(w0.w), bfhi(w0.w), bflo(w1.x), bfhi(w1.x), bflo(w1.y), bfhi(w1.y), bflo(w1.z), bfhi(w1.z), bflo(w1.w), bfhi(w1.w)};
#pragma unroll 1
        for (int ci = 0; ci < 9; ++ci) { const f32x4* sp = (const f32x4*)(sh + (size_t)ci * 6144); const f32x4 a = sp[2 * lane], b = sp[2 * lane + 1], c = sp[128 + 2 * lane], d = sp[128 + 2 * lane + 1];
            float t = (a.x * wf[0] + a.y * wf[1]) + (a.z * wf[2] + a.w * wf[3]) + (b.x * wf[4] + b.y * wf[5]) + (b.z * wf[6] + b.w * wf[7]) + (c.x * wf[8] + c.y * wf[9]) + (c.z * wf[10] + c.w * wf[11]) + (d.x * wf[12] + d.y * wf[13]) + (d.z * wf[14] + d.w * wf[15]);
            t = wave_sum(t); if (lane == 0) B[(size_t)ci * N + n] = t; }
    }
}
__device__ __forceinline__ void bias_rows8(const unsigned char* Wt8, int N, float winv, const float* sh, float* B, int gw, int ngw, int lane) {
    typedef float f32x2_ __attribute__((ext_vector_type(2)));
    for (int n = gw; n < N; n += ngw) {
        const v4u w = ((const v4u*)(Wt8 + (size_t)n * 1024))[lane];
        float wf[16];
#pragma unroll
        for (int q = 0; q < 4; ++q) { const int wd = (int)(q == 0 ? w.x : q == 1 ? w.y : q == 2 ? w.z : w.w);
            const f32x2_ lo = __builtin_amdgcn_cvt_pk_f32_fp8(wd, false), hi = __builtin_amdgcn_cvt_pk_f32_fp8(wd, true); wf[4 * q] = lo.x; wf[4 * q + 1] = lo.y; wf[4 * q + 2] = hi.x; wf[4 * q + 3] = hi.y; }
#pragma unroll 1
        for (int ci = 0; ci < 9; ++ci) { const f32x4* sp = (const f32x4*)(sh + (size_t)ci * 6144); const f32x4 a = sp[4 * lane], b = sp[4 * lane + 1], c = sp[4 * lane + 2], d = sp[4 * lane + 3];
            float t = (a.x * wf[0] + a.y * wf[1]) + (a.z * wf[2] + a.w * wf[3]) + (b.x * wf[4] + b.y * wf[5]) + (b.z * wf[6] + b.w * wf[7]) + (c.x * wf[8] + c.y * wf[9]) + (c.z * wf[10] + c.w * wf[11]) + (d.x * wf[12] + d.y * wf[13]) + (d.z * wf[14] + d.w * wf[15]);
            t = wave_sum(t); if (lane == 0) B[(size_t)ci * N + n] = t * winv; }
    }
}
__device__ __forceinline__ void bias_phase(const Args& a, int gw, int ngw, int lane) {
    const float* MOD = (const float*)(a.ws + WS_MOD);
    if (D0_IN8) bias_rows8(a.ws + W_F13, 5632, 1.0f / F8_SW13, MOD + 0 * 9 * 6144 + 3072, (float*)(a.ws + BIAS_P6), gw, ngw, lane);
    else bias_rows((const bf16*)(a.ws + W_F13), 5632, MOD + 0 * 9 * 6144 + 3072, (float*)(a.ws + BIAS_P6), 0, gw, ngw, lane);
    bias_rows((const bf16*)(a.ws + W_DAQKV), 3072, MOD + 1 * 9 * 6144 + 0, (float*)(a.ws + BIAS_P9), 0, gw, ngw, lane);
    if (D2_8) bias_rows8(a.ws + W_F13 + (size_t)5632 * 1024 * 2, 5632, 1.0f / F8_SW13, MOD + 2 * 9 * 6144 + 3072, (float*)(a.ws + BIAS_P22), gw, ngw, lane);
    else bias_rows((const bf16*)(a.ws + W_F13) + (size_t)5632 * 1024, 5632, MOD + 2 * 9 * 6144 + 3072, (float*)(a.ws + BIAS_P22), 0, gw, ngw, lane);
    bias_rows((const bf16*)(a.ws + W_SWQKV), 1536, MOD + 3 * 9 * 6144 + 0, (float*)(a.ws + BIAS_P25), 0, gw, ngw, lane);
}

template <bool COMBINE, bool NORM, bool ROUTER, bool SRC32, bool OUT32, bool A8 = false>
__device__ __forceinline__ void row_phase(const Args& a, const Grp& c, LAS unsigned char* lds, const void* src_lat, const void* src_ctx, void* dst_lat, void* dst_ctx, int nrows,
                                          const float* gn, const float* mod  , int sh_off  , const float* mod_prev_g2  ,
                                          const float* rw, const float* rb, int vcu, int G, int tid, int wave, int lane) {
    LAS float* wrT = (LAS float*)lds;
    LAS int* hist = (LAS int*)(lds + 32768);
    if (ROUTER) {
        for (int i = tid; i < 8192; i += NTHR) { const int k = i >> 3, e = i & 7; wrT[e * 1024 + k] = rw[i]; }
        if (tid < 8) hist[tid] = 0;
        __syncthreads();
    }
    bf16* A = c.A;
    const bf16* Y = c.S;
    const int* toks = c.toks;
    int* toke = c.toke; float* tokg = c.tokg;
    f32x4 gv[4];
    if (NORM) {
#pragma unroll
        for (int j = 0; j < 4; ++j) gv[j] = ((const f32x4*)gn)[lane + 64 * j];
    }
    const int gw = vcu * NWAVES + wave, ngw = G * NWAVES;
    struct RowRegs { f32x4 v[4]; v2u hraw[4]; v2u q0[4], q1[4]; };
    auto ld = [&](const int m, RowRegs& r) __attribute__((always_inline)) {
        const bool lat = m < TLAT;
        if (SRC32) { const float* hr = lat ? (const float*)src_lat + (size_t)m * 1024 : (const float*)src_ctx + (size_t)(m - TLAT) * 1024;
#pragma unroll
            for (int j = 0; j < 4; ++j) r.v[j] = ((const f32x4*)hr)[lane + 64 * j];
        } else { const bf16* hr = lat ? (const bf16*)src_lat + (size_t)m * HPITCH : (const bf16*)src_ctx + (size_t)(m - TLAT) * HPITCH;
#pragma unroll
            for (int j = 0; j < 4; ++j) r.hraw[j] = ((const v2u*)hr)[lane + 64 * j];
        }
        if (COMBINE) {
            const int s0 = toks[2 * m], s1 = toks[2 * m + 1];
            const v2u* y0 = (const v2u*)(Y + (size_t)s0 * 1024); const v2u* y1 = (const v2u*)(Y + (size_t)s1 * 1024);
#pragma unroll
            for (int j = 0; j < 4; ++j) { r.q0[j] = y0[lane + 64 * j]; r.q1[j] = y1[lane + 64 * j]; }
        }
    };
    auto body = [&](const int m, RowRegs& r) __attribute__((always_inline)) {
        const bool lat = m < TLAT; const int cidx = lat ? c.b0 + (m >> 12) : 8;
        f32x4 (&v)[4] = r.v;
        if (!SRC32) {
#pragma unroll
            for (int j = 0; j < 4; ++j) { const v2u p = r.hraw[j]; v[j] = f32x4{bflo(p.x), bfhi(p.x), bflo(p.y), bfhi(p.y)}; }
        }
        if (COMBINE) {
            const f32x4* g2 = (const f32x4*)(mod_prev_g2 + (size_t)cidx * 6144);
            float* hw32 = (float*)dst_lat + (size_t)m * 1024;
            bf16* hw = lat ? (bf16*)dst_lat + (size_t)m * HPITCH : (bf16*)dst_ctx + (size_t)(m - TLAT) * HPITCH;
            if (OUT32) asm volatile("" ::: "memory");
#pragma unroll
            for (int j = 0; j < 4; ++j) { const v2u p0 = r.q0[j], p1 = r.q1[j]; const f32x4 g = g2[lane + 64 * j];
                f32x4 ys; ys.x = bflo(p0.x) + bflo(p1.x); ys.y = bfhi(p0.x) + bfhi(p1.x); ys.z = bflo(p0.y) + bflo(p1.y); ys.w = bfhi(p0.y) + bfhi(p1.y);
                v[j] = v[j] + g * ys;
                if (OUT32) ((f32x4*)hw32)[lane + 64 * j] = v[j]; else { v2u o; o.x = pk2(v[j].x, v[j].y); o.y = pk2(v[j].z, v[j].w); ((v2u*)hw)[lane + 64 * j] = o; } }
        }
        if (NORM) {
            float ss = 0.f;
#pragma unroll
            for (int j = 0; j < 4; ++j) ss += (v[j].x * v[j].x + v[j].y * v[j].y) + (v[j].z * v[j].z + v[j].w * v[j].w);
            const float rstd = 1.0f / sqrtf(wave_sum(ss) * (1.0f / 1024.0f) + EPS);
            const f32x4* shp = (const f32x4*)(mod + (size_t)cidx * 6144 + sh_off); const f32x4* scp = shp + 256;
            v2u* ar = (v2u*)(A + (size_t)m * 1024);
#pragma unroll
            for (int j = 0; j < 4; ++j) { const f32x4 sh = shp[lane + 64 * j], sc = scp[lane + 64 * j];
                v[j] = (v[j] * rstd * gv[j]) * (sc + 1.0f) + sh;
                if (A8) ((unsigned*)((unsigned char*)A + (size_t)m * 1024))[lane + 64 * j] = pg8::cvt_pk_fp8x4(v[j].x * F8_SA, v[j].y * F8_SA, v[j].z * F8_SA, v[j].w * F8_SA);
                else { v2u o; o.x = pk2(v[j].x, v[j].y); o.y = pk2(v[j].z, v[j].w); ar[lane + 64 * j] = o; } }
            if (ROUTER) {
                float lg[8];
#pragma unroll
                for (int e = 0; e < 8; ++e) { float s = 0.f;
#pragma unroll
                    for (int j = 0; j < 4; ++j) { const f32x4 w = ((const LAS f32x4*)(wrT + e * 1024))[lane + 64 * j]; s += (v[j].x * w.x + v[j].y * w.y) + (v[j].z * w.z + v[j].w * w.w); }
                    lg[e] = wave_sum(s) + rb[e]; }
                int i0 = 0; float v0 = lg[0];
#pragma unroll
                for (int e = 1; e < 8; ++e) if (lg[e] > v0) { v0 = lg[e]; i0 = e; }
                int i1 = -1; float v1 = -INFINITY;
#pragma unroll
                for (int e = 0; e < 8; ++e) if (e != i0 && lg[e] > v1) { v1 = lg[e]; i1 = e; }
                const float ex = __expf(v1 - v0); const float g0 = 1.0f / (1.0f + ex), g1 = ex * g0;
                if (lane == 0) { toke[m] = i0 | (i1 << 8); tokg[2 * m] = g0; tokg[2 * m + 1] = g1; atomicAdd((int*)(hist + i0), 1); atomicAdd((int*)(hist + i1), 1); }
            }
        }
    };
    for (int m = gw; m < nrows; m += 2 * ngw) {
        RowRegs ra, rb; const int mb = m + ngw; const bool hb = mb < nrows;
        ld(m, ra); ld(hb ? mb : m, rb);
        body(m, ra); if (hb) body(mb, rb);
    }
    if (ROUTER) { __syncthreads(); if (tid < 8) c.wgcnt[vcu * 8 + tid] = hist[tid]; }
}

template <bool A8>
__device__ __forceinline__ void moe_scatter_phase(const Grp& c, LAS unsigned char* lds, int nrows, int vcu, int G, int tid, int wave, int lane) {
    LAS int* cnt = (LAS int*)lds;
    LAS int* base = cnt + 2048;
    LAS int* tot = base + 8;
    LAS int* slots = tot + 8;
    const int* wg = c.wgcnt;
    for (int i = tid; i < GG * 8; i += NTHR) cnt[i] = wg[i];
    __syncthreads();
    if (tid < 8) { int t = 0, b = 0; for (int w = 0; w < G; ++w) { const int c = cnt[w * 8 + tid]; if (w < vcu) b += c; t += c; } tot[tid] = t; base[tid] = b; }
    __syncthreads();
    if (tid == 0) { int ps = 0; int* pan = c.panel; int np = 0;
        for (int e = 0; e < 8; ++e) { const int t = tot[e]; base[e] += ps; const int npe = (t + 255) >> 8;
            if (vcu == 0) for (int p = 0; p < npe; ++p) pan[1 + np + p] = e;
            np += npe; ps += npe * 256; }
        if (vcu == 0) pan[0] = np; }
    __syncthreads();
    const int* toke = c.toke; const float* tokg = c.tokg;
    int* toks = c.toks; float* sgate = c.sgate;
    const int ntok = (nrows / (G * NWAVES)) * NWAVES;
    if (wave == 0) {
        int run[8];
#pragma unroll
        for (int e = 0; e < 8; ++e) run[e] = base[e];
        for (int p0 = 0; p0 < ntok; p0 += 64) {
            const int j = p0 + lane; const bool ok = j < ntok; const int m = (vcu * NWAVES + (j & 7)) + (G * NWAVES) * (j >> 3);
            int e0 = -1, e1 = -1; if (ok) { const int ee = toke[m]; e0 = ee & 255; e1 = ee >> 8; }
            int s0 = 0, s1 = 0;
            const unsigned long long below = (lane == 0) ? 0ull : (~0ull >> (64 - lane));
#pragma unroll
            for (int e = 0; e < 8; ++e) { const unsigned long long mk = __ballot(e0 == e || e1 == e); const int rk = __popcll(mk & below);
                if (e0 == e) s0 = run[e] + rk; if (e1 == e) s1 = run[e] + rk; run[e] += __popcll(mk); }
            if (ok) { slots[2 * j] = s0; slots[2 * j + 1] = s1; toks[2 * m] = s0; toks[2 * m + 1] = s1; sgate[s0] = tokg[2 * m]; sgate[s1] = tokg[2 * m + 1]; }
        }
    }
    __syncthreads();
    const bf16* A = c.A; bf16* S = c.S;
    constexpr int RE = A8 ? 512 : 1024;
    for (int j0 = wave; j0 < ntok; j0 += 4 * NWAVES) {
        v4u x[4][2]; int sl[4][2];
#pragma unroll
        for (int r = 0; r < 4; ++r) { const int j = j0 + r * NWAVES; if (j < ntok) { const int m = (vcu * NWAVES + (j & 7)) + (G * NWAVES) * (j >> 3);
            const v4u* src = (const v4u*)(A + (size_t)m * RE); x[r][0] = src[lane]; if (!A8) x[r][1] = src[lane + 64]; sl[r][0] = slots[2 * j]; sl[r][1] = slots[2 * j + 1]; } }
#pragma unroll
        for (int r = 0; r < 4; ++r) { const int j = j0 + r * NWAVES; if (j < ntok) {
            v4u* d0 = (v4u*)(S + (size_t)sl[r][0] * RE); v4u* d1 = (v4u*)(S + (size_t)sl[r][1] * RE);
            d0[lane] = x[r][0]; d1[lane] = x[r][0]; if (!A8) { d0[lane + 64] = x[r][1]; d1[lane + 64] = x[r][1]; } } }
    }
}

__device__ __forceinline__ void conv_phase(const Args& a, const Grp& c, int vcu, int G, int wave, int lane) {
    const bf16* U = c.H; bf16* Z = c.S;
    const float* cw = a.in[I_SCCONV];
    const int gw = vcu * NWAVES + wave, ngw = G * NWAVES;
    for (int it = gw; it < (TTOT / 16) * 2; it += ngw) {
        const int strip = it >> 1, c0 = (it & 1) * 512 + lane * 8, t0 = strip * 16;
        const int seqlen = (t0 < TLAT) ? SEQ : CTXL; const int tin = (t0 < TLAT) ? (t0 & (SEQ - 1)) : ((t0 - TLAT) & (CTXL - 1));
        float w0[8], w1[8], w2[8];
#pragma unroll
        for (int i = 0; i < 8; ++i) { w0[i] = cw[c0 + i]; w1[i] = cw[1024 + c0 + i]; w2[i] = cw[2048 + c0 + i]; }
        float yp[8], yc[8], yn[8];
        auto ld_y = [&](int t, float (&y)[8]) { const v4u yv = *(const v4u*)(U + (size_t)t * 2048 + 1024 + c0);
            y[0] = bflo(yv.x); y[1] = bfhi(yv.x); y[2] = bflo(yv.y); y[3] = bfhi(yv.y); y[4] = bflo(yv.z); y[5] = bfhi(yv.z); y[6] = bflo(yv.w); y[7] = bfhi(yv.w); };
        if (tin > 0) ld_y(t0 - 1, yp); else {
#pragma unroll
            for (int i = 0; i < 8; ++i) yp[i] = 0.f; }
        ld_y(t0, yc);
#pragma unroll 4
        for (int r = 0; r < 16; ++r) {
            const int t = t0 + r;
            if (tin + r + 1 < seqlen) ld_y(t + 1, yn); else {
#pragma unroll
                for (int i = 0; i < 8; ++i) yn[i] = 0.f; }
            const v4u bg = *(const v4u*)(U + (size_t)t * 2048 + c0);
            float b[8] = {bflo(bg.x), bfhi(bg.x), bflo(bg.y), bfhi(bg.y), bflo(bg.z), bfhi(bg.z), bflo(bg.w), bfhi(bg.w)};
            float z[8];
#pragma unroll
            for (int i = 0; i < 8; ++i) z[i] = b[i] * (w0[i] * yp[i] + w1[i] * yc[i] + w2[i] * yn[i]);
            v4u o; o.x = pk2(z[0], z[1]); o.y = pk2(z[2], z[3]); o.z = pk2(z[4], z[5]); o.w = pk2(z[6], z[7]);
            *(v4u*)(Z + (size_t)t * 1024 + c0) = o;
#pragma unroll
            for (int i = 0; i < 8; ++i) { yp[i] = yc[i]; yc[i] = yn[i]; }
        }
    }
}

__device__ __forceinline__ void qknorm_phase(const Args& a, const Grp& c, int ld, int nq, int nk, const float* qg, const float* kg, int vcu, int G, int wave, int lane) {
    bf16* QKV = c.H; const float* RT = (const float*)(a.ws + WS_RT);
    const int j8 = lane & 7;
    const int fb = 8 * (j8 & 1); const bool second = (j8 >> 1) & 1; const bool usecol = j8 >= 4;
    float gq[8], gk[8];
#pragma unroll
    for (int i = 0; i < 8; ++i) { gq[i] = qg[8 * j8 + i] * QSCALE; gk[i] = kg[8 * j8 + i]; }
    const int nch = (nq + nk) * 8;
    const int gw = vcu * NWAVES + wave, ngw = G * NWAVES;
    for (int m = gw; m < TTOT; m += ngw) {
        const bool lat = m < TLAT; const int s = m & (SEQ - 1); const int pos = usecol ? (s & 63) : (s >> 6);
        bf16* rowp = QKV + (size_t)m * ld;
        v4u raw[4];
#pragma unroll
        for (int k = 0; k < 4; ++k) { const int ch = lane + 64 * k; if (ch < nch) raw[k] = *(const v4u*)(rowp + ch * 8); }
        float cs[8], sn[8];
        if (lat) {
#pragma unroll
            for (int i = 0; i < 8; ++i) { const float2 t = *(const float2*)(RT + 2 * (pos * 16 + fb + i)); cs[i] = t.x; sn[i] = t.y; }
        }
#pragma unroll
        for (int k = 0; k < 4; ++k) { const int ch = lane + 64 * k;
            if (ch < nch) {
                const bool isq = (ch >> 3) < nq;
                float x[8] = {bflo(raw[k].x), bfhi(raw[k].x), bflo(raw[k].y), bfhi(raw[k].y), bflo(raw[k].z), bfhi(raw[k].z), bflo(raw[k].w), bfhi(raw[k].w)};
                float ss = 0.f;
#pragma unroll
                for (int i = 0; i < 8; ++i) ss += x[i] * x[i];
                ss += __shfl_xor(ss, 1); ss += __shfl_xor(ss, 2); ss += __shfl_xor(ss, 4);
                const float rstd = 1.0f / sqrtf(ss * (1.0f / 64.0f) + EPS);
#pragma unroll
                for (int i = 0; i < 8; ++i) x[i] = x[i] * rstd * (isq ? gq[i] : gk[i]);
                if (lat) {
#pragma unroll
                    for (int i = 0; i < 8; ++i) { const float o = __shfl_xor(x[i], 2); x[i] = second ? (o * sn[i] + x[i] * cs[i]) : (x[i] * cs[i] - o * sn[i]); }
                }
                v4u w; w.x = pk2(x[0], x[1]); w.y = pk2(x[2], x[3]); w.z = pk2(x[4], x[5]); w.w = pk2(x[6], x[7]);
                *(v4u*)(rowp + ch * 8) = w; } }
    }
}
constexpr int KP = 144;
__device__ __forceinline__ s16x4 vtr(const LAS unsigned char* p) { typedef short v4i16_t __attribute__((ext_vector_type(4)));
    return __builtin_bit_cast(s16x4, __builtin_amdgcn_ds_read_tr16_b64_v4i16((LAS v4i16_t*)p)); }
__device__ __forceinline__ int crow(int r, int hi) { return (r & 3) + 8 * (r >> 2) + 4 * hi; }

template <bool MASK>
__device__ __forceinline__ void attn_qk(const LAS unsigned char* Kb, const bf16x8 (&qr)[4], float nb2, float& lsum, v4u (&pw)[4], int lane, int kpos0, int qpos) {
    const int r32 = lane & 31, hi = lane >> 5;
    const LAS unsigned char* kp = Kb + r32 * KP + hi * 16;
    float acc = 0.f;
#pragma unroll
    for (int h = 0; h < 2; ++h) {
        f32x16 sc;
#pragma unroll
        for (int r = 0; r < 16; ++r) sc[r] = nb2;
#pragma unroll
        for (int d0 = 0; d0 < 4; ++d0) { const bf16x8 a0 = *(const LAS bf16x8*)(kp + h * 32 * KP + d0 * 32); sc = __builtin_amdgcn_mfma_f32_32x32x16_bf16(a0, qr[d0], sc, 0, 0, 0); }
#pragma unroll
        for (int r = 0; r < 16; ++r) { float p = __builtin_amdgcn_exp2f(sc[r]);
            if (MASK) { const int dd = kpos0 + 32 * h + crow(r, hi) - qpos; if (dd < -128 || dd > 128) p = 0.f; }
            sc[r] = p; acc += p; }
#pragma unroll
        for (int i = 0; i < 4; ++i) { pw[2 * h][i] = pk2(sc[2 * i], sc[2 * i + 1]); pw[2 * h + 1][i] = pk2(sc[8 + 2 * i], sc[8 + 2 * i + 1]); }
        asm volatile("" :: "v"(pw[2 * h]), "v"(pw[2 * h + 1]));
    }
    lsum += acc;
}
template <int NDV, int VP>
__device__ __forceinline__ void attn_pv(const LAS unsigned char* Vb, const v4u (&pw)[4], f32x16 (&o)[NDV], int lane) {
    const int hi = lane >> 5, i16 = lane & 15, rh = (lane >> 4) & 1;
    const LAS unsigned char* vp = Vb + (4 * hi + (i16 >> 2)) * VP + rh * 32 + (i16 & 3) * 8;
#pragma unroll
    for (int t = 0; t < NDV; ++t)
#pragma unroll
        for (int ks = 0; ks < 4; ++ks) {
            const s16x4 lo = vtr(vp + (16 * ks) * VP + t * 64), hh = vtr(vp + (16 * ks + 8) * VP + t * 64);
            const bf16x8 vf = (bf16x8){lo[0], lo[1], lo[2], lo[3], hh[0], hh[1], hh[2], hh[3]};
            o[t] = __builtin_amdgcn_mfma_f32_32x32x16_bf16(vf, __builtin_bit_cast(bf16x8, pw[ks]), o[t], 0, 0, 0);
        }
}
template <int NDV  , int VP, bool MASK>
__device__ __forceinline__ void attn_tile(const LAS unsigned char* Kb, const LAS unsigned char* Vb, const bf16x8 (&qr)[4], float nb2, f32x16 (&o)[NDV], float& lsum, int lane, int kpos0, int qpos) {
    const int r32 = lane & 31, hi = lane >> 5;
    f32x16 s0, s1;
#pragma unroll
    for (int r = 0; r < 16; ++r) { s0[r] = nb2; s1[r] = nb2; }
    const LAS unsigned char* kp = Kb + r32 * KP + hi * 16;
#pragma unroll
    for (int d0 = 0; d0 < 4; ++d0) {
        const bf16x8 a0 = *(const LAS bf16x8*)(kp + d0 * 32), a1 = *(const LAS bf16x8*)(kp + 32 * KP + d0 * 32);
        s0 = __builtin_amdgcn_mfma_f32_32x32x16_bf16(a0, qr[d0], s0, 0, 0, 0);
        s1 = __builtin_amdgcn_mfma_f32_32x32x16_bf16(a1, qr[d0], s1, 0, 0, 0);
    }
    float acc = 0.f;
#pragma unroll
    for (int r = 0; r < 16; ++r) {
        float p0 = __builtin_amdgcn_exp2f(s0[r]), p1 = __builtin_amdgcn_exp2f(s1[r]);
        if (MASK) { const int k0 = kpos0 + crow(r, hi), k1 = k0 + 32; const int d0 = k0 - qpos, d1 = k1 - qpos;
            if (d0 < -128 || d0 > 128) p0 = 0.f; if (d1 < -128 || d1 > 128) p1 = 0.f; }
        s0[r] = p0; s1[r] = p1; acc += p0 + p1;
    }
    lsum += acc;
    v4u pw[4];
#pragma unroll
    for (int i = 0; i < 4; ++i) { pw[0][i] = pk2(s0[2 * i], s0[2 * i + 1]); pw[1][i] = pk2(s0[8 + 2 * i], s0[8 + 2 * i + 1]); pw[2][i] = pk2(s1[2 * i], s1[2 * i + 1]); pw[3][i] = pk2(s1[8 + 2 * i], s1[8 + 2 * i + 1]); }
    const int i16 = lane & 15, rh = (lane >> 4) & 1;
    const LAS unsigned char* vp = Vb + (4 * hi + (i16 >> 2)) * VP + rh * 32 + (i16 & 3) * 8;
#pragma unroll
    for (int t = 0; t < NDV; ++t)
#pragma unroll
        for (int ks = 0; ks < 4; ++ks) {
            const s16x4 lo = vtr(vp + (16 * ks) * VP + t * 64), hh = vtr(vp + (16 * ks + 8) * VP + t * 64);
            const bf16x8 vf = (bf16x8){lo[0], lo[1], lo[2], lo[3], hh[0], hh[1], hh[2], hh[3]};
            o[t] = __builtin_amdgcn_mfma_f32_32x32x16_bf16(vf, __builtin_bit_cast(bf16x8, pw[ks]), o[t], 0, 0, 0);
        }
}

__device__ __forceinline__ void diff_attn_phase(const Args& a, const Grp& c, LAS unsigned char* lds, int vcu, int G, int tid, int wave, int lane) {
    constexpr int VP = 320, KBUF = 64 * KP, VBUF = 64 * VP, BUF = KBUF + VBUF;
    const bf16* QKV = c.H; bf16* O = c.S;
    const float* lp = a.in[I_DALAM];
    float l01 = lp[lane] * lp[64 + lane], l23 = lp[128 + lane] * lp[192 + lane];
    l01 = wave_sum(l01); l23 = wave_sum(l23);
    const float lam_init = 0.8f - 0.6f * 0.7408182206817179f;
    const float lam = __expf(l01) - __expf(l23) + lam_init;
    float mq = fabsf(a.in[I_DAQG][lane]), mk = fabsf(a.in[I_DAKG][lane]);
#pragma unroll
    for (int o = 1; o < 64; o <<= 1) { mq = fmaxf(mq, __shfl_xor(mq, o)); mk = fmaxf(mk, __shfl_xor(mk, o)); }
    const float nb2 = -(8.0f * mq * mk * LOG2E * 1.001f + 0.01f);
    const float* subg = a.in[I_DASUB];
    const int r32 = lane & 31, hi = lane >> 5;
    const int krow = tid >> 3, kch = tid & 7;
    const unsigned koff = (unsigned)(krow * 6144 + kch * 16), voff = (unsigned)((tid >> 4) * 6144 + (tid & 15) * 16);
    for (int id = vcu; id < NB * 8 * 16 + NB * 8; id += G) {
        int b, h, nkt; size_t qrow0;
        if (id < NB * 8 * 16) { const int bh = id >> 4, qb = id & 15; b = bh >> 3; h = bh & 7; nkt = 68; qrow0 = (size_t)b * SEQ + qb * 256; }
        else { const int bh = id - NB * 8 * 16; b = bh >> 3; h = bh & 7; nkt = 4; qrow0 = (size_t)TLAT + b * CTXL; }
        const size_t ctx0 = (size_t)TLAT + b * CTXL, lat0 = (size_t)b * SEQ;
        const size_t qrow = qrow0 + wave * 32 + r32;
        v4u* o0l = (v4u*)((unsigned char*)c.A + (size_t)vcu * 65536 + wave * 8192) + lane;
#pragma unroll 1
        for (int map = 0; map < 2; ++map) {
            const int kh = 2 * h + map;
            bf16x8 qr[4];
#pragma unroll
            for (int d0 = 0; d0 < 4; ++d0) qr[d0] = *(const bf16x8*)(QKV + qrow * 3072 + kh * 64 + d0 * 16 + hi * 8);
            f32x16 o[4];
#pragma unroll
            for (int t = 0; t < 4; ++t)
#pragma unroll
                for (int r = 0; r < 16; ++r) o[t][r] = 0.f;
            float lsum = 0.f;
            v4u kreg, vreg0, vreg1;
            auto ld_tile = [&](int t) { const size_t r0 = (t < 4) ? ctx0 + t * 64 : lat0 + (size_t)(t - 4) * 64;
                const char* kb = (const char*)(QKV + r0 * 3072 + 1024 + kh * 64); const char* vb = (const char*)(QKV + r0 * 3072 + 2048 + h * 128);
                kreg = *(const v4u*)(kb + koff); vreg0 = *(const v4u*)(vb + voff); vreg1 = *(const v4u*)(vb + 32 * 6144 + voff); };
            auto st_tile = [&](int buf) { LAS unsigned char* base = lds + buf * BUF;
                *(LAS v4u*)(base + krow * KP + kch * 16) = kreg;
                *(LAS v4u*)(base + KBUF + (tid >> 4) * VP + (tid & 15) * 16) = vreg0;
                *(LAS v4u*)(base + KBUF + (32 + (tid >> 4)) * VP + (tid & 15) * 16) = vreg1; };
            ld_tile(0); st_tile(0); ld_tile(1); __syncthreads();
            if (wave < 4) {
                int bcur = 0;
#pragma unroll 1
                for (int t = 0; t < nkt; ++t) {
                    const int bnext = (bcur == 2) ? 0 : bcur + 1;
                    if (t + 1 < nkt) st_tile(bnext);
                    if (t + 2 < nkt) ld_tile(t + 2);
                    const LAS unsigned char* base = lds + bcur * BUF; v4u pw[4];
                    attn_qk<false>(base, qr, nb2, lsum, pw, lane, 0, 0); attn_pv<4, VP>(base + KBUF, pw, o, lane);
                    asm volatile("s_waitcnt lgkmcnt(0)\n\ts_barrier" ::: "memory");
                    bcur = bnext;
                }
            } else {
                int bcur = 0, bprev = 2; v4u pw[4];
#pragma unroll
                for (int i = 0; i < 4; ++i) pw[i] = (v4u){0u, 0u, 0u, 0u};
#pragma unroll 1
                for (int t = 0; t < nkt; ++t) {
                    const int bnext = (bcur == 2) ? 0 : bcur + 1;
                    if (t + 1 < nkt) st_tile(bnext);
                    if (t + 2 < nkt) ld_tile(t + 2);
                    if (t > 0) attn_pv<4, VP>(lds + bprev * BUF + KBUF, pw, o, lane);
                    attn_qk<false>(lds + bcur * BUF, qr, nb2, lsum, pw, lane, 0, 0);
                    asm volatile("s_waitcnt lgkmcnt(0)\n\ts_barrier" ::: "memory");
                    bprev = bcur; bcur = bnext;
                }
                attn_pv<4, VP>(lds + bprev * BUF + KBUF, pw, o, lane);
            }
            asm volatile("s_waitcnt lgkmcnt(0)\n\ts_barrier" ::: "memory");
            const float l = lsum + __shfl_xor(lsum, 32); const float inv = 1.0f / l;
            if (map == 0) {
#pragma unroll
                for (int t = 0; t < 4; ++t)
#pragma unroll
                    for (int r4 = 0; r4 < 2; ++r4) { v4u w;
#pragma unroll
                        for (int i = 0; i < 4; ++i) w[i] = pk2(o[t][8 * r4 + 2 * i] * inv, o[t][8 * r4 + 2 * i + 1] * inv);
                        o0l[(t * 2 + r4) * 64] = w; }
            } else {
                const float li = lam * inv; float ss = 0.f;
#pragma unroll
                for (int t = 0; t < 4; ++t)
#pragma unroll
                    for (int r4 = 0; r4 < 2; ++r4) { const v4u w = o0l[(t * 2 + r4) * 64];
#pragma unroll
                        for (int i = 0; i < 4; ++i) { const unsigned u = w[i]; const int r = 4 * r4 + i; const float d0 = bflo(u) - li * o[t][2 * r], d1 = bfhi(u) - li * o[t][2 * r + 1]; o[t][2 * r] = d0; o[t][2 * r + 1] = d1; ss += d0 * d0 + d1 * d1; } }
                ss += __shfl_xor(ss, 32);
                const float rs = (1.0f / sqrtf(ss * (1.0f / 128.0f) + EPS)) * (1.0f - lam_init);
                bf16* orow = O + qrow * 1024 + h * 128;
#pragma unroll
                for (int t = 0; t < 4; ++t)
#pragma unroll
                    for (int g = 0; g < 4; ++g) { const int dv = 32 * t + 8 * g + 4 * hi; const f32x4 sg = *(const f32x4*)(subg + dv);
                        v2u w; w.x = pk2(o[t][4 * g] * rs * sg.x, o[t][4 * g + 1] * rs * sg.y); w.y = pk2(o[t][4 * g + 2] * rs * sg.z, o[t][4 * g + 3] * rs * sg.w);
                        *(v2u*)(orow + dv) = w; }
            }
        }
    }
}

__device__ __forceinline__ void swa_attn_phase(const Args& a, const Grp& c, LAS unsigned char* lds, int vcu, int G, int tid, int wave, int lane) {
    constexpr int VP = 192, KBUF = 64 * KP, VBUF = 64 * VP, BUF = KBUF + VBUF;
    const bf16* QKV = c.H; bf16* O = c.S;
    float mq = fabsf(a.in[I_SWQG][lane]), mk = fabsf(a.in[I_SWKG][lane]); float ms = (lane < 16) ? a.in[I_SWSINK][lane] : -INFINITY;
#pragma unroll
    for (int o = 1; o < 64; o <<= 1) { mq = fmaxf(mq, __shfl_xor(mq, o)); mk = fmaxf(mk, __shfl_xor(mk, o)); ms = fmaxf(ms, __shfl_xor(ms, o)); }
    const float b2 = fmaxf(8.0f * mq * mk * 1.001f + 0.01f, ms) * LOG2E; const float nb2 = -b2;
    const int r32 = lane & 31, hi = lane >> 5;
    const int krow = tid >> 3, kch = tid & 7;
    for (int id = vcu; id < NB * 4 * 64; id += G) {
        const int qb = id & 63, kvh = (id >> 6) & 3, b = id >> 8;
        const int q0 = qb * 64; const int qh = kvh * 4 + (wave & 3); const int qpos = q0 + (wave >> 2) * 32 + r32;
        const size_t ctx0 = (size_t)TLAT + b * CTXL, lat0 = (size_t)b * SEQ;
        const size_t qrow = lat0 + qpos;
        int bt_lo = (128 - q0) / 64; if (bt_lo < 0) bt_lo = 0; int bt_hi = (SEQ + 128 - q0) / 64; if (bt_hi > 5) bt_hi = 5;
        const int nkt = 4 + (bt_hi - bt_lo);
        bf16x8 qr[4];
#pragma unroll
        for (int d0 = 0; d0 < 4; ++d0) qr[d0] = *(const bf16x8*)(QKV + qrow * 1536 + qh * 64 + d0 * 16 + hi * 8);
        f32x16 o[2];
#pragma unroll
        for (int t = 0; t < 2; ++t)
#pragma unroll
            for (int r = 0; r < 16; ++r) o[t][r] = 0.f;
        float lsum = 0.f;
        v4u kreg, vreg;
        auto tile_row0 = [&](int t) -> size_t { return (t < 4) ? ctx0 + t * 64 : lat0 + (size_t)(q0 - 128 + (t - 4 + bt_lo) * 64); };
        auto ld_tile = [&](int t) { const size_t r0 = tile_row0(t);
            kreg = *(const v4u*)(QKV + (r0 + krow) * 1536 + 1024 + kvh * 64 + kch * 8);
            vreg = *(const v4u*)(QKV + (r0 + krow) * 1536 + 1280 + kvh * 64 + kch * 8); };
        auto st_tile = [&](int buf) { LAS unsigned char* base = lds + buf * BUF;
            *(LAS v4u*)(base + krow * KP + kch * 16) = kreg;
            *(LAS v4u*)(base + KBUF + krow * VP + kch * 16) = vreg; };
        ld_tile(0); st_tile(0); __syncthreads();
#pragma unroll 1
        for (int t = 0; t < nkt; ++t) {
            if (t + 1 < nkt) ld_tile(t + 1);
            const LAS unsigned char* base = lds + (t & 1) * BUF;
            if (t < 4) attn_tile<2, VP, false>(base, base + KBUF, qr, nb2, o, lsum, lane, 0, 0);
            else attn_tile<2, VP, true>(base, base + KBUF, qr, nb2, o, lsum, lane, q0 - 128 + (t - 4 + bt_lo) * 64, qpos);
            if (t + 1 < nkt) st_tile((t + 1) & 1);
            __syncthreads();
        }
        const float l = lsum + __shfl_xor(lsum, 32) + __builtin_amdgcn_exp2f(a.in[I_SWSINK][qh] * LOG2E - b2); const float inv = 1.0f / l;
        bf16* orow = O + qrow * 1024 + qh * 64;
#pragma unroll
        for (int t = 0; t < 2; ++t)
#pragma unroll
            for (int g = 0; g < 4; ++g) { const int dv = 32 * t + 8 * g + 4 * hi;
                v2u w; w.x = pk2(o[t][4 * g] * inv, o[t][4 * g + 1] * inv); w.y = pk2(o[t][4 * g + 2] * inv, o[t][4 * g + 3] * inv);
                *(v2u*)(orow + dv) = w; }
    }
}

__device__ __forceinline__ void gate_phase(const Args& a, const Grp& c, LAS unsigned char* lds, int vcu, int G, int tid, int wave, int lane) {
    constexpr int WP = 272, VP = 576, TP = 528;
    LAS unsigned char* Wl = lds; LAS unsigned char* Vl = lds + 128 * WP; LAS float* rstd = (LAS float*)(lds + 128 * WP + 128 * VP); LAS float* bsl = rstd + 128;
    const bf16* Zc = c.H; bf16* Gout = c.S;
    const bf16* wsb = (const bf16*)(a.ws + WS_WSB); const float* ssq = c.ssq;
    const float* vg = a.in[I_CMVG];
    const int r32 = lane & 31, hi = lane >> 5, i16 = lane & 15, rh = (lane >> 4) & 1;
    const int q0 = tid >> 5, c8 = tid & 31;
    for (int i = tid; i < 1024; i += NTHR) bsl[i] = a.in[I_CMBS][i];
    const int NU = (TTOT / 128) * 8;
    v4u vraw[8], wraw[4]; f32x4 sq0, sq1;
    auto issue_vw = [&](int id) { const int n = id >> 3, g = id & 7; const size_t row0 = (size_t)n * 128;
        const bf16* zb = Zc + (row0 + q0) * 4096 + g * 256 + c8 * 8 + 2048;
#pragma unroll
        for (int i = 0; i < 8; ++i) vraw[i] = *(const v4u*)(zb + (size_t)i * 16 * 4096);
#pragma unroll
        for (int i = 0; i < 4; ++i) { const int ch = tid + NTHR * i, p = ch >> 4, c16 = ch & 15; wraw[i] = *(const v4u*)(wsb + ((size_t)g * 128 + p) * 128 + c16 * 8); }
        const f32x4* sp = (const f32x4*)(ssq + (row0 + (tid >> 2)) * 32 + (tid & 3) * 8); sq0 = sp[0]; sq1 = sp[1]; };
    if (vcu < NU) issue_vw(vcu);
    for (int id = vcu; id < NU; id += G) {
        const int n = id >> 3, g = id & 7; const size_t row0 = (size_t)n * 128;
        const f32x4 g0 = *(const f32x4*)(vg + g * 256 + c8 * 8), g1 = *(const f32x4*)(vg + g * 256 + c8 * 8 + 4);
        { float t = ((sq0.x + sq0.y) + (sq0.z + sq0.w)) + ((sq1.x + sq1.y) + (sq1.z + sq1.w)); t += __shfl_xor(t, 1); t += __shfl_xor(t, 2);
          if ((tid & 3) == 0) rstd[tid >> 2] = 1.0f / sqrtf(t * (1.0f / 2048.0f) + EPS); }
#pragma unroll
        for (int i = 0; i < 4; ++i) { const int ch = tid + NTHR * i, p = ch >> 4, c16 = ch & 15; *(LAS v4u*)(Wl + p * WP + c16 * 16) = wraw[i]; }
        __syncthreads();
#pragma unroll
        for (int i = 0; i < 8; ++i) { const int q = q0 + 16 * i; const float rs = rstd[q]; const v4u raw = vraw[i];
            v4u w; w.x = pk2(bflo(raw.x) * rs * g0.x, bfhi(raw.x) * rs * g0.y); w.y = pk2(bflo(raw.y) * rs * g0.z, bfhi(raw.y) * rs * g0.w);
            w.z = pk2(bflo(raw.z) * rs * g1.x, bfhi(raw.z) * rs * g1.y); w.w = pk2(bflo(raw.w) * rs * g1.z, bfhi(raw.w) * rs * g1.w);
            *(LAS v4u*)(Vl + q * VP + c8 * 16) = w; }
        __syncthreads();
        v4u uraw[8];
        { const bf16* zb = Zc + (row0 + q0) * 4096 + g * 256 + c8 * 8;
#pragma unroll
          for (int i = 0; i < 8; ++i) uraw[i] = *(const v4u*)(zb + (size_t)i * 16 * 4096); }
        if (id + G < NU) issue_vw(id + G);
        f32x16 d[4];
#pragma unroll
        for (int t = 0; t < 4; ++t)
#pragma unroll
            for (int r = 0; r < 16; ++r) d[t][r] = bsl[g * 128 + 32 * t + crow(r, hi)];
        const LAS unsigned char* vp = Vl + (8 * hi + (i16 >> 2)) * VP + (wave * 32 + rh * 16 + (i16 & 3) * 4) * 2;
        const LAS unsigned char* wp = Wl + r32 * WP + hi * 16;
#pragma unroll
        for (int ks = 0; ks < 8; ++ks) {
            const s16x4 lo = vtr(vp + (16 * ks) * VP), hh = vtr(vp + (16 * ks + 4) * VP);
            const bf16x8 bfr = (bf16x8){lo[0], lo[1], lo[2], lo[3], hh[0], hh[1], hh[2], hh[3]};
#pragma unroll
            for (int t = 0; t < 4; ++t) { const bf16x8 af = *(const LAS bf16x8*)(wp + (32 * t) * WP + ks * 32);
                d[t] = __builtin_amdgcn_mfma_f32_32x32x16_bf16(af, bfr, d[t], 0, 0, 0); }
        }
        asm volatile("s_waitcnt lgkmcnt(0)\n\ts_barrier" ::: "memory");
        { LAS bf16* T = (LAS bf16*)Vl; const int cc = wave * 32 + r32;
#pragma unroll
          for (int t = 0; t < 4; ++t)
#pragma unroll
            for (int r = 0; r < 16; ++r) { const int p = 32 * t + crow(r, hi); T[p * (TP / 2) + cc] = (bf16)f2bf(d[t][r]); } }
        asm volatile("s_waitcnt lgkmcnt(0)\n\ts_barrier" ::: "memory");
        bf16* gb = Gout + (row0 + q0) * 2048 + g * 256 + c8 * 8;
#pragma unroll
        for (int i = 0; i < 8; ++i) { const int p = q0 + 16 * i; const v4u sv = *(const LAS v4u*)(Vl + p * TP + c8 * 16); const v4u u = uraw[i];
            v4u w; w.x = pk2(bflo(u.x) * bflo(sv.x), bfhi(u.x) * bfhi(sv.x)); w.y = pk2(bflo(u.y) * bflo(sv.y), bfhi(u.y) * bfhi(sv.y));
            w.z = pk2(bflo(u.z) * bflo(sv.z), bfhi(u.z) * bfhi(sv.z)); w.w = pk2(bflo(u.w) * bflo(sv.w), bfhi(u.w) * bfhi(sv.w));
            *(v4u*)(gb + (size_t)i * 16 * 2048) = w; }
        asm volatile("s_waitcnt lgkmcnt(0)\n\ts_barrier" ::: "memory");
    }
}

constexpr int N_PHASES = 34;
__device__ __forceinline__ void wait_flag(gu32* flag) {
    if (threadIdx.x == 0) { unsigned sp = 0; while (__hip_atomic_load(flag, RLX_AGENT) == 0u) { __builtin_amdgcn_s_sleep(4); if (++sp > (1u << 22)) break; }
        __builtin_amdgcn_fence(__ATOMIC_ACQUIRE, "agent"); asm volatile("s_waitcnt vmcnt(0)" ::: "memory"); }
    __syncthreads();
}
__global__ void __launch_bounds__(NTHR, 2) mk_fwd(Args args) {
    extern __shared__ __attribute__((aligned(16))) unsigned char lds_raw[];
    LAS unsigned char* lds = (LAS unsigned char*)lds_raw;
    volatile LAS unsigned* MISC = (volatile LAS unsigned*)(lds + MISC_OFF);
#define PH_IDS int tid = threadIdx.x; asm volatile("" : "+v"(tid)); const int lane = tid & 63, wave = __builtin_amdgcn_readfirstlane(tid >> 6); const int gw = vcu * NWAVES + wave; (void)gw; (void)lane; \
        unsigned char* ws = args.ws; asm volatile("" : "+s"(ws));   \
        float* const MOD = (float*)(ws + WS_MOD); \
        Grp c; \
        c.b0 = grp * NB; \
        c.x = args.in[I_X] + (size_t)grp * TLAT * 1024; c.ctx = args.in[I_CTX] + (size_t)grp * TCTX * 1024; c.out = args.out + (size_t)grp * TLAT * 1024; c.hc = (float*)(ws + WS_HC) + (size_t)grp * TCTX * 1024; \
        c.S = (bf16*)(ws + WS_S + grp * S_STRIDE); c.H = (bf16*)(ws + WS_H + grp * H_STRIDE); c.A = (bf16*)(ws + WS_H + grp * H_STRIDE + A_IN_H); \
        { unsigned char* t = ws + WS_TOK + grp * TOK_STRIDE; c.toke = (int*)t; c.tokg = (float*)(t + T_TOKG); c.toks = (int*)(t + T_TOKS); c.sgate = (float*)(t + T_SGATE); c.wgcnt = (int*)(t + T_WGCNT); c.panel = (int*)(t + T_PANEL); } \
        c.ssq = (float*)(ws + WS_SSQ + grp * SSQ_STRIDE); \
        bf16* const HL = (bf16*)c.out; bf16* const HCX = (bf16*)c.hc; bf16* const ABUF = c.A; bf16* const SBUF = c.S; bf16* const HBUF = c.H; \
        const int b0 = c.b0; (void)MOD; (void)HL; (void)HCX; (void)ABUF; (void)SBUF; (void)HBUF; (void)b0
    const int bx = blockIdx.x; const int grp = (NGRP == 2) ? ((bx >> 2) & 1) : 0;
    const int G = GG; const int vcu = (NGRP == 2) ? ((bx & 3) * 32 + (bx >> 3)) : ((bx & 7) * 32 + (bx >> 3));
    const int oid = (NGRP == 2) ? ((bx >> 3) * 4 + (bx & 3)) : bx;
    gu32* ctl = (gu32*)(args.ws + WS_CTL);
    for (int u = threadIdx.x; u < (LDS_BYTES - PERS_OFF) / 4; u += NTHR) ((LAS unsigned*)(lds + PERS_OFF))[u] = 0u;
    __syncthreads();
    const int lo = args.ph_lo, hi = args.ph_hi;
    XcdBarrier bar = xcd_barrier_post((unsigned*)(ctl + CW_BAR) + grp * XCD_BAR_WORDS, MISC + 8, (unsigned)GG);
#ifndef PH_LO
#define PH_LO 0
#define PH_HI 99
#endif
#define IN(k) ((k) >= PH_LO && (k) < PH_HI && lo <= (k) && (k) < hi)
#define SEAM(k) do { if (IN(k) && IN((k) + 1)) xcd_barrier(bar); } while (0)
    const int ngw = G * NWAVES;
    LAS int* const ptab = (LAS int*)(lds + PERS_OFF);

    constexpr int CM_ALL = NE * 3 * 1408, CM0_A = CM_ALL * 18 / 100, CM0_B = CM_ALL * 82 / 100, CM1_A = CM_ALL * 35 / 100;
#define PG8_ER(n, s) pg8::EpiResid<n, s>
#define PG8_ER4(n, s, n8, a8) pg8::EpiResid<n, s, n8, a8>
#define GEMM_GRID8(Abuf, Wt, nM_, nN_, K_, EpiT, Eobj) do { pg8::Gemm g{(const pg8::bf16_t*)(Abuf), (const pg8::bf16_t*)(Wt), (nM_) * 256, (nN_) * 256, (K_)}; pg8::GridOrder S; S.init((nM_), (nN_), G, oid); \
        pg8::gemm_phase<EpiT, pg8::GridOrder, true, true, true>(lds, g, S, (Eobj)); } while (0)
#define GEMM_GRID(Abuf, Wt, nM_, nN_, K_, EpiT, Eobj) do { pg8::Gemm g{(const pg8::bf16_t*)(Abuf), (const pg8::bf16_t*)(Wt), (nM_) * 256, (nN_) * 256, (K_)}; pg8::GridOrder S; S.init((nM_), (nN_), G, oid); \
        pg8::gemm_phase<EpiT, pg8::GridOrder, true, true>(lds, g, S, (Eobj)); } while (0)
#define GEMM_MOE(Abuf, Wt, nNe_, K_, EpiT, Eobj) do { const int* pan = c.panel; const int np = pan[0]; \
        for (int i = tid; i < np; i += NTHR) ptab[i] = pan[1 + i]; __syncthreads(); \
        pg8::Gemm g{(const pg8::bf16_t*)(Abuf), (const pg8::bf16_t*)(Wt), np * 256, (nNe_) * 256, (K_)}; pg8::MoeOrder S; S.g.init(np, (nNe_), G, oid); S.pexp = ptab; S.nNe = (nNe_); \
        pg8::gemm_phase<EpiT, pg8::MoeOrder, true, true>(lds, g, S, (Eobj)); } while (0)
#define GEMM_MOE8(Abuf, Wt, nNe_, K_, EpiT, Eobj) do { const int* pan = c.panel; const int np = pan[0]; \
        for (int i = tid; i < np; i += NTHR) ptab[i] = pan[1 + i]; __syncthreads(); \
        pg8::Gemm g{(const pg8::bf16_t*)(Abuf), (const pg8::bf16_t*)(Wt), np * 256, (nNe_) * 256, (K_)}; pg8::MoeOrderC<(nNe_)> S; S.nM = np; S.c = oid; S.pexp = ptab; \
        pg8::gemm_phase<EpiT, pg8::MoeOrderC<(nNe_)>, true, true, true>(lds, g, S, (Eobj)); } while (0)
    constexpr int NMA = TTOT / 256, NML = TLAT / 256;

    if (IN(0)) {
        if (grp == 0) {
            { PH_IDS; adaln_phase(args, lds, vcu, G, tid);
              if (vcu == 0) rope_table(args, tid);
              { const float* w = args.in[I_CMWS]; bf16* o = (bf16*)(ws + WS_WSB); for (int i = gw * 64 + lane; i < 131072 / 4; i += ngw * 64) { const f32x4 v = ((const f32x4*)w)[i]; v2u p; p.x = pk2(v.x, v.y); p.y = pk2(v.z, v.w); ((v2u*)o)[i] = p; } }
              conv_dense(args, lds, gw, ngw, wave, lane);
            }
            xcd_barrier(bar);
            if (NGRP == 1) { PH_IDS; bias_phase(args, gw, ngw, lane); }
            else { { PH_IDS; bias_phase(args, gw, ngw, lane); } xcd_barrier(bar); }
            if (NGRP == 2 && vcu == 0 && threadIdx.x == 0) { __builtin_amdgcn_fence(__ATOMIC_RELEASE, "agent"); asm volatile("s_waitcnt vmcnt(0)" ::: "memory"); __hip_atomic_store(ctl + CW_FLAG_DENSE, 1u, RLX_AGENT); }
        } else {
            { PH_IDS; conv_moe(args, 0, lds, gw, ngw, wave, lane); conv_moe(args, 1, lds, gw, ngw, wave, lane); }
            xcd_barrier(bar);
            if (vcu == 0 && threadIdx.x == 0) { __builtin_amdgcn_fence(__ATOMIC_RELEASE, "agent"); asm volatile("s_waitcnt vmcnt(0)" ::: "memory"); __hip_atomic_store(ctl + CW_FLAG_MOE, 1u, RLX_AGENT); }
            wait_flag(ctl + CW_FLAG_DENSE);
        }
    }
    if (IN(1)) { PH_IDS; row_phase<false, true, false, true, false>(args, c, lds, c.x, c.ctx, nullptr, nullptr, TTOT, args.in[I_NMIX] + 0 * 1024, MOD + 0 * 9 * 6144, 0, nullptr, nullptr, nullptr, vcu, G, tid, wave, lane); }
    SEAM(1);
    if (IN(2)) { PH_IDS; { pg8::EpiConvIn E{(pg8::bf16_t*)HBUF}; GEMM_GRID(ABUF, ws + W_SCIN, NMA, 12, 1024, pg8::EpiConvIn, E); } }
    SEAM(2);
    if (IN(3)) { PH_IDS; conv_phase(args, c, vcu, G, wave, lane); }
    SEAM(3);
    if (IN(4)) { PH_IDS; { pg8::EpiResid<true, true, D0_IN8, false> E{c.x, c.ctx, (pg8::bf16_t*)HL, (pg8::bf16_t*)HCX, MOD + 0 * 9 * 6144 + 2048, (pg8::bf16_t*)ABUF, args.in[I_NFFN] + 0 * 1024, MOD + 0 * 9 * 6144 + 4096, c.ssq, b0}; GEMM_GRID(SBUF, ws + W_SCOUT, NMA, 4, 1024, PG8_ER4(true, true, D0_IN8, false), E); } }
    if (IN(4)) { if (NGRP == 1 && bx >= 32) { PH_IDS; conv_moe(args, 0, lds, (bx - 32) * NWAVES + wave, 224 * NWAVES, wave, lane, 0, CM0_A); } }
    SEAM(4);
#define PG8_SG(n, a) pg8::EpiSwiGLU<n, a>
#define PG8_SG8(n, g) pg8::EpiSwiGLU8<n, g>
    if (IN(6)) { PH_IDS;
        if (D0_IN8 && D0_H8) { pg8::EpiSwiGLU8<true> E{(unsigned char*)HBUF, c.ssq, (const float*)(ws + BIAS_P6), b0}; GEMM_GRID8(ABUF, ws + W_F13, NMA, 22, 512, pg8::EpiSwiGLU8<true>, E); }
        else if (D0_IN8) { pg8::EpiSwiGLU<true, true> E{(pg8::bf16_t*)HBUF, FF, c.ssq, (const float*)(ws + BIAS_P6), b0}; GEMM_GRID8(ABUF, ws + W_F13, NMA, 22, 512, PG8_SG(true, true), E); }
        else if (D0_H8) { pg8::EpiSwiGLU8<true, false> E{(unsigned char*)HBUF, c.ssq, (const float*)(ws + BIAS_P6), b0}; GEMM_GRID(ABUF, ws + W_F13, NMA, 22, 1024, PG8_SG8(true, false), E); }
        else { pg8::EpiSwiGLU<true> E{(pg8::bf16_t*)HBUF, FF, c.ssq, (const float*)(ws + BIAS_P6), b0}; GEMM_GRID(ABUF, ws + W_F13, NMA, 22, 1024, pg8::EpiSwiGLU<true>, E); } }
    SEAM(6);
    if (IN(7)) { PH_IDS; if (D0_H8) { pg8::EpiResid<true, false, false, true> E{HL, HCX, (pg8::bf16_t*)HL, (pg8::bf16_t*)HCX, MOD + 0 * 9 * 6144 + 5120, (pg8::bf16_t*)ABUF, args.in[I_NMIX] + 1 * 1024, MOD + 1 * 9 * 6144 + 1024, c.ssq, b0}; GEMM_GRID8(HBUF, ws + W_F2, NMA, 4, FF / 2, PG8_ER4(true, false, false, true), E); }
                        else { pg8::EpiResid<true, false> E{HL, HCX, (pg8::bf16_t*)HL, (pg8::bf16_t*)HCX, MOD + 0 * 9 * 6144 + 5120, (pg8::bf16_t*)ABUF, args.in[I_NMIX] + 1 * 1024, MOD + 1 * 9 * 6144 + 1024, c.ssq, b0}; GEMM_GRID(HBUF, ws + W_F2, NMA, 4, FF, PG8_ER(true, false), E); }
               }
    if (IN(7)) { if (NGRP == 1 && bx >= 32) { PH_IDS; conv_moe(args, 0, lds, (bx - 32) * NWAVES + wave, 224 * NWAVES, wave, lane, CM0_A, CM0_B); } }
    SEAM(7);
    if (IN(9)) { PH_IDS; { pg8::EpiQKV E{(pg8::bf16_t*)HBUF, 3072, c.ssq, (const float*)(ws + BIAS_P9), 3072, 4, 4, args.in[I_DAQG], args.in[I_DAKG], (const float*)(ws + WS_RT), QSCALE, b0}; GEMM_GRID(ABUF, ws + W_DAQKV, NMA, 12, 1024, pg8::EpiQKV, E); } }
    SEAM(9);
    if (IN(11)) { PH_IDS; diff_attn_phase(args, c, lds, vcu, G, tid, wave, lane); }
    SEAM(11);
    if (IN(12)) { PH_IDS; { pg8::EpiResid<false, false> E{HL, HCX, (pg8::bf16_t*)HL, (pg8::bf16_t*)HCX, MOD + 1 * 9 * 6144 + 2048, nullptr, nullptr, nullptr, nullptr, b0}; GEMM_GRID(SBUF, ws + W_DAOUT, NMA, 4, 1024, PG8_ER(false, false), E); } }
    if (IN(12)) { if (NGRP == 1 && bx >= 32) { PH_IDS; conv_moe(args, 0, lds, (bx - 32) * NWAVES + wave, 224 * NWAVES, wave, lane, CM0_B, NE * 3 * 1408); } }
    SEAM(12);
    if (IN(13)) { PH_IDS; row_phase<false, true, true, false, false, true>(args, c, lds, HL, HCX, nullptr, nullptr, TTOT, args.in[I_NFFN] + 1 * 1024, MOD + 1 * 9 * 6144, 3072, nullptr, args.in[I_RW] + 0 * 8192, args.in[I_RB] + 0 * 8, vcu, G, tid, wave, lane); }
    SEAM(13);
    if (IN(14)) { PH_IDS; moe_scatter_phase<true>(c, lds, TTOT, vcu, G, tid, wave, lane); }
    if (NGRP == 2 && IN(14) && grp == 0) wait_flag(ctl + CW_FLAG_MOE);
    SEAM(14);
    if (IN(15)) { PH_IDS; { pg8::EpiSwiGLU8<false> E{(unsigned char*)HBUF, nullptr, nullptr, 0}; GEMM_MOE8(SBUF, ws + W_MOE, 22, 512, pg8::EpiSwiGLU8<false>, E); } }
    SEAM(15);
    if (IN(16)) { PH_IDS; { pg8::EpiMoeDown<true> E{(pg8::bf16_t*)SBUF, c.sgate}; GEMM_MOE8(HBUF, ws + W_MOE + 88 * MiB, 4, FF / 2, pg8::EpiMoeDown<true>, E); } }
    SEAM(16);
    if (IN(17)) { PH_IDS; row_phase<true, true, false, false, false>(args, c, lds, HL, HCX, HL, HCX, TTOT, args.in[I_NMIX] + 2 * 1024, MOD + 2 * 9 * 6144, 0, MOD + 1 * 9 * 6144 + 5120, nullptr, nullptr, vcu, G, tid, wave, lane); }
    SEAM(17);
    if (IN(18)) { PH_IDS; { pg8::EpiStore<1> E{(pg8::bf16_t*)HBUF, 4096, args.in[I_CMINB], c.ssq, 8}; GEMM_GRID(ABUF, ws + W_CMIN, NMA, 16, 1024, pg8::EpiStore<1>, E); } }
    SEAM(18);
    if (IN(19)) { PH_IDS; gate_phase(args, c, lds, vcu, G, tid, wave, lane); }
    SEAM(19);
    if (IN(20)) { PH_IDS; { pg8::EpiResid<true, false, true, false> E{HL, HCX, (pg8::bf16_t*)HL, (pg8::bf16_t*)HCX, MOD + 2 * 9 * 6144 + 2048, (pg8::bf16_t*)ABUF, args.in[I_NFFN] + 2 * 1024, MOD + 2 * 9 * 6144 + 4096, c.ssq, b0}; GEMM_GRID(SBUF, ws + W_CMOUT, NMA, 4, 2048, PG8_ER4(true, false, true, false), E); } }
    if (IN(20)) { if (NGRP == 1 && bx >= 32) { PH_IDS; conv_moe(args, 1, lds, (bx - 32) * NWAVES + wave, 224 * NWAVES, wave, lane, 0, CM1_A); } }
    SEAM(20);
    if (IN(22)) { PH_IDS; { pg8::EpiSwiGLU8<true> E{(unsigned char*)HBUF, c.ssq, (const float*)(ws + BIAS_P22), b0}; GEMM_GRID8(ABUF, ws + W_F13 + (size_t)5632 * 1024 * 2, NMA, 22, 512, pg8::EpiSwiGLU8<true>, E); } }
    SEAM(22);
    if (IN(23)) { PH_IDS; { pg8::EpiResid<true, false, false, true> E{HL, HCX, (pg8::bf16_t*)HL, (pg8::bf16_t*)HCX, MOD + 2 * 9 * 6144 + 5120, (pg8::bf16_t*)ABUF, args.in[I_NMIX] + 3 * 1024, MOD + 3 * 9 * 6144 + 1024, c.ssq, b0}; GEMM_GRID8(HBUF, ws + W_F2 + (size_t)1024 * 2816 * 2, NMA, 4, FF / 2, PG8_ER4(true, false, false, true), E); }
               }
    if (IN(23)) { if (NGRP == 1 && bx >= 32) { PH_IDS; conv_moe(args, 1, lds, (bx - 32) * NWAVES + wave, 224 * NWAVES, wave, lane, CM1_A, NE * 3 * 1408); } }
    SEAM(23);
    if (IN(25)) { PH_IDS; { pg8::EpiQKV E{(pg8::bf16_t*)HBUF, 1536, c.ssq, (const float*)(ws + BIAS_P25), 1536, 4, 1, args.in[I_SWQG], args.in[I_SWKG], (const float*)(ws + WS_RT), QSCALE, b0}; GEMM_GRID(ABUF, ws + W_SWQKV, NMA, 6, 1024, pg8::EpiQKV, E); } }
    SEAM(25);
    if (IN(27)) { PH_IDS; swa_attn_phase(args, c, lds, vcu, G, tid, wave, lane); }
    SEAM(27);
    if (IN(28)) { PH_IDS; { pg8::EpiResid<false, false> E{HL, HCX, (pg8::bf16_t*)HL, (pg8::bf16_t*)HCX, MOD + 3 * 9 * 6144 + 2048, nullptr, nullptr, nullptr, nullptr, b0}; GEMM_GRID(SBUF, ws + W_SWOUT, NML, 4, 1024, PG8_ER(false, false), E); } }
    SEAM(28);
    if (IN(29)) { PH_IDS; row_phase<false, true, true, false, false, true>(args, c, lds, HL, HCX, nullptr, nullptr, TLAT, args.in[I_NFFN] + 3 * 1024, MOD + 3 * 9 * 6144, 3072, nullptr, args.in[I_RW] + 1 * 8192, args.in[I_RB] + 1 * 8, vcu, G, tid, wave, lane); }
    SEAM(29);
    if (IN(30)) { PH_IDS; moe_scatter_phase<true>(c, lds, TLAT, vcu, G, tid, wave, lane); }
    SEAM(30);
    if (IN(31)) { PH_IDS; { pg8::EpiSwiGLU8<false> E{(unsigned char*)HBUF, nullptr, nullptr, 0}; GEMM_MOE8(SBUF, ws + W_MOE + W_MOE_STRIDE, 22, 512, pg8::EpiSwiGLU8<false>, E); } }
    SEAM(31);
    if (IN(32)) { PH_IDS; { pg8::EpiMoeDown<true> E{(pg8::bf16_t*)SBUF, c.sgate}; GEMM_MOE8(HBUF, ws + W_MOE + W_MOE_STRIDE + 88 * MiB, 4, FF / 2, pg8::EpiMoeDown<true>, E); } }
    SEAM(32);
    if (IN(33)) { PH_IDS; row_phase<true, false, false, false, true>(args, c, lds, HL, HCX, c.out, nullptr, TLAT, nullptr, nullptr, 0, MOD + 3 * 9 * 6144 + 5120, nullptr, nullptr, vcu, G, tid, wave, lane); }
#undef IN
#undef SEAM
}

extern "C" void kernel_launch(void* const* d_in, const int* in_sizes, int n_in, void* d_out, int out_size, void* d_ws, size_t ws_size, hipStream_t stream) {
    static int grid = 0;
    if (grid == 0) {
        if (n_in != N_IN || in_sizes[0] != NGRP * TLAT * D || out_size != NGRP * TLAT * D || ws_size < WS_END) { fprintf(stderr, "kernel_launch: unexpected shapes / workspace (n_in %d, ws %zu < %zu)\n", n_in, ws_size, (size_t)WS_END); grid = -1; return; }
        int dev = 0, cus = 0;
        if (hipGetDevice(&dev) != hipSuccess || hipDeviceGetAttribute(&cus, hipDeviceAttributeMultiprocessorCount, dev) != hipSuccess) { grid = -1; return; }
        if (hipFuncSetAttribute((const void*)mk_fwd, hipFuncAttributeMaxDynamicSharedMemorySize, LDS_BYTES) != hipSuccess) { fprintf(stderr, "kernel_launch: hipFuncSetAttribute failed\n"); grid = -1; return; }
        int per_cu = 0;
        if (hipOccupancyMaxActiveBlocksPerMultiprocessor(&per_cu, (const void*)mk_fwd, NTHR, LDS_BYTES) != hipSuccess || per_cu < 1) fprintf(stderr, "kernel_launch: occupancy query reports %d\n", per_cu);
        (void)hipGetLastError();
        grid = cus;
        if (grid != NGRP * GG) { fprintf(stderr, "kernel_launch: built for 256 CUs, found %d\n", cus); grid = -1; return; }
    }
    if (grid < 0) return;
    (void)hipMemsetAsync((char*)d_ws + WS_CTL, 0, CTL_ZERO_BYTES, stream);
    Args a{};
    for (int i = 0; i < N_IN; ++i) a.in[i] = (const float*)d_in[i];
    a.out = (float*)d_out; a.ws = (unsigned char*)d_ws;
    a.ph_lo = 0; a.ph_hi = N_PHASES; hipLaunchKernelGGL(mk_fwd, dim3(grid), dim3(NTHR), LDS_BYTES, stream, a);
}
```

```cpp
#include <hip/hip_runtime.h>
#include <cstdio>
#include <cstdint>
#include <cmath>
#ifndef MK_NGRP
#define MK_NGRP 1
#endif
#define MK_TLAT (32768 / MK_NGRP)
namespace pg8 {
#define PG8_LAS __attribute__((address_space(3)))
typedef unsigned short bf16_t;
typedef short bf16x8 __attribute__((ext_vector_type(8)));
typedef float f32x4 __attribute__((ext_vector_type(4)));
typedef unsigned u32x4 __attribute__((ext_vector_type(4)));
constexpr int BM = 256, BK = 64, HALF = 128, HTB = HALF * BK * 2  , STAGE_BYTES = 8 * HTB, NXCD = 8, WGM = 4;

__host__ __device__ __forceinline__ int lds_byte(int r, int c) { const int st = (r >> 4) * 2 + (c >> 5), rr = r & 15, cc = c & 31, ob = rr * 64 + cc * 2; return st * 1024 + (ob ^ (((ob >> 9) & 1) << 5)); }
__host__ __device__ __forceinline__ void stage_rc(int b, int& R, int& C) { const int st = b / 1024, sb = b % 1024, swz = sb ^ (((sb >> 9) & 1) << 5); R = (st >> 1) * 16 + swz / 64; C = (st & 1) * 32 + (swz % 64) / 2; }
__host__ __device__ __forceinline__ int perm32(int rho) { const int n = rho >> 4, i = rho & 15; return 8 * (i >> 2) + 4 * n + (i & 3); }

struct Unit { int pm, pn; };
struct Gemm { const bf16_t* A; const bf16_t* Bt; int M, N, K; };

struct StaticOrder {
    int nM, nN, nwg, G, c;
    __host__ __device__ void init(int M, int N, int G_, int c_) { nM = M / BM; nN = N / BM; nwg = nM * nN; G = G_; c = c_; }
    __host__ __device__ bool next(int i, Unit& u) const {
        const long L = (long)i * G + c; if (L >= nwg) return false;
        int wgid = (int)L; { const int q = nwg / NXCD, r = nwg % NXCD, xcd = wgid % NXCD, off = wgid / NXCD; wgid = (xcd < r ? xcd * (q + 1) : r * (q + 1) + (xcd - r) * q) + off; }
        const int nig = WGM * nN, gid = wgid / nig, fm = gid * WGM, gsz = (nM - fm) < WGM ? (nM - fm) : WGM;
        u.pm = fm + ((wgid % nig) % gsz); u.pn = (wgid % nig) / gsz; return true;
    }
    __device__ __forceinline__ void a_ready(const Unit&) const {}
    __device__ __forceinline__ void done(const Unit&) const {}
};

__device__ __forceinline__ unsigned cvt_pk_bf16(float lo, float hi) { unsigned r; asm volatile("v_cvt_pk_bf16_f32 %0, %1, %2" : "=v"(r) : "v"(lo), "v"(hi)); return r; }
typedef int i32x4_ __attribute__((ext_vector_type(4)));
constexpr float F8_SA = 16.f, F8_SW13 = 32.f, F8_SH = 4.f, F8_SW2 = 64.f, F8_SAU = 8.f;
__device__ __forceinline__ unsigned cvt_pk_fp8x4(float a, float b, float c, float d) {
    a = __builtin_amdgcn_fmed3f(a, -448.f, 448.f); b = __builtin_amdgcn_fmed3f(b, -448.f, 448.f); c = __builtin_amdgcn_fmed3f(c, -448.f, 448.f); d = __builtin_amdgcn_fmed3f(d, -448.f, 448.f);
    unsigned w = 0u; w = (unsigned)__builtin_amdgcn_cvt_pk_fp8_f32(a, b, (int)w, false); w = (unsigned)__builtin_amdgcn_cvt_pk_fp8_f32(c, d, (int)w, true); return w; }
__device__ __forceinline__ float bf_lo(unsigned u) { return __builtin_bit_cast(float, u << 16); }
__device__ __forceinline__ float bf_hi(unsigned u) { return __builtin_bit_cast(float, u & 0xffff0000u); }

typedef float f32x2 __attribute__((ext_vector_type(2)));
__device__ __forceinline__ float gelu_tanh1(float x) {
    const float u = 0.7978845608028654f * (x + 0.044715f * x * x * x);
    const float e = __builtin_amdgcn_exp2f(-2.8853900817779268f * u);
    return x * __builtin_amdgcn_rcpf(1.0f + e);
}
__device__ __forceinline__ float silu1(float x) { return x * __builtin_amdgcn_rcpf(1.0f + __builtin_amdgcn_exp2f(-1.4426950408889634f * x)); }
__device__ __forceinline__ void swiglu8(const float (&g)[8], const float (&u)[8], const float c1, const float K, float (&h)[8]) {
    float t[8], p[8];
#pragma unroll
    for (int j = 0; j < 8; ++j) t[j] = g[j] * c1;
    __builtin_amdgcn_sched_barrier(0);
#pragma unroll
    for (int j = 0; j < 8; ++j) t[j] = __builtin_amdgcn_exp2f(t[j]);
#pragma unroll
    for (int j = 0; j < 8; ++j) p[j] = g[j] * u[j];
    __builtin_amdgcn_sched_barrier(0);
#pragma unroll
    for (int j = 0; j < 8; ++j) t[j] = __builtin_fmaf(t[j], K, K);
    __builtin_amdgcn_sched_barrier(0);
#pragma unroll
    for (int j = 0; j < 8; ++j) t[j] = __builtin_amdgcn_rcpf(t[j]);
    __builtin_amdgcn_sched_barrier(0);
#pragma unroll
    for (int j = 0; j < 8; ++j) h[j] = p[j] * t[j];
}

__device__ __forceinline__ float row_rstd16(const float* ssq, int row) {
    const f32x4* p = (const f32x4*)(ssq + (size_t)row * 32); const f32x4 a = p[0], b = p[1], c = p[2], d = p[3];
    const float t = ((a.x + a.y) + (a.z + a.w)) + ((b.x + b.y) + (b.z + b.w)) + ((c.x + c.y) + (c.z + c.w)) + ((d.x + d.y) + (d.z + d.w));
    return 1.0f / sqrtf(t * (1.0f / 1024.0f) + 1e-6f);
}
template <int ACT> struct EpiStore {
    static constexpr bool PERM = true, AFTER_DRAIN = false;
    bf16_t* O; int ldc; const float* bias; float* ssq; int ssq_pn0;
    __device__ __forceinline__ void operator()(const f32x4 (&acc)[2][2][4][2], const Unit& u, int wr, int wc, int fr, int fq) const {
        const int row0 = u.pm * BM + wr * 64 + fr; const int col0 = u.pn * BM + wc * 32 + 8 * fq;
        f32x4 bv[2][2];
#pragma unroll
        for (int bj = 0; bj < 2; ++bj)
#pragma unroll
            for (int n = 0; n < 2; ++n) bv[bj][n] = bias ? *(const f32x4*)(bias + col0 + bj * HALF + 4 * n) : (f32x4){0.f, 0.f, 0.f, 0.f};
#pragma unroll
        for (int ai = 0; ai < 2; ++ai)
#pragma unroll
            for (int m = 0; m < 4; ++m) { bf16_t* rowp = O + (size_t)(row0 + ai * HALF + m * 16) * ldc + col0; float ss = 0.f;
#pragma unroll
                for (int bj = 0; bj < 2; ++bj) { f32x4 v0 = acc[ai][bj][m][0] + bv[bj][0], v1 = acc[ai][bj][m][1] + bv[bj][1];
                    if (ACT == 1) {
#pragma unroll
                        for (int i = 0; i < 4; ++i) { v0[i] = gelu_tanh1(v0[i]); v1[i] = gelu_tanh1(v1[i]); }
#pragma unroll
                        for (int i = 0; i < 4; ++i) ss += v0[i] * v0[i] + v1[i] * v1[i];
                    }
                    u32x4 w; w.x = cvt_pk_bf16(v0[0], v0[1]); w.y = cvt_pk_bf16(v0[2], v0[3]); w.z = cvt_pk_bf16(v1[0], v1[1]); w.w = cvt_pk_bf16(v1[2], v1[3]);
                    *(u32x4*)(rowp + bj * HALF) = w; }
                if (ACT == 1) { ss += __shfl_xor(ss, 16); ss += __shfl_xor(ss, 32);
                    if (u.pn >= ssq_pn0 && fq == 0) ssq[(size_t)(row0 + ai * HALF + m * 16) * 32 + (u.pn - ssq_pn0) * 4 + wc] = ss; }
            }
    }
};

struct EpiConvIn {
    static constexpr bool PERM = true, AFTER_DRAIN = false;
    bf16_t* O;
    __device__ __forceinline__ void operator()(const f32x4 (&acc)[2][2][4][2], const Unit& u, int wr, int wc, int fr, int fq) const {
        const int row0 = u.pm * BM + wr * 64 + fr;
        if (u.pn < 4) { const int col0 = u.pn * BM + wc * 32 + 8 * fq;
#pragma unroll
            for (int ai = 0; ai < 2; ++ai)
#pragma unroll
                for (int m = 0; m < 4; ++m) { bf16_t* rowp = O + (size_t)(row0 + ai * HALF + m * 16) * 2048 + col0;
#pragma unroll
                    for (int bj = 0; bj < 2; ++bj) { const f32x4 v0 = acc[ai][bj][m][0], v1 = acc[ai][bj][m][1];
                        u32x4 w; w.x = cvt_pk_bf16(v0[0], v0[1]); w.y = cvt_pk_bf16(v0[2], v0[3]); w.z = cvt_pk_bf16(v1[0], v1[1]); w.w = cvt_pk_bf16(v1[2], v1[3]);
                        *(u32x4*)(rowp + bj * HALF) = w; } }
        } else { const int col0 = 1024 + (u.pn - 4) * HALF + wc * 32 + 8 * fq;
#pragma unroll
            for (int ai = 0; ai < 2; ++ai)
#pragma unroll
                for (int m = 0; m < 4; ++m) { const f32x4 v0 = acc[ai][0][m][0] * acc[ai][1][m][0], v1 = acc[ai][0][m][1] * acc[ai][1][m][1];
                    u32x4 w; w.x = cvt_pk_bf16(v0[0], v0[1]); w.y = cvt_pk_bf16(v0[2], v0[3]); w.z = cvt_pk_bf16(v1[0], v1[1]); w.w = cvt_pk_bf16(v1[2], v1[3]);
                    *(u32x4*)(O + (size_t)(row0 + ai * HALF + m * 16) * 2048 + col0) = w; }
        }
    }
};

struct EpiQKV {
    static constexpr bool PERM = true, AFTER_DRAIN = false;
    bf16_t* O; int ldc; const float* ssq; const float* bias  ; int N; int nq_t, nk_t; const float* qg; const float* kg; const float* RT; float qscale; int b0;
    __device__ __forceinline__ void operator()(const f32x4 (&acc)[2][2][4][2], const Unit& u, int wr, int wc, int fr, int fq) const {
        const int prow = u.pm * BM; const bool lat = prow < MK_TLAT; const int cidx = lat ? b0 + (prow >> 12) : 8;
        const int rl0 = wr * 64 + fr; const int ncol0 = u.pn * BM + wc * 32 + 8 * fq;
        const float* bp = bias + (size_t)cidx * N + ncol0;
        f32x4 bv[2][2];
#pragma unroll
        for (int bj = 0; bj < 2; ++bj)
#pragma unroll
            for (int n = 0; n < 2; ++n) bv[bj][n] = *(const f32x4*)(bp + bj * HALF + 4 * n);
        const bool isq = u.pn < nq_t, isqk = u.pn < nq_t + nk_t;
        f32x4 gg[2][2];
        if (isqk) { const float* gp = isq ? qg : kg; const float sc = isq ? qscale : 1.0f;
#pragma unroll
            for (int bj = 0; bj < 2; ++bj)
#pragma unroll
                for (int n = 0; n < 2; ++n) gg[bj][n] = *(const f32x4*)(gp + bj * 32 + 16 * n + 4 * fq) * sc; }
        typedef unsigned u32x2q __attribute__((ext_vector_type(2)));
#pragma unroll
        for (int ai = 0; ai < 2; ++ai) {
            f32x4 csR, snR;
            if (isqk && lat) { const int posr = ((prow + wr * 64 + ai * HALF) & 4095) >> 6;
                const f32x4 t0 = *(const f32x4*)(RT + 2 * (posr * 16 + 4 * fq)), t1 = *(const f32x4*)(RT + 2 * (posr * 16 + 4 * fq) + 4);
                csR = (f32x4){t0.x, t0.z, t1.x, t1.z}; snR = (f32x4){t0.y, t0.w, t1.y, t1.w}; }
#pragma unroll
            for (int m = 0; m < 4; ++m) { const int row = prow + rl0 + ai * HALF + m * 16;
                const float rs = row_rstd16(ssq, row);
                f32x4 v[2][2]; float ss = 0.f;
#pragma unroll
                for (int bj = 0; bj < 2; ++bj)
#pragma unroll
                    for (int n = 0; n < 2; ++n) { v[bj][n] = acc[ai][bj][m][n] * rs + bv[bj][n]; ss += (v[bj][n].x * v[bj][n].x + v[bj][n].y * v[bj][n].y) + (v[bj][n].z * v[bj][n].z + v[bj][n].w * v[bj][n].w); }
                if (isqk) {
                    ss += __shfl_xor(ss, 16); ss += __shfl_xor(ss, 32);
                    const float rh = 1.0f / sqrtf(ss * (1.0f / 64.0f) + 1e-6f);
#pragma unroll
                    for (int bj = 0; bj < 2; ++bj)
#pragma unroll
                        for (int n = 0; n < 2; ++n) v[bj][n] = v[bj][n] * rh * gg[bj][n];
                    if (lat) {
                        { const f32x4 x1 = v[0][0], x2 = v[0][1]; v[0][0] = x1 * csR - x2 * snR; v[0][1] = x1 * snR + x2 * csR; }
                        { const int posc = fr + 16 * m;
                          const f32x4 t0 = *(const f32x4*)(RT + 2 * (posc * 16 + 4 * fq)), t1 = *(const f32x4*)(RT + 2 * (posc * 16 + 4 * fq) + 4);
                          const f32x4 cs = (f32x4){t0.x, t0.z, t1.x, t1.z}, sn = (f32x4){t0.y, t0.w, t1.y, t1.w};
                          const f32x4 x1 = v[1][0], x2 = v[1][1]; v[1][0] = x1 * cs - x2 * sn; v[1][1] = x1 * sn + x2 * cs; }
                    }
                    bf16_t* rowp = O + (size_t)row * ldc + u.pn * BM + wc * 64 + 4 * fq;
#pragma unroll
                    for (int bj = 0; bj < 2; ++bj)
#pragma unroll
                        for (int n = 0; n < 2; ++n) { u32x2q w; w.x = cvt_pk_bf16(v[bj][n][0], v[bj][n][1]); w.y = cvt_pk_bf16(v[bj][n][2], v[bj][n][3]); *(u32x2q*)(rowp + bj * 32 + 16 * n) = w; }
                } else {
                    bf16_t* rowp = O + (size_t)row * ldc + ncol0;
#pragma unroll
                    for (int bj = 0; bj < 2; ++bj) { u32x4 w; w.x = cvt_pk_bf16(v[bj][0][0], v[bj][0][1]); w.y = cvt_pk_bf16(v[bj][0][2], v[bj][0][3]); w.z = cvt_pk_bf16(v[bj][1][0], v[bj][1][1]); w.w = cvt_pk_bf16(v[bj][1][2], v[bj][1][3]);
                        *(u32x4*)(rowp + bj * HALF) = w; }
                }
            }
        }
    }
};

template <bool NIN, bool A8 = false> struct EpiSwiGLU {
    static constexpr bool PERM = true, AFTER_DRAIN = false;
    bf16_t* O; int ldo; const float* ssq; const float* bias  ; int b0;
    __device__ __forceinline__ void operator()(const f32x4 (&acc)[2][2][4][2], const Unit& u, int wr, int wc, int fr, int fq) const {
        const int row0 = u.pm * BM + wr * 64 + fr; const int col0 = (u.pn % 22) * HALF + wc * 32 + 8 * fq;
        f32x4 bv[2][2];
        if (NIN) { const int prow = u.pm * BM; const int cidx = prow < MK_TLAT ? b0 + (prow >> 12) : 8; const float* bp = bias + (size_t)cidx * 5632 + u.pn * BM + wc * 32 + 8 * fq;
#pragma unroll
            for (int bj = 0; bj < 2; ++bj)
#pragma unroll
                for (int n = 0; n < 2; ++n) bv[bj][n] = *(const f32x4*)(bp + bj * HALF + 4 * n); }
#pragma unroll
        for (int ai = 0; ai < 2; ++ai)
#pragma unroll
            for (int m = 0; m < 4; ++m) { const int row = row0 + ai * HALF + m * 16; bf16_t* rowp = O + (size_t)row * ldo + col0;
                float rs = 1.0f; if (NIN) rs = row_rstd16(ssq, row); if (A8) rs *= 1.0f / (F8_SAU * F8_SW13);
                float h[8], gg[8], uu[8];
#pragma unroll
                for (int n = 0; n < 2; ++n)
#pragma unroll
                    for (int i = 0; i < 4; ++i) { float gt = acc[ai][0][m][n][i], up = acc[ai][1][m][n][i]; if (NIN) { gt = gt * rs + bv[0][n][i]; up = up * rs + bv[1][n][i]; } gg[4 * n + i] = gt; uu[4 * n + i] = up; }
                swiglu8(gg, uu, -1.4426950408889634f, 1.0f, h);
                u32x4 w; w.x = cvt_pk_bf16(h[0], h[1]); w.y = cvt_pk_bf16(h[2], h[3]); w.z = cvt_pk_bf16(h[4], h[5]); w.w = cvt_pk_bf16(h[6], h[7]);
                *(u32x4*)rowp = w; }
    }
};

template <bool NIN, bool G8 = true> struct EpiSwiGLU8 {
    static constexpr bool PERM = true, AFTER_DRAIN = false;
    unsigned char* O; const float* ssq; const float* bias  ; int b0;
    static constexpr int ldo = 2816; static constexpr float in_scale = G8 ? 1.0f / ((NIN ? F8_SAU : F8_SA) * F8_SW13) : 1.0f, out_scale = F8_SH;
    __device__ __forceinline__ void operator()(const f32x4 (&acc)[2][2][4][2], const Unit& u, int wr, int wc, int fr, int fq) const {
        const int row0 = u.pm * BM + wr * 64 + fr; const int col0 = (u.pn % 22) * HALF + wc * 32 + 8 * fq;
        f32x4 bv[2][2];
        if (NIN) { const int prow = u.pm * BM; const int cidx = prow < MK_TLAT ? b0 + (prow >> 12) : 8; const float* bp = bias + (size_t)cidx * 5632 + u.pn * BM + wc * 32 + 8 * fq;
#pragma unroll
            for (int bj = 0; bj < 2; ++bj)
#pragma unroll
                for (int n = 0; n < 2; ++n) bv[bj][n] = *(const f32x4*)(bp + bj * HALF + 4 * n); }
#pragma unroll
        for (int ai = 0; ai < 2; ++ai)
#pragma unroll
            for (int m = 0; m < 4; ++m) { const int row = row0 + ai * HALF + m * 16;
                float rs = in_scale; if (NIN) rs = row_rstd16(ssq, row) * in_scale;
                float h[8], gg[8], uu[8];
#pragma unroll
                for (int n = 0; n < 2; ++n)
#pragma unroll
                    for (int i = 0; i < 4; ++i) { float gt = acc[ai][0][m][n][i], up = acc[ai][1][m][n][i]; if (NIN) { gt = gt * rs + bv[0][n][i]; up = up * rs + bv[1][n][i]; } gg[4 * n + i] = gt; uu[4 * n + i] = up; }
                if (NIN) swiglu8(gg, uu, -1.4426950408889634f, 1.0f / out_scale, h);
                else swiglu8(gg, uu, -1.4426950408889634f * in_scale, 1.0f / (in_scale * in_scale * out_scale), h);
                unsigned w0 = cvt_pk_fp8x4(h[0], h[1], h[2], h[3]), w1 = cvt_pk_fp8x4(h[4], h[5], h[6], h[7]);
                typedef unsigned u32x2_ __attribute__((ext_vector_type(2)));
                *(u32x2_*)(O + (size_t)row * ldo + col0) = (u32x2_){w0, w1}; }
    }
};

template <bool NEXT, bool SRC32, bool N8 = false, bool A8S = false> struct EpiResid {
    static constexpr bool PERM = true, AFTER_DRAIN = false; static constexpr float ascale = A8S ? 1.0f / (F8_SH * F8_SW2) : 1.0f;
    static constexpr int HP = 2048;
    const void* src_lat; const void* src_ctx; bf16_t* dst_lat; bf16_t* dst_ctx; const float* gate;
    bf16_t* An; const float* gn; const float* scn; float* ssq; int b0;
    __device__ __forceinline__ void operator()(const f32x4 (&acc)[2][2][4][2], const Unit& u, int wr, int wc, int fr, int fq) const {
        const int prow = u.pm * BM; const bool lat = prow < MK_TLAT; const int cidx = lat ? b0 + (prow >> 12) : 8;
        const float* s32 = lat ? (const float*)src_lat + (size_t)prow * 1024 : (const float*)src_ctx + (size_t)(prow - MK_TLAT) * 1024;
        const bf16_t* s16 = lat ? (const bf16_t*)src_lat + (size_t)prow * HP : (const bf16_t*)src_ctx + (size_t)(prow - MK_TLAT) * HP;
        bf16_t* d = lat ? dst_lat + (size_t)prow * HP : dst_ctx + (size_t)(prow - MK_TLAT) * HP;
        const int rl0 = wr * 64 + fr; const int col0 = u.pn * BM + wc * 32 + 8 * fq;
        const float* g = gate + (size_t)cidx * 6144 + col0;
        float ss[2][4];
#pragma unroll
        for (int ai = 0; ai < 2; ++ai)
#pragma unroll
            for (int m = 0; m < 4; ++m) ss[ai][m] = 0.f;
#pragma unroll
        for (int bj = 0; bj < 2; ++bj) {
            asm volatile("" ::: "memory");
            f32x4 gv[2], Gn[2];
#pragma unroll
            for (int n = 0; n < 2; ++n) { gv[n] = *(const f32x4*)(g + bj * HALF + 4 * n); if (A8S) gv[n] = gv[n] * ascale;
                if (NEXT) { Gn[n] = *(const f32x4*)(gn + col0 + bj * HALF + 4 * n) * (*(const f32x4*)(scn + (size_t)cidx * 6144 + col0 + bj * HALF + 4 * n) + 1.0f); if (N8) Gn[n] = Gn[n] * F8_SAU; } }
#pragma unroll
            for (int ai = 0; ai < 2; ++ai)
#pragma unroll
                for (int m = 0; m < 4; ++m) { if ((m & 1) == 0) asm volatile("" ::: "memory");
                    const int rl = rl0 + ai * HALF + m * 16; f32x4 hn[2];
                    if (SRC32) { const size_t ro = (size_t)rl * 1024 + col0 + bj * HALF; hn[0] = *(const f32x4*)(s32 + ro); hn[1] = *(const f32x4*)(s32 + ro + 4); }
                    else { const u32x4 p = *(const u32x4*)(s16 + (size_t)rl * HP + col0 + bj * HALF);
                        hn[0] = f32x4{bf_lo(p.x), bf_hi(p.x), bf_lo(p.y), bf_hi(p.y)}; hn[1] = f32x4{bf_lo(p.z), bf_hi(p.z), bf_lo(p.w), bf_hi(p.w)}; }
#pragma unroll
                    for (int n = 0; n < 2; ++n) hn[n] = hn[n] + gv[n] * acc[ai][bj][m][n];
                    { u32x4 w; w.x = cvt_pk_bf16(hn[0][0], hn[0][1]); w.y = cvt_pk_bf16(hn[0][2], hn[0][3]); w.z = cvt_pk_bf16(hn[1][0], hn[1][1]); w.w = cvt_pk_bf16(hn[1][2], hn[1][3]);
                      *(u32x4*)(d + (size_t)rl * HP + col0 + bj * HALF) = w; }
                    if (NEXT) { ss[ai][m] += (hn[0].x * hn[0].x + hn[0].y * hn[0].y) + (hn[0].z * hn[0].z + hn[0].w * hn[0].w) + (hn[1].x * hn[1].x + hn[1].y * hn[1].y) + (hn[1].z * hn[1].z + hn[1].w * hn[1].w);
                        const f32x4 a0 = hn[0] * Gn[0], a1 = hn[1] * Gn[1];
                        if (N8) { typedef unsigned u32x2_ __attribute__((ext_vector_type(2)));
                            *(u32x2_*)((unsigned char*)An + (size_t)(prow + rl) * 1024 + col0 + bj * HALF) = (u32x2_){cvt_pk_fp8x4(a0[0], a0[1], a0[2], a0[3]), cvt_pk_fp8x4(a1[0], a1[1], a1[2], a1[3])}; }
                        else { u32x4 w; w.x = cvt_pk_bf16(a0[0], a0[1]); w.y = cvt_pk_bf16(a0[2], a0[3]); w.z = cvt_pk_bf16(a1[0], a1[1]); w.w = cvt_pk_bf16(a1[2], a1[3]);
                            *(u32x4*)(An + (size_t)(prow + rl) * 1024 + col0 + bj * HALF) = w; } } }
        }
        if (NEXT) {
#pragma unroll
            for (int ai = 0; ai < 2; ++ai)
#pragma unroll
                for (int m = 0; m < 4; ++m) { float t = ss[ai][m]; t += __shfl_xor(t, 16); t += __shfl_xor(t, 32); if (fq == 0) ssq[(size_t)(prow + rl0 + ai * HALF + m * 16) * 32 + u.pn * 4 + wc] = t; }
        }
    }
};

template <bool F8S> struct EpiMoeDown {
    static constexpr bool PERM = true, AFTER_DRAIN = false; static constexpr float scale = F8S ? 1.0f / (F8_SH * F8_SW2) : 1.0f;
    bf16_t* Y; const float* slot_gate;
    __device__ __forceinline__ void operator()(const f32x4 (&acc)[2][2][4][2], const Unit& u, int wr, int wc, int fr, int fq) const {
        const int row0 = u.pm * BM + wr * 64 + fr; const int col0 = (u.pn & 3) * BM + wc * 32 + 8 * fq;
#pragma unroll
        for (int ai = 0; ai < 2; ++ai)
#pragma unroll
            for (int m = 0; m < 4; ++m) { const int row = row0 + ai * HALF + m * 16; const float sg = slot_gate[row] * scale; bf16_t* rowp = Y + (size_t)row * 1024 + col0;
#pragma unroll
                for (int bj = 0; bj < 2; ++bj) { const f32x4 v0 = acc[ai][bj][m][0] * sg, v1 = acc[ai][bj][m][1] * sg;
                    u32x4 w; w.x = cvt_pk_bf16(v0[0], v0[1]); w.y = cvt_pk_bf16(v0[2], v0[3]); w.z = cvt_pk_bf16(v1[0], v1[1]); w.w = cvt_pk_bf16(v1[2], v1[3]);
                    *(u32x4*)(rowp + bj * HALF) = w; } }
    }
};

struct GridOrder {
    int nM, nN, nwg, G, c;
    __device__ void init(int nM_, int nN_, int G_, int c_) { nM = nM_; nN = nN_; nwg = nM * nN; G = G_; c = c_; }
    __device__ bool next(int i, Unit& u) const {
        const long L = (long)i * G + c; if (L >= nwg) return false;
        int wgid = (int)L; { const int q = nwg / NXCD, r = nwg % NXCD, xcd = wgid % NXCD, off = wgid / NXCD; wgid = (xcd < r ? xcd * (q + 1) : r * (q + 1) + (xcd - r) * q) + off; }
        const int nig = WGM * nN, gid = wgid / nig, fm = gid * WGM, gsz = (nM - fm) < WGM ? (nM - fm) : WGM;
        u.pm = fm + ((wgid % nig) % gsz); u.pn = (wgid % nig) / gsz; return true;
    }
    __device__ __forceinline__ void a_ready(const Unit&) const {}
    __device__ __forceinline__ void done(const Unit&) const {}
};
struct MoeOrder {
    GridOrder g; const PG8_LAS int* pexp; int nNe;
    __device__ bool next(int i, Unit& u) const { if (!g.next(i, u)) return false; u.pn += pexp[u.pm] * nNe; return true; }
    __device__ __forceinline__ void a_ready(const Unit&) const {}
    __device__ __forceinline__ void done(const Unit&) const {}
};
template <int NNE> struct MoeOrderC {
    int nM, c; const PG8_LAS int* pexp;
    __device__ bool next(int i, Unit& u) const {
        const int nwg = nM * NNE; const long L = (long)i * 256 + c; if (L >= nwg) return false;
        int wgid = (int)L; { const int q = nwg / NXCD, r = nwg % NXCD, xcd = wgid % NXCD, off = wgid / NXCD; wgid = (xcd < r ? xcd * (q + 1) : r * (q + 1) + (xcd - r) * q) + off; }
        constexpr int nig = WGM * NNE; const int gid = wgid / nig, fm = gid * WGM, gsz = (nM - fm) < WGM ? (nM - fm) : WGM;
        u.pm = fm + ((wgid % nig) % gsz); u.pn = (wgid % nig) / gsz; u.pn += pexp[u.pm] * NNE; return true;
    }
    __device__ __forceinline__ void a_ready(const Unit&) const {}
    __device__ __forceinline__ void done(const Unit&) const {}
};
__device__ __forceinline__ const char* sgpr_ptr(const char* p) { const unsigned long long v = (unsigned long long)p; const unsigned lo = __builtin_amdgcn_readfirstlane((unsigned)v), hi = __builtin_amdgcn_readfirstlane((unsigned)(v >> 32)); return (const char*)(((unsigned long long)hi << 32) | lo); }
template <class Epi, class Sched, bool ALIGN_EPI = false, bool SP2 = false, bool F8 = false>
__device__ __forceinline__ void gemm_phase(PG8_LAS unsigned char* lds, const Gemm g, const Sched& S, const Epi& E) {
    int tid_ = threadIdx.x; asm volatile("" : "+v"(tid_));
    const int tid = tid_, wid = __builtin_amdgcn_readfirstlane(tid >> 6), lane = tid & 63, wr = wid >> 2, wc = wid & 3, fr = lane & 15, fq = lane >> 4;
    const int K = g.K, nt = K / BK;
    unsigned voffA[2], voffB[2];
#pragma unroll
    for (int i = 0; i < 2; ++i) { int R, C; stage_rc(tid * 16 + i * 8192, R, C); const int Rb = Epi::PERM ? ((R & ~31) + perm32(R & 31)) : R;
        voffA[i] = (unsigned)(R * K + C) * 2u; voffB[i] = (unsigned)(Rb * K + C) * 2u; }
    const size_t kstep = (size_t)(BK * 2);
    const size_t hstep = (size_t)HALF * K * 2;
    const size_t tstep = 2 * hstep;
    const unsigned ldsw = (unsigned)wid * 1024u;
    const int aoff = lds_byte(wr * 64 + fr, fq * 8), boff = lds_byte(wc * 32 + fr, fq * 8);
#define PG8_SA(b, h) (((b) * 2 + (h)) * HTB)
#define PG8_SB(b, h) ((4 + (b) * 2 + (h)) * HTB)
#define PG8_STAGE(bufoff, gbase, voff) do { _Pragma("unroll") for (int _i = 0; _i < 2; ++_i) { unsigned _vo = (voff)[_i]; asm volatile("" : "+v"(_vo)); unsigned _lw = ldsw; asm volatile("" : "+s"(_lw)); \
        __builtin_amdgcn_global_load_lds((const unsigned*)((const char*)(gbase) + _vo), (PG8_LAS unsigned*)(lds + (bufoff) + _lw + _i * 8192), 16, 0, 0); } } while (0)
#define PG8_LDA(dst, b, h) do { _Pragma("unroll") for (int m = 0; m < 4; ++m) _Pragma("unroll") for (int k = 0; k < 2; ++k) dst[m][k] = *(const PG8_LAS bf16x8*)(lds + PG8_SA(b, h) + aoff + m * 2048 + k * 1024); } while (0)
#define PG8_LDB(dst, b, h) do { _Pragma("unroll") for (int n = 0; n < 2; ++n) _Pragma("unroll") for (int k = 0; k < 2; ++k) dst[n][k] = *(const PG8_LAS bf16x8*)(lds + PG8_SB(b, h) + boff + n * 2048 + k * 1024); } while (0)
#define PG8_CAT8(x0, x1) __builtin_shufflevector(__builtin_bit_cast(i32x4_, x0), __builtin_bit_cast(i32x4_, x1), 0, 1, 2, 3, 4, 5, 6, 7)
#define PG8_MMA(ai, bj, At, Bt) do { __builtin_amdgcn_s_setprio(1); if constexpr (F8) { _Pragma("unroll") for (int m = 0; m < 4; ++m) _Pragma("unroll") for (int n = 0; n < 2; ++n) \
        acc[ai][bj][m][n] = __builtin_amdgcn_mfma_scale_f32_16x16x128_f8f6f4(PG8_CAT8(Bt[n][0], Bt[n][1]), PG8_CAT8(At[m][0], At[m][1]), acc[ai][bj][m][n], 0, 0, 0, 0, 0, 0); } else { \
        _Pragma("unroll") for (int m = 0; m < 4; ++m) _Pragma("unroll") for (int n = 0; n < 2; ++n) _Pragma("unroll") for (int k = 0; k < 2; ++k) \
        acc[ai][bj][m][n] = __builtin_amdgcn_mfma_f32_16x16x32_bf16(Bt[n][k], At[m][k], acc[ai][bj][m][n], 0, 0, 0); } __builtin_amdgcn_s_setprio(0); } while (0)
#define PG8_WAIT_V(n) asm volatile("s_waitcnt vmcnt(" #n ")" ::: "memory")
#define PG8_WAIT_L(n) asm volatile("s_waitcnt lgkmcnt(" #n ")" ::: "memory")
#define PG8_BAR __builtin_amdgcn_s_barrier()
#define PG8_SCHED __builtin_amdgcn_sched_barrier(0)
    Unit cur, nxt; int ui = 0;
    if (!S.next(0, cur)) return;
    f32x4 acc[2][2][4][2];
#pragma unroll
    for (int a = 0; a < 2; ++a)
#pragma unroll
        for (int b = 0; b < 2; ++b)
#pragma unroll
            for (int m = 0; m < 4; ++m)
#pragma unroll
                for (int n = 0; n < 2; ++n) acc[a][b][m][n] = (f32x4){0.f, 0.f, 0.f, 0.f};
    bf16x8 At[4][2], B0[2][2], B1[2][2];
    const char* cA = (const char*)g.A + (size_t)cur.pm * tstep; const char* cB = (const char*)g.Bt + (size_t)cur.pn * tstep;
    S.a_ready(cur);
    if constexpr (SP2) {
        PG8_STAGE(PG8_SB(0, 0), cB, voffB); PG8_STAGE(PG8_SB(0, 1), cB + hstep, voffB); PG8_STAGE(PG8_SA(0, 0), cA, voffA); PG8_STAGE(PG8_SA(0, 1), cA + hstep, voffA);
        if (wr == 1) PG8_BAR;
        PG8_WAIT_V(2); PG8_BAR;
        PG8_STAGE(PG8_SB(1, 0), cB + kstep, voffB); PG8_STAGE(PG8_SA(1, 0), cA + kstep, voffA); PG8_STAGE(PG8_SB(1, 1), cB + hstep + kstep, voffB);
        PG8_WAIT_V(6); PG8_BAR;
    } else {
        PG8_STAGE(PG8_SB(0, 0), cB, voffB); PG8_STAGE(PG8_SA(0, 0), cA, voffA); PG8_STAGE(PG8_SB(0, 1), cB + hstep, voffB); PG8_STAGE(PG8_SA(0, 1), cA + hstep, voffA);
        if (wr == 1) PG8_BAR;
        PG8_WAIT_V(4); PG8_BAR;
        PG8_STAGE(PG8_SB(1, 0), cB + kstep, voffB); PG8_STAGE(PG8_SA(1, 0), cA + kstep, voffA); PG8_STAGE(PG8_SB(1, 1), cB + hstep + kstep, voffB);
        PG8_WAIT_V(6); PG8_BAR;
    }
    for (;;) {
        const bool has_next = S.next(ui + 1, nxt);
        const char* nA = has_next ? (const char*)g.A + (size_t)nxt.pm * tstep : cA; const char* nB = has_next ? (const char*)g.Bt + (size_t)nxt.pn * tstep : cB;
        for (int t = 0; t < nt; t += 2) {
            const bool last = (t == nt - 2);
            const char* a1 = cA + (size_t)(t + 1) * kstep;
            const char* a2 = last ? nA : cA + (size_t)(t + 2) * kstep; const char* b2 = last ? nB : cB + (size_t)(t + 2) * kstep;
            const char* a3 = a2 + kstep; const char* b3 = b2 + kstep;
            if (last && has_next) S.a_ready(nxt);
            if constexpr (SP2) {
            PG8_LDB(B0, 0, 0); PG8_LDB(B1, 0, 1); PG8_SCHED; PG8_LDA(At, 0, 0); PG8_STAGE(PG8_SA(1, 1), a1 + hstep, voffA);
            PG8_WAIT_V(8); PG8_WAIT_L(0); PG8_BAR; PG8_MMA(0, 0, At, B0); PG8_MMA(0, 1, At, B1); PG8_BAR; PG8_SCHED;
            PG8_LDA(At, 0, 1); PG8_STAGE(PG8_SB(0, 0), b2, voffB); PG8_STAGE(PG8_SB(0, 1), b2 + hstep, voffB); PG8_STAGE(PG8_SA(0, 0), a2, voffA);
            PG8_WAIT_V(8); PG8_WAIT_L(0); PG8_BAR; PG8_MMA(1, 0, At, B0); PG8_MMA(1, 1, At, B1); PG8_BAR; PG8_SCHED;
            PG8_LDB(B0, 1, 0); PG8_LDB(B1, 1, 1); PG8_SCHED; PG8_LDA(At, 1, 0); PG8_STAGE(PG8_SA(0, 1), a2 + hstep, voffA);
            PG8_WAIT_V(8); PG8_WAIT_L(0); PG8_BAR; PG8_MMA(0, 0, At, B0); PG8_MMA(0, 1, At, B1); PG8_BAR; PG8_SCHED;
            PG8_LDA(At, 1, 1); PG8_STAGE(PG8_SB(1, 0), b3, voffB); PG8_STAGE(PG8_SB(1, 1), b3 + hstep, voffB); PG8_STAGE(PG8_SA(1, 0), a3, voffA);
            PG8_WAIT_V(8); PG8_WAIT_L(0); PG8_BAR; PG8_MMA(1, 0, At, B0); PG8_MMA(1, 1, At, B1); PG8_BAR; PG8_SCHED;
            } else {
            PG8_LDB(B0, 0, 0); PG8_SCHED; PG8_LDA(At, 0, 0); PG8_STAGE(PG8_SA(1, 1), a1 + hstep, voffA);
            PG8_WAIT_L(8); PG8_BAR; PG8_WAIT_L(0); PG8_MMA(0, 0, At, B0); PG8_BAR; PG8_SCHED;
            PG8_LDB(B1, 0, 1); PG8_STAGE(PG8_SB(0, 0), b2, voffB);
            PG8_BAR; PG8_WAIT_L(0); PG8_MMA(0, 1, At, B1); PG8_BAR;
            PG8_LDA(At, 0, 1); PG8_STAGE(PG8_SA(0, 0), a2, voffA);
            PG8_BAR; PG8_WAIT_L(0); PG8_MMA(1, 0, At, B0); PG8_BAR; PG8_SCHED;
            PG8_STAGE(PG8_SB(0, 1), b2 + hstep, voffB);
            PG8_WAIT_V(6); PG8_BAR; PG8_MMA(1, 1, At, B1); PG8_BAR;
            PG8_LDB(B0, 1, 0); PG8_SCHED; PG8_LDA(At, 1, 0); PG8_STAGE(PG8_SA(0, 1), a2 + hstep, voffA);
            PG8_WAIT_L(8); PG8_BAR; PG8_WAIT_L(0); PG8_MMA(0, 0, At, B0); PG8_BAR; PG8_SCHED;
            PG8_LDB(B1, 1, 1); PG8_STAGE(PG8_SB(1, 0), b3, voffB);
            PG8_BAR; PG8_WAIT_L(0); PG8_MMA(0, 1, At, B1); PG8_BAR;
            PG8_LDA(At, 1, 1); PG8_STAGE(PG8_SA(1, 0), a3, voffA);
            PG8_BAR; PG8_WAIT_L(0); PG8_MMA(1, 0, At, B0); PG8_BAR; PG8_SCHED;
            PG8_STAGE(PG8_SB(1, 1), b3 + hstep, voffB);
            PG8_WAIT_V(6); PG8_BAR; PG8_MMA(1, 1, At, B1); PG8_BAR;
            }
        }
        if constexpr (ALIGN_EPI) { if (wr == 0) PG8_BAR; }
        if constexpr (!Epi::AFTER_DRAIN) { E(acc, cur, wr, wc, fr, fq); S.done(cur); }
        if (!has_next) break;
#pragma unroll
        for (int a = 0; a < 2; ++a)
#pragma unroll
            for (int b = 0; b < 2; ++b)
#pragma unroll
                for (int m = 0; m < 4; ++m)
#pragma unroll
                    for (int n = 0; n < 2; ++n) acc[a][b][m][n] = (f32x4){0.f, 0.f, 0.f, 0.f};
        cur = nxt; cA = nA; cB = nB; ++ui;
        if constexpr (ALIGN_EPI) { if (wr == 1) PG8_BAR; }
    }
    PG8_WAIT_V(0);
    if constexpr (!ALIGN_EPI) { if (wr == 0) PG8_BAR; }
    PG8_BAR;
    if constexpr (Epi::AFTER_DRAIN) { E.fused(acc, cur, wr, wc, fr, fq, lds, wid, lane); S.done(cur); }
#undef PG8_SA
#undef PG8_SB
#undef PG8_STAGE
#undef PG8_LDA
#undef PG8_LDB
#undef PG8_MMA
#undef PG8_CAT8
#undef PG8_WAIT_V
#undef PG8_WAIT_L
#undef PG8_BAR
#undef PG8_SCHED
}
}

#define GAS __attribute__((address_space(1)))
#define LAS __attribute__((address_space(3)))
typedef unsigned short bf16;
typedef unsigned v4u __attribute__((ext_vector_type(4)));
typedef unsigned v2u __attribute__((ext_vector_type(2)));
typedef float f32x4 __attribute__((ext_vector_type(4)));
typedef float f32x16 __attribute__((ext_vector_type(16)));
typedef short bf16x8 __attribute__((ext_vector_type(8)));
typedef short s16x4 __attribute__((ext_vector_type(4)));
typedef GAS unsigned gu32;
#define RLX_AGENT __ATOMIC_RELAXED, __HIP_MEMORY_SCOPE_AGENT
#define LDS_WAIT() asm volatile("s_waitcnt lgkmcnt(0)" ::: "memory")

#ifndef MK_NGRP
#define MK_NGRP 1
#endif
constexpr int D = 1024, NGRP = MK_NGRP, NB = 8 / NGRP, SEQ = 4096, CTXL = 256, TLAT = NB * SEQ, TCTX = NB * CTXL, TTOT = TLAT + TCTX;
constexpr int FF = 2816, NE = 8, MAXSLOT = 73728 / NGRP;
constexpr float EPS = 1e-6f;
constexpr int NWAVES = 8, NTHR = 512, GG = 256 / NGRP;
constexpr float LOG2E = 1.4426950408889634f;
constexpr float QSCALE = 0.125f * LOG2E;

enum { I_X = 0, I_C, I_CTX, I_CCTX, I_ADAW, I_ADAB, I_NMIX, I_NFFN, I_SCIN, I_SCCONV, I_SCOUT, I_DAQKV, I_DAOUT, I_DAQG, I_DAKG, I_DALAM, I_DASUB,
       I_CMIN, I_CMINB, I_CMVG, I_CMWS, I_CMBS, I_CMOUT, I_SWQKV, I_SWOUT, I_SWQG, I_SWKG, I_SWSINK, I_W1, I_W3, I_W2, I_RW, I_RB, I_MW1, I_MW3, I_MW2, N_IN };

constexpr size_t MiB = 1u << 20;
constexpr size_t WS_CTL = 0, CTL_ZERO_BYTES = 1 * MiB;
constexpr size_t WS_ZERO = 256 * 1024;
constexpr size_t WS_MOD = 1 * MiB;
constexpr size_t WS_RT = 2 * MiB;
constexpr size_t WS_WSB = 2 * MiB + 65536;
constexpr size_t WS_BIAS = 3 * MiB;
constexpr size_t BIAS_P6 = WS_BIAS, BIAS_P9 = BIAS_P6 + 9 * 5632 * 4, BIAS_P22 = BIAS_P9 + 9 * 3072 * 4, BIAS_P25 = BIAS_P22 + 9 * 5632 * 4;
constexpr size_t T_TOKG = (size_t)TTOT * 4, T_TOKS = T_TOKG + (size_t)TTOT * 8, T_SGATE = T_TOKS + (size_t)TTOT * 8, T_WGCNT = T_SGATE + (size_t)MAXSLOT * 4, T_PANEL = T_WGCNT + (size_t)GG * 32, T_END = T_PANEL + 4096;
static_assert(T_END <= 1 * MiB, "per-group token tables");
constexpr size_t WS_TOK = 4 * MiB, TOK_STRIDE = 1 * MiB;
constexpr size_t WS_SSQ = 6 * MiB, SSQ_STRIDE = (size_t)TTOT * 32 * 4;
constexpr size_t WS_HC = 11 * MiB;
constexpr size_t WS_W = 19 * MiB;
constexpr size_t W_SCIN = WS_W, W_SCOUT = W_SCIN + 6 * MiB, W_DAQKV = W_SCOUT + 2 * MiB, W_DAOUT = W_DAQKV + 6 * MiB, W_CMIN = W_DAOUT + 2 * MiB, W_CMOUT = W_CMIN + 8 * MiB,
                 W_SWQKV = W_CMOUT + 4 * MiB, W_SWOUT = W_SWQKV + 3 * MiB, W_F13 = W_SWOUT + 2 * MiB  , W_F2 = W_F13 + 22 * MiB  , W_MOE = W_F2 + 11 * MiB,
                 W_MOE_STRIDE = 132 * MiB  , W_END = W_MOE + 2 * W_MOE_STRIDE;
static_assert(W_END == 349 * MiB, "weight map");
static_assert(WS_ZERO + 512 * 1024 <= CTL_ZERO_BYTES && BIAS_P25 + 9 * 1536 * 4 <= WS_TOK && WS_SSQ + NGRP * SSQ_STRIDE <= WS_HC && WS_HC + (size_t)NGRP * TCTX * 4096 <= WS_W, "small-buffer map");
constexpr size_t WS_S = 349 * MiB, S_STRIDE = (size_t)MAXSLOT * 1024 * 2;
constexpr size_t WS_H = WS_S + NGRP * S_STRIDE, H_STRIDE = (size_t)MAXSLOT * 2816 * 2;
constexpr size_t A_IN_H = (size_t)TTOT * 4096 * 2;
constexpr size_t WS_END = WS_H + NGRP * H_STRIDE;
static_assert(WS_END == 889 * MiB && (size_t)TTOT * 4096 * 2 <= A_IN_H && A_IN_H + (size_t)TTOT * 1024 * 2 <= H_STRIDE && (size_t)TTOT * 2048 * 2 <= S_STRIDE, "ws map");

constexpr int CW_BAR = 4096;
constexpr int CW_FLAG_DENSE = 64, CW_FLAG_MOE = 128;

constexpr int RING_BYTES = 131072;
constexpr int PERS_OFF = RING_BYTES;
constexpr int MISC_OFF = PERS_OFF + 4096;
constexpr int LDS_BYTES = 147456;

__device__ __forceinline__ unsigned f2bf(float f) { unsigned u = __builtin_bit_cast(unsigned, f); return (u + 0x7fffu + ((u >> 16) & 1u)) >> 16; }
__device__ __forceinline__ unsigned pk2(float lo, float hi) { unsigned r; asm volatile("v_cvt_pk_bf16_f32 %0, %1, %2" : "=v"(r) : "v"(lo), "v"(hi)); return r; }
__device__ __forceinline__ float bflo(unsigned u) { return __builtin_bit_cast(float, u << 16); }
__device__ __forceinline__ float bfhi(unsigned u) { return __builtin_bit_cast(float, u & 0xffff0000u); }
constexpr int HPITCH = 2048;
__device__ __forceinline__ float wave_sum(float v) {
#pragma unroll
    for (int o = 1; o < 64; o <<= 1) v += __shfl_xor(v, o);
    return v;
}
#define XB_TMO      128
#define XB_XCNT(j)  (256  + 64 * (j))
#define XB_XSUB(j)  (1280 + 64 * (j))
#define XB_XGEN(j)  (2304 + 64 * (j))
#define XB_TOP      3328
#define XB_TOPGEN   3392
#define XCD_BAR_WORDS 3456
#define XB_SPIN_CAP (1u << 18)

__device__ __forceinline__ unsigned xb_ld(unsigned* p)              { return __hip_atomic_load(p, __ATOMIC_RELAXED, __HIP_MEMORY_SCOPE_AGENT); }
__device__ __forceinline__ unsigned xb_add(unsigned* p, unsigned v) { return __hip_atomic_fetch_add(p, v, __ATOMIC_RELAXED, __HIP_MEMORY_SCOPE_AGENT); }
__device__ __forceinline__ unsigned xb_xcc_id() { return (unsigned)__builtin_amdgcn_s_getreg((3 << 11) | 20) & 0xFu; }
#define XB_SPIN(cond, bar) do { unsigned _sp = 0; while (cond) { __builtin_amdgcn_s_sleep(1); \
    if ((++_sp & 255u) == 0u) { if (xb_ld(&(bar)[XB_TMO])) break; if (_sp > XB_SPIN_CAP) { atomicAdd(&(bar)[XB_TMO], 1u); break; } } } } while (0)

struct XcdBarrier {
    unsigned* bar; unsigned x; unsigned gsz;
    volatile LAS unsigned* st;
};

__device__ __forceinline__ XcdBarrier xcd_barrier_post(unsigned* bar, volatile LAS unsigned* st, unsigned gsz) {
    XcdBarrier b; b.bar = bar; b.x = xb_xcc_id(); b.st = st; b.gsz = gsz;
    if (threadIdx.x == 0) (void)xb_add(&bar[XB_XCNT(b.x)], 1u);
    return b;
}
__device__ __forceinline__ void xcd_barrier_complete(unsigned* bar, unsigned x, unsigned& nloc, unsigned& nx, unsigned G) {
    unsigned sum, cnt, mine, sp = 0u;
    for (;;) {
        sum = 0u; cnt = 0u; mine = 0u;
#pragma unroll
        for (unsigned j = 0; j < 16; ++j) { const unsigned c = xb_ld(&bar[XB_XCNT(j)]); sum += c; cnt += (c > 0u) ? 1u : 0u; mine = (j == x) ? c : mine; }
        if (sum == G) break;
        __builtin_amdgcn_s_sleep(1);
        if ((++sp & 255u) == 0u) { if (xb_ld(&bar[XB_TMO])) break; if (sp > XB_SPIN_CAP) { atomicAdd(&bar[XB_TMO], 1u); break; } }
    }
    nloc = mine > 0u ? mine : 1u; nx = cnt > 0u ? cnt : 1u;
}

__device__ __forceinline__ void xcd_barrier(const XcdBarrier& b) {
    asm volatile("s_waitcnt vmcnt(0)" ::: "memory");
    __syncthreads();
    if (threadIdx.x == 0) {
        unsigned* bar = b.bar;
        __builtin_amdgcn_s_waitcnt(0);
        unsigned nloc = b.st[0], nx = b.st[1];
        if (nloc == 0u) { xcd_barrier_complete(bar, b.x, nloc, nx, b.gsz); b.st[0] = nloc; b.st[1] = nx; }
        const unsigned old = xb_add(&bar[XB_XSUB(b.x)], 1u);
        const unsigned gen = old / nloc;
        if (old + 1u == (gen + 1u) * nloc) {
            __builtin_amdgcn_fence(__ATOMIC_RELEASE, "agent");
            asm volatile("s_waitcnt vmcnt(0)" ::: "memory");
            const unsigned og = xb_add(&bar[XB_TOP], 1u);
            const unsigned tg = og / nx;
            if (og + 1u == (tg + 1u) * nx) xb_add(&bar[XB_TOPGEN], 1u);
            else XB_SPIN(xb_ld(&bar[XB_TOPGEN]) == tg, bar);
            __builtin_amdgcn_fence(__ATOMIC_ACQUIRE, "agent");
            xb_add(&bar[XB_XGEN(b.x)], 1u);
            asm volatile("s_waitcnt vmcnt(0)" ::: "memory");
        } else {
            XB_SPIN(xb_ld(&bar[XB_XGEN(b.x)]) == gen, bar);
            __builtin_amdgcn_fence(__ATOMIC_ACQUIRE, "agent");
            asm volatile("s_waitcnt vmcnt(0)" ::: "memory");
        }
    }
    __syncthreads();
}

struct Args { const float* in[N_IN]; float* out; unsigned char* ws; int ph_lo, ph_hi; };
struct Grp {
    const float* x; const float* ctx; float* out; float* hc; bf16* A; bf16* S; bf16* H;
    int* toke; float* tokg; int* toks; float* sgate; int* wgcnt; int* panel; float* ssq; int b0;
};

template <bool RP = false> __device__ __forceinline__ void transpose_item(const float* __restrict__ W, int K, int N, bf16* WT, int k0, int n0, int drow0, LAS float* scr, int lane) {
    { f32x4 v[8]; const int r8 = lane >> 3, c4 = lane & 7;
#pragma unroll
      for (int i = 0; i < 8; ++i) v[i] = *(const f32x4*)(W + (size_t)(k0 + 8 * i + r8) * N + n0 + 4 * c4);
#pragma unroll
      for (int i = 0; i < 8; ++i) { LAS float* d = scr + (8 * i + r8) * 33 + 4 * c4; d[0] = v[i].x; d[1] = v[i].y; d[2] = v[i].z; d[3] = v[i].w; } }
    LDS_WAIT(); asm volatile("" ::: "memory");
    const int c = lane & 7;
#pragma unroll
    for (int j = 0; j < 4; ++j) { const int n = (lane >> 3) + 8 * j; const LAS float* s = scr + (8 * c) * 33 + n;
        v4u o; o.x = f2bf(s[0 * 33]) | (f2bf(s[1 * 33]) << 16); o.y = f2bf(s[2 * 33]) | (f2bf(s[3 * 33]) << 16); o.z = f2bf(s[4 * 33]) | (f2bf(s[5 * 33]) << 16); o.w = f2bf(s[6 * 33]) | (f2bf(s[7 * 33]) << 16);
        const int dn = RP ? (8 * ((n & 15) >> 2) + 4 * (n >> 4) + (n & 3)) : n;
        *(GAS v4u*)(WT + (size_t)(drow0 + dn) * K + k0 + 8 * c) = o; }
    LDS_WAIT(); asm volatile("" ::: "memory");
}
__device__ __forceinline__ void transpose_item8(const float* __restrict__ W, int K, int N, unsigned char* WT8, int k0, int n0, int drow0, float sc, LAS float* scr, int lane) {
    { f32x4 v[8]; const int r8 = lane >> 3, c4 = lane & 7;
#pragma unroll
      for (int i = 0; i < 8; ++i) v[i] = *(const f32x4*)(W + (size_t)(k0 + 8 * i + r8) * N + n0 + 4 * c4);
#pragma unroll
      for (int i = 0; i < 8; ++i) { LAS float* d = scr + (8 * i + r8) * 33 + 4 * c4; d[0] = v[i].x; d[1] = v[i].y; d[2] = v[i].z; d[3] = v[i].w; } }
    LDS_WAIT(); asm volatile("" ::: "memory");
    const int c = lane & 7;
#pragma unroll
    for (int j = 0; j < 4; ++j) { const int n = (lane >> 3) + 8 * j; const LAS float* s = scr + (8 * c) * 33 + n;
        v2u o; o.x = pg8::cvt_pk_fp8x4(s[0 * 33] * sc, s[1 * 33] * sc, s[2 * 33] * sc, s[3 * 33] * sc); o.y = pg8::cvt_pk_fp8x4(s[4 * 33] * sc, s[5 * 33] * sc, s[6 * 33] * sc, s[7 * 33] * sc);
        *(GAS v2u*)(WT8 + (size_t)(drow0 + n) * K + k0 + 8 * c) = o; }
    LDS_WAIT(); asm volatile("" ::: "memory");
}
template <int MODE> __device__ __forceinline__ void conv_item8(const float* W, int K, int N, unsigned char* WT8, int r, float sc, LAS float* scr, int lane) {
    const int nblk = N / 32, kb = r / nblk, nb = r % nblk, n0 = nb * 32;
    const int drow = (MODE == 0) ? n0 : ((n0 >> 7) * 256 + (n0 & 127) + (MODE == 2 ? 128 : 0));
    transpose_item8(W, K, N, WT8, kb * 64, n0, drow, sc, scr, lane);
}
template <int MODE> __device__ __forceinline__ void conv_item(const float* W, int K, int N, bf16* WT, int r, LAS float* scr, int lane, int nqk = 0) {
    const int nblk = N / 32, kb = r / nblk, nb = r % nblk, n0 = nb * 32;
    int drow = (MODE == 0) ? n0 : ((n0 >> 7) * 256 + (n0 & 127) + (MODE == 2 ? 128 : 0));
    if (MODE == 4) drow = (n0 < 1024) ? n0 : (1024 + (((n0 - 1024) & 1023) >> 7) * 256 + (n0 >= 2048 ? 128 : 0) + (n0 & 127));
    if (MODE == 3) { drow = (n0 < nqk) ? ((n0 >> 8) * 256 + ((n0 >> 5) & 1) * 128 + ((n0 >> 6) & 3) * 32) : n0;
        if (n0 < nqk) { transpose_item<true>(W, K, N, WT, kb * 64, n0, drow, scr, lane); return; } }
    transpose_item(W, K, N, WT, kb * 64, n0, drow, scr, lane);
}
constexpr bool D0_IN8 = true, D0_H8 = true;
constexpr bool D2_8 = true;
constexpr bool MOE8_L[2] = {true, true};
using pg8::F8_SA; using pg8::F8_SW13; using pg8::F8_SW2; using pg8::F8_SAU;
__device__ __forceinline__ void conv_moe(const Args& a, int f, LAS unsigned char* lds, int gw, int ngw, int wave, int lane, int it_lo = 0, int it_hi = NE * 3 * 1408) {
    LAS float* scr = (LAS float*)(lds + wave * 16384);
    constexpr int PER = 1408;
    bf16* w13 = (bf16*)(a.ws + W_MOE + (size_t)f * W_MOE_STRIDE); bf16* w2 = (bf16*)(a.ws + W_MOE + (size_t)f * W_MOE_STRIDE + 88 * MiB);
    for (int it = it_lo + gw; it < it_hi; it += ngw) {
        const int e = it / (3 * PER), rem = it % (3 * PER), which = rem / PER, r = rem % PER;
        const size_t eo = ((size_t)f * NE + e) * 1024 * 2816;
        if (MOE8_L[f]) {
            unsigned char* w13b = (unsigned char*)w13; unsigned char* w2b = (unsigned char*)w2;
            if (which == 0)      conv_item8<1>(a.in[I_MW1] + eo, 1024, 2816, w13b + (size_t)e * 5632 * 1024, r, F8_SW13, scr, lane);
            else if (which == 1) conv_item8<2>(a.in[I_MW3] + eo, 1024, 2816, w13b + (size_t)e * 5632 * 1024, r, F8_SW13, scr, lane);
            else                 conv_item8<0>(a.in[I_MW2] + eo, 2816, 1024, w2b + (size_t)e * 1024 * 2816, r, F8_SW2, scr, lane);
            continue; }
        if (which == 0)      conv_item<1>(a.in[I_MW1] + eo, 1024, 2816, w13 + (size_t)e * 5632 * 1024, r, scr, lane);
        else if (which == 1) conv_item<2>(a.in[I_MW3] + eo, 1024, 2816, w13 + (size_t)e * 5632 * 1024, r, scr, lane);
        else                 conv_item<0>(a.in[I_MW2] + eo, 2816, 1024, w2 + (size_t)e * 1024 * 2816, r, scr, lane);
    }
}
__device__ __forceinline__ void conv_dense(const Args& a, LAS unsigned char* lds, int gw, int ngw, int wave, int lane) {
    LAS float* scr = (LAS float*)(lds + wave * 16384);
    constexpr int N_SCIN = 16 * 96, N_1K = 16 * 32, N_CMIN = 16 * 128, N_CMOUT = 32 * 32, N_SWQKV = 16 * 48, N_FF = 1408;
    constexpr int TOTAL = N_SCIN + N_1K + N_SCIN + N_1K + N_CMIN + N_CMOUT + N_SWQKV + N_1K + 6 * N_FF;
    unsigned char* ws = a.ws;
    for (int it = gw; it < TOTAL; it += ngw) {
        int r = it;
        if (r < N_SCIN) { conv_item<4>(a.in[I_SCIN], 1024, 3072, (bf16*)(ws + W_SCIN), r, scr, lane); continue; } r -= N_SCIN;
        if (r < N_1K) { conv_item<0>(a.in[I_SCOUT], 1024, 1024, (bf16*)(ws + W_SCOUT), r, scr, lane); continue; } r -= N_1K;
        if (r < N_SCIN) { conv_item<3>(a.in[I_DAQKV], 1024, 3072, (bf16*)(ws + W_DAQKV), r, scr, lane, 2048); continue; } r -= N_SCIN;
        if (r < N_1K) { conv_item<0>(a.in[I_DAOUT], 1024, 1024, (bf16*)(ws + W_DAOUT), r, scr, lane); continue; } r -= N_1K;
        if (r < N_CMIN) { conv_item<0>(a.in[I_CMIN], 1024, 4096, (bf16*)(ws + W_CMIN), r, scr, lane); continue; } r -= N_CMIN;
        if (r < N_CMOUT) { conv_item<0>(a.in[I_CMOUT], 2048, 1024, (bf16*)(ws + W_CMOUT), r, scr, lane); continue; } r -= N_CMOUT;
        if (r < N_SWQKV) { conv_item<3>(a.in[I_SWQKV], 1024, 1536, (bf16*)(ws + W_SWQKV), r, scr, lane, 1280); continue; } r -= N_SWQKV;
        if (r < N_1K) { conv_item<0>(a.in[I_SWOUT], 1024, 1024, (bf16*)(ws + W_SWOUT), r, scr, lane); continue; } r -= N_1K;
        const int f = r / (3 * N_FF), rem = r % (3 * N_FF), which = rem / N_FF, rr = rem % N_FF; const size_t fo = (size_t)f * 1024 * 2816;
        if ((which < 2) ? (f == 0 ? D0_IN8 : D2_8) : (f == 0 ? D0_H8 : D2_8)) {
            unsigned char* w13b = ws + W_F13 + (size_t)f * 5632 * 1024 * 2; unsigned char* w2b = ws + W_F2 + (size_t)f * 1024 * 2816 * 2;
            if (which == 0)      conv_item8<1>(a.in[I_W1] + fo, 1024, 2816, w13b, rr, F8_SW13, scr, lane);
            else if (which == 1) conv_item8<2>(a.in[I_W3] + fo, 1024, 2816, w13b, rr, F8_SW13, scr, lane);
            else                 conv_item8<0>(a.in[I_W2] + fo, 2816, 1024, w2b, rr, F8_SW2, scr, lane);
            continue; }
        if (which == 0)      conv_item<1>(a.in[I_W1] + fo, 1024, 2816, (bf16*)(ws + W_F13) + (size_t)f * 5632 * 1024, rr, scr, lane);
        else if (which == 1) conv_item<2>(a.in[I_W3] + fo, 1024, 2816, (bf16*)(ws + W_F13) + (size_t)f * 5632 * 1024, rr, scr, lane);
        else                 conv_item<0>(a.in[I_W2] + fo, 2816, 1024, (bf16*)(ws + W_F2) + (size_t)f * 1024 * 2816, rr, scr, lane);
    }
}
__device__ __forceinline__ void adaln_phase(const Args& a, LAS unsigned char* lds, int vcu, int G, int tid) {
    LAS float* sl = (LAS float*)lds;
    LAS float* red = sl + 9 * 1024;
    for (int i = tid; i < 9 * 1024; i += NTHR) { const float cv = (i < 8192) ? a.in[I_C][i] : a.in[I_CCTX][i - 8192]; sl[i] = cv / (1.0f + __expf(-cv)); }
    __syncthreads();
    float* MOD = (float*)(a.ws + WS_MOD);
    const int c4 = tid & 63, kg = tid >> 6;
    for (int u = vcu; u < 4 * 24; u += G) {
        const int l = u / 24, n0 = (u % 24) * 256;
        const float* w = a.in[I_ADAW] + (size_t)l * 1024 * 6144 + n0 + 4 * c4;
        f32x4 acc[9];
#pragma unroll
        for (int ci = 0; ci < 9; ++ci) acc[ci] = (f32x4){0.f, 0.f, 0.f, 0.f};
#pragma unroll 1
        for (int k0 = kg * 128; k0 < kg * 128 + 128; k0 += 8) { f32x4 wv[8];
#pragma unroll
            for (int j = 0; j < 8; ++j) wv[j] = *(const f32x4*)(w + (size_t)(k0 + j) * 6144);
#pragma unroll
            for (int j = 0; j < 8; ++j)
#pragma unroll
                for (int ci = 0; ci < 9; ++ci) acc[ci] += wv[j] * sl[ci * 1024 + k0 + j]; }
#pragma unroll
        for (int ci = 0; ci < 9; ++ci) *(LAS f32x4*)(red + (kg * 9 + ci) * 256 + 4 * c4) = acc[ci];
        __syncthreads();
        for (int o = tid; o < 9 * 256; o += NTHR) { const int ci = o >> 8, cc = o & 255; float s = a.in[I_ADAB][l * 6144 + n0 + cc];
#pragma unroll
            for (int k2 = 0; k2 < 8; ++k2) s += red[(k2 * 9 + ci) * 256 + cc];
            MOD[(size_t)(l * 9 + ci) * 6144 + n0 + cc] = s; }
        __syncthreads();
    }
}
__device__ __forceinline__ void rope_table(const Args& a, int tid) {
    float* RT = (float*)(a.ws + WS_RT);
    for (int i = tid; i < 1024; i += NTHR) {
        const int p = i >> 4, f = i & 15;
        double inv = 1.0; for (int j = 0; j < f; ++j) inv *= 0.56234132519034908;
        const float ang = (float)p * (float)inv;
        const double x = (double)ang;
        const double kq = __builtin_rint(x * 0.63661977236758134);
        const double r = (x - kq * 1.5707963267948966) - kq * 6.123233995736766e-17;
        const double r2 = r * r;
        double sn = 1.0, cs = 1.0;
        sn = 1.0 - r2 / (18.0 * 19.0) * sn; sn = 1.0 - r2 / (16.0 * 17.0) * sn; sn = 1.0 - r2 / (14.0 * 15.0) * sn; sn = 1.0 - r2 / (12.0 * 13.0) * sn; sn = 1.0 - r2 / (10.0 * 11.0) * sn;
        sn = 1.0 - r2 / (8.0 * 9.0) * sn; sn = 1.0 - r2 / (6.0 * 7.0) * sn; sn = 1.0 - r2 / (4.0 * 5.0) * sn; sn = 1.0 - r2 / (2.0 * 3.0) * sn; sn *= r;
        cs = 1.0 - r2 / (17.0 * 18.0) * cs; cs = 1.0 - r2 / (15.0 * 16.0) * cs; cs = 1.0 - r2 / (13.0 * 14.0) * cs; cs = 1.0 - r2 / (11.0 * 12.0) * cs; cs = 1.0 - r2 / (9.0 * 10.0) * cs;
        cs = 1.0 - r2 / (7.0 * 8.0) * cs; cs = 1.0 - r2 / (5.0 * 6.0) * cs; cs = 1.0 - r2 / (3.0 * 4.0) * cs; cs = 1.0 - r2 / (1.0 * 2.0) * cs;
        const int q = ((int)kq) & 3;
        const double c = (q == 0) ? cs : (q == 1) ? -sn : (q == 2) ? -cs : sn;
        const double s = (q == 0) ? sn : (q == 1) ? cs : (q == 2) ? -sn : -cs;
        RT[2 * i] = (float)c; RT[2 * i + 1] = (float)s;
    }
}

__device__ __forceinline__ void bias_rows(const bf16* Wt, int N, const float* sh  , float* B, int first, int gw, int ngw, int lane) {
    for (int n = gw - first; n < N; n += ngw) { if (n < 0) continue;
        const v4u w0 = ((const v4u*)(Wt + (size_t)n * 1024))[lane], w1 = ((const v4u*)(Wt + (size_t)n * 1024))[lane + 64];
        const float wf[16] = {bflo(w0.x), bfhi(w0.x), bflo(w0.y), bfhi(w0.y), bflo(w0.z), bfhi(w0.z), bflo(w0.w), bfhi(w0.w), bflo(w1.x), bfhi(w1.x), bflo(w1.y), bfhi(w1.y), bflo(w1.z), bfhi(w1.z), bflo(w1.w), bfhi(w1.w)};
#pragma unroll 1
        for (int ci = 0; ci < 9; ++ci) { const f32x4* sp = (const f32x4*)(sh + (size_t)ci * 6144); const f32x4 a = sp[2 * lane], b = sp[2 * lane + 1], c = sp[128 + 2 * lane], d = sp[128 + 2 * lane + 1];
            float t = (a.x * wf[0] + a.y * wf[1]) + (a.z * wf[2] + a.w * wf[3]) + (b.x * wf[4] + b.y * wf[5]) + (b.z * wf[6] + b.w * wf[7]) + (c.x * wf[8] + c.y * wf[9]) + (c.z * wf[10] + c.w * wf[11]) + (d.x * wf[12] + d.y * wf[13]) + (d.z * wf[14] + d.w * wf[15]);
            t = wave_sum(t); if (lane == 0) B[(size_t)ci * N + n] = t; }
    }
}
__device__ __forceinline__ void bias_rows8(const unsigned char* Wt8, int N, float winv, const float* sh, float* B, int gw, int ngw, int lane) {
    typedef float f32x2_ __attribute__((ext_vector_type(2)));
    for (int n = gw; n < N; n += ngw) {
        const v4u w = ((const v4u*)(Wt8 + (size_t)n * 1024))[lane];
        float wf[16];
#pragma unroll
        for (int q = 0; q < 4; ++q) { const int wd = (int)(q == 0 ? w.x : q == 1 ? w.y : q == 2 ? w.z : w.w);
            const f32x2_ lo = __builtin_amdgcn_cvt_pk_f32_fp8(wd, false), hi = __builtin_amdgcn_cvt_pk_f32_fp8(wd, true); wf[4 * q] = lo.x; wf[4 * q + 1] = lo.y; wf[4 * q + 2] = hi.x; wf[4 * q + 3] = hi.y; }
#pragma unroll 1
        for (int ci = 0; ci < 9; ++ci) { const f32x4* sp = (const f32x4*)(sh + (size_t)ci * 6144); const f32x4 a = sp[4 * lane], b = sp[4 * lane + 1], c = sp[4 * lane + 2], d = sp[4 * lane + 3];
            float t = (a.x * wf[0] + a.y * wf[1]) + (a.z * wf[2] + a.w * wf[3]) + (b.x * wf[4] + b.y * wf[5]) + (b.z * wf[6] + b.w * wf[7]) + (c.x * wf[8] + c.y * wf[9]) + (c.z * wf[10] + c.w * wf[11]) + (d.x * wf[12] + d.y * wf[13]) + (d.z * wf[14] + d.w * wf[15]);
            t = wave_sum(t); if (lane == 0) B[(size_t)ci * N + n] = t * winv; }
    }
}
__device__ __forceinline__ void bias_phase(const Args& a, int gw, int ngw, int lane) {
    const float* MOD = (const float*)(a.ws + WS_MOD);
    if (D0_IN8) bias_rows8(a.ws + W_F13, 5632, 1.0f / F8_SW13, MOD + 0 * 9 * 6144 + 3072, (float*)(a.ws + BIAS_P6), gw, ngw, lane);
    else bias_rows((const bf16*)(a.ws + W_F13), 5632, MOD + 0 * 9 * 6144 + 3072, (float*)(a.ws + BIAS_P6), 0, gw, ngw, lane);
    bias_rows((const bf16*)(a.ws + W_DAQKV), 3072, MOD + 1 * 9 * 6144 + 0, (float*)(a.ws + BIAS_P9), 0, gw, ngw, lane);
    if (D2_8) bias_rows8(a.ws + W_F13 + (size_t)5632 * 1024 * 2, 5632, 1.0f / F8_SW13, MOD + 2 * 9 * 6144 + 3072, (float*)(a.ws + BIAS_P22), gw, ngw, lane);
    else bias_rows((const bf16*)(a.ws + W_F13) + (size_t)5632 * 1024, 5632, MOD + 2 * 9 * 6144 + 3072, (float*)(a.ws + BIAS_P22), 0, gw, ngw, lane);
    bias_rows((const bf16*)(a.ws + W_SWQKV), 1536, MOD + 3 * 9 * 6144 + 0, (float*)(a.ws + BIAS_P25), 0, gw, ngw, lane);
}

template <bool COMBINE, bool NORM, bool ROUTER, bool SRC32, bool OUT32, bool A8 = false>
__device__ __forceinline__ void row_phase(const Args& a, const Grp& c, LAS unsigned char* lds, const void* src_lat, const void* src_ctx, void* dst_lat, void* dst_ctx, int nrows,
                                          const float* gn, const float* mod  , int sh_off  , const float* mod_prev_g2  ,
                                          const float* rw, const float* rb, int vcu, int G, int tid, int wave, int lane) {
    LAS float* wrT = (LAS float*)lds;
    LAS int* hist = (LAS int*)(lds + 32768);
    if (ROUTER) {
        for (int i = tid; i < 8192; i += NTHR) { const int k = i >> 3, e = i & 7; wrT[e * 1024 + k] = rw[i]; }
        if (tid < 8) hist[tid] = 0;
        __syncthreads();
    }
    bf16* A = c.A;
    const bf16* Y = c.S;
    const int* toks = c.toks;
    int* toke = c.toke; float* tokg = c.tokg;
    f32x4 gv[4];
    if (NORM) {
#pragma unroll
        for (int j = 0; j < 4; ++j) gv[j] = ((const f32x4*)gn)[lane + 64 * j];
    }
    const int gw = vcu * NWAVES + wave, ngw = G * NWAVES;
    struct RowRegs { f32x4 v[4]; v2u hraw[4]; v2u q0[4], q1[4]; };
    auto ld = [&](const int m, RowRegs& r) __attribute__((always_inline)) {
        const bool lat = m < TLAT;
        if (SRC32) { const float* hr = lat ? (const float*)src_lat + (size_t)m * 1024 : (const float*)src_ctx + (size_t)(m - TLAT) * 1024;
#pragma unroll
            for (int j = 0; j < 4; ++j) r.v[j] = ((const f32x4*)hr)[lane + 64 * j];
        } else { const bf16* hr = lat ? (const bf16*)src_lat + (size_t)m * HPITCH : (const bf16*)src_ctx + (size_t)(m - TLAT) * HPITCH;
#pragma unroll
            for (int j = 0; j < 4; ++j) r.hraw[j] = ((const v2u*)hr)[lane + 64 * j];
        }
        if (COMBINE) {
            const int s0 = toks[2 * m], s1 = toks[2 * m + 1];
            const v2u* y0 = (const v2u*)(Y + (size_t)s0 * 1024); const v2u* y1 = (const v2u*)(Y + (size_t)s1 * 1024);
#pragma unroll
            for (int j = 0; j < 4; ++j) { r.q0[j] = y0[lane + 64 * j]; r.q1[j] = y1[lane + 64 * j]; }
        }
    };
    auto body = [&](const int m, RowRegs& r) __attribute__((always_inline)) {
        const bool lat = m < TLAT; const int cidx = lat ? c.b0 + (m >> 12) : 8;
        f32x4 (&v)[4] = r.v;
        if (!SRC32) {
#pragma unroll
            for (int j = 0; j < 4; ++j) { const v2u p = r.hraw[j]; v[j] = f32x4{bflo(p.x), bfhi(p.x), bflo(p.y), bfhi(p.y)}; }
        }
        if (COMBINE) {
            const f32x4* g2 = (const f32x4*)(mod_prev_g2 + (size_t)cidx * 6144);
            float* hw32 = (float*)dst_lat + (size_t)m * 1024;
            bf16* hw = lat ? (bf16*)dst_lat + (size_t)m * HPITCH : (bf16*)dst_ctx + (size_t)(m - TLAT) * HPITCH;
            if (OUT32) asm volatile("" ::: "memory");
#pragma unroll
            for (int j = 0; j < 4; ++j) { const v2u p0 = r.q0[j], p1 = r.q1[j]; const f32x4 g = g2[lane + 64 * j];
                f32x4 ys; ys.x = bflo(p0.x) + bflo(p1.x); ys.y = bfhi(p0.x) + bfhi(p1.x); ys.z = bflo(p0.y) + bflo(p1.y); ys.w = bfhi(p0.y) + bfhi(p1.y);
                v[j] = v[j] + g * ys;
                if (OUT32) ((f32x4*)hw32)[lane + 64 * j] = v[j]; else { v2u o; o.x = pk2(v[j].x, v[j].y); o.y = pk2(v[j].z, v[j].w); ((v2u*)hw)[lane + 64 * j] = o; } }
        }
        if (NORM) {
            float ss = 0.f;
#pragma unroll
            for (int j = 0; j < 4; ++j) ss += (v[j].x * v[j].x + v[j].y * v[j].y) + (v[j].z * v[j].z + v[j].w * v[j].w);
            const float rstd = 1.0f / sqrtf(wave_sum(ss) * (1.0f / 1024.0f) + EPS);
            const f32x4* shp = (const f32x4*)(mod + (size_t)cidx * 6144 + sh_off); const f32x4* scp = shp + 256;
            v2u* ar = (v2u*)(A + (size_t)m * 1024);
#pragma unroll
            for (int j = 0; j < 4; ++j) { const f32x4 sh = shp[lane + 64 * j], sc = scp[lane + 64 * j];
                v[j] = (v[j] * rstd * gv[j]) * (sc + 1.0f) + sh;
                if (A8) ((unsigned*)((unsigned char*)A + (size_t)m * 1024))[lane + 64 * j] = pg8::cvt_pk_fp8x4(v[j].x * F8_SA, v[j].y * F8_SA, v[j].z * F8_SA, v[j].w * F8_SA);
                else { v2u o; o.x = pk2(v[j].x, v[j].y); o.y = pk2(v[j].z, v[j].w); ar[lane + 64 * j] = o; } }
            if (ROUTER) {
                float lg[8];
#pragma unroll
                for (int e = 0; e < 8; ++e) { float s = 0.f;
#pragma unroll
                    for (int j = 0; j < 4; ++j) { const f32x4 w = ((const LAS f32x4*)(wrT + e * 1024))[lane + 64 * j]; s += (v[j].x * w.x + v[j].y * w.y) + (v[j].z * w.z + v[j].w * w.w); }
                    lg[e] = wave_sum(s) + rb[e]; }
                int i0 = 0; float v0 = lg[0];
#pragma unroll
                for (int e = 1; e < 8; ++e) if (lg[e] > v0) { v0 = lg[e]; i0 = e; }
                int i1 = -1; float v1 = -INFINITY;
#pragma unroll
                for (int e = 0; e < 8; ++e) if (e != i0 && lg[e] > v1) { v1 = lg[e]; i1 = e; }
                const float ex = __expf(v1 - v0); const float g0 = 1.0f / (1.0f + ex), g1 = ex * g0;
                if (lane == 0) { toke[m] = i0 | (i1 << 8); tokg[2 * m] = g0; tokg[2 * m + 1] = g1; atomicAdd((int*)(hist + i0), 1); atomicAdd((int*)(hist + i1), 1); }
            }
        }
    };
    for (int m = gw; m < nrows; m += 2 * ngw) {
        RowRegs ra, rb; const int mb = m + ngw; const bool hb = mb < nrows;
        ld(m, ra); ld(hb ? mb : m, rb);
        body(m, ra); if (hb) body(mb, rb);
    }
    if (ROUTER) { __syncthreads(); if (tid < 8) c.wgcnt[vcu * 8 + tid] = hist[tid]; }
}

template <bool A8>
__device__ __forceinline__ void moe_scatter_phase(const Grp& c, LAS unsigned char* lds, int nrows, int vcu, int G, int tid, int wave, int lane) {
    LAS int* cnt = (LAS int*)lds;
    LAS int* base = cnt + 2048;
    LAS int* tot = base + 8;
    LAS int* slots = tot + 8;
    const int* wg = c.wgcnt;
    for (int i = tid; i < GG * 8; i += NTHR) cnt[i] = wg[i];
    __syncthreads();
    if (tid < 8) { int t = 0, b = 0; for (int w = 0; w < G; ++w) { const int c = cnt[w * 8 + tid]; if (w < vcu) b += c; t += c; } tot[tid] = t; base[tid] = b; }
    __syncthreads();
    if (tid == 0) { int ps = 0; int* pan = c.panel; int np = 0;
        for (int e = 0; e < 8; ++e) { const int t = tot[e]; base[e] += ps; const int npe = (t + 255) >> 8;
            if (vcu == 0) for (int p = 0; p < npe; ++p) pan[1 + np + p] = e;
            np += npe; ps += npe * 256; }
        if (vcu == 0) pan[0] = np; }
    __syncthreads();
    const int* toke = c.toke; const float* tokg = c.tokg;
    int* toks = c.toks; float* sgate = c.sgate;
    const int ntok = (nrows / (G * NWAVES)) * NWAVES;
    if (wave == 0) {
        int run[8];
#pragma unroll
        for (int e = 0; e < 8; ++e) run[e] = base[e];
        for (int p0 = 0; p0 < ntok; p0 += 64) {
            const int j = p0 + lane; const bool ok = j < ntok; const int m = (vcu * NWAVES + (j & 7)) + (G * NWAVES) * (j >> 3);
            int e0 = -1, e1 = -1; if (ok) { const int ee = toke[m]; e0 = ee & 255; e1 = ee >> 8; }
            int s0 = 0, s1 = 0;
            const unsigned long long below = (lane == 0) ? 0ull : (~0ull >> (64 - lane));
#pragma unroll
            for (int e = 0; e < 8; ++e) { const unsigned long long mk = __ballot(e0 == e || e1 == e); const int rk = __popcll(mk & below);
                if (e0 == e) s0 = run[e] + rk; if (e1 == e) s1 = run[e] + rk; run[e] += __popcll(mk); }
            if (ok) { slots[2 * j] = s0; slots[2 * j + 1] = s1; toks[2 * m] = s0; toks[2 * m + 1] = s1; sgate[s0] = tokg[2 * m]; sgate[s1] = tokg[2 * m + 1]; }
        }
    }
    __syncthreads();
    const bf16* A = c.A; bf16* S = c.S;
    constexpr int RE = A8 ? 512 : 1024;
    for (int j0 = wave; j0 < ntok; j0 += 4 * NWAVES) {
        v4u x[4][2]; int sl[4][2];
#pragma unroll
        for (int r = 0; r < 4; ++r) { const int j = j0 + r * NWAVES; if (j < ntok) { const int m = (vcu * NWAVES + (j & 7)) + (G * NWAVES) * (j >> 3);
            const v4u* src = (const v4u*)(A + (size_t)m * RE); x[r][0] = src[lane]; if (!A8) x[r][1] = src[lane + 64]; sl[r][0] = slots[2 * j]; sl[r][1] = slots[2 * j + 1]; } }
#pragma unroll
        for (int r = 0; r < 4; ++r) { const int j = j0 + r * NWAVES; if (j < ntok) {
            v4u* d0 = (v4u*)(S + (size_t)sl[r][0] * RE); v4u* d1 = (v4u*)(S + (size_t)sl[r][1] * RE);
            d0[lane] = x[r][0]; d1[lane] = x[r][0]; if (!A8) { d0[lane + 64] = x[r][1]; d1[lane + 64] = x[r][1]; } } }
    }
}

__device__ __forceinline__ void conv_phase(const Args& a, const Grp& c, int vcu, int G, int wave, int lane) {
    const bf16* U = c.H; bf16* Z = c.S;
    const float* cw = a.in[I_SCCONV];
    const int gw = vcu * NWAVES + wave, ngw = G * NWAVES;
    for (int it = gw; it < (TTOT / 16) * 2; it += ngw) {
        const int strip = it >> 1, c0 = (it & 1) * 512 + lane * 8, t0 = strip * 16;
        const int seqlen = (t0 < TLAT) ? SEQ : CTXL; const int tin = (t0 < TLAT) ? (t0 & (SEQ - 1)) : ((t0 - TLAT) & (CTXL - 1));
        float w0[8], w1[8], w2[8];
#pragma unroll
        for (int i = 0; i < 8; ++i) { w0[i] = cw[c0 + i]; w1[i] = cw[1024 + c0 + i]; w2[i] = cw[2048 + c0 + i]; }
        float yp[8], yc[8], yn[8];
        auto ld_y = [&](int t, float (&y)[8]) { const v4u yv = *(const v4u*)(U + (size_t)t * 2048 + 1024 + c0);
            y[0] = bflo(yv.x); y[1] = bfhi(yv.x); y[2] = bflo(yv.y); y[3] = bfhi(yv.y); y[4] = bflo(yv.z); y[5] = bfhi(yv.z); y[6] = bflo(yv.w); y[7] = bfhi(yv.w); };
        if (tin > 0) ld_y(t0 - 1, yp); else {
#pragma unroll
            for (int i = 0; i < 8; ++i) yp[i] = 0.f; }
        ld_y(t0, yc);
#pragma unroll 4
        for (int r = 0; r < 16; ++r) {
            const int t = t0 + r;
            if (tin + r + 1 < seqlen) ld_y(t + 1, yn); else {
#pragma unroll
                for (int i = 0; i < 8; ++i) yn[i] = 0.f; }
            const v4u bg = *(const v4u*)(U + (size_t)t * 2048 + c0);
            float b[8] = {bflo(bg.x), bfhi(bg.x), bflo(bg.y), bfhi(bg.y), bflo(bg.z), bfhi(bg.z), bflo(bg.w), bfhi(bg.w)};
            float z[8];
#pragma unroll
            for (int i = 0; i < 8; ++i) z[i] = b[i] * (w0[i] * yp[i] + w1[i] * yc[i] + w2[i] * yn[i]);
            v4u o; o.x = pk2(z[0], z[1]); o.y = pk2(z[2], z[3]); o.z = pk2(z[4], z[5]); o.w = pk2(z[6], z[7]);
            *(v4u*)(Z + (size_t)t * 1024 + c0) = o;
#pragma unroll
            for (int i = 0; i < 8; ++i) { yp[i] = yc[i]; yc[i] = yn[i]; }
        }
    }
}

__device__ __forceinline__ void qknorm_phase(const Args& a, const Grp& c, int ld, int nq, int nk, const float* qg, const float* kg, int vcu, int G, int wave, int lane) {
    bf16* QKV = c.H; const float* RT = (const float*)(a.ws + WS_RT);
    const int j8 = lane & 7;
    const int fb = 8 * (j8 & 1); const bool second = (j8 >> 1) & 1; const bool usecol = j8 >= 4;
    float gq[8], gk[8];
#pragma unroll
    for (int i = 0; i < 8; ++i) { gq[i] = qg[8 * j8 + i] * QSCALE; gk[i] = kg[8 * j8 + i]; }
    const int nch = (nq + nk) * 8;
    const int gw = vcu * NWAVES + wave, ngw = G * NWAVES;
    for (int m = gw; m < TTOT; m += ngw) {
        const bool lat = m < TLAT; const int s = m & (SEQ - 1); const int pos = usecol ? (s & 63) : (s >> 6);
        bf16* rowp = QKV + (size_t)m * ld;
        v4u raw[4];
#pragma unroll
        for (int k = 0; k < 4; ++k) { const int ch = lane + 64 * k; if (ch < nch) raw[k] = *(const v4u*)(rowp + ch * 8); }
        float cs[8], sn[8];
        if (lat) {
#pragma unroll
            for (int i = 0; i < 8; ++i) { const float2 t = *(const float2*)(RT + 2 * (pos * 16 + fb + i)); cs[i] = t.x; sn[i] = t.y; }
        }
#pragma unroll
        for (int k = 0; k < 4; ++k) { const int ch = lane + 64 * k;
            if (ch < nch) {
                const bool isq = (ch >> 3) < nq;
                float x[8] = {bflo(raw[k].x), bfhi(raw[k].x), bflo(raw[k].y), bfhi(raw[k].y), bflo(raw[k].z), bfhi(raw[k].z), bflo(raw[k].w), bfhi(raw[k].w)};
                float ss = 0.f;
#pragma unroll
                for (int i = 0; i < 8; ++i) ss += x[i] * x[i];
                ss += __shfl_xor(ss, 1); ss += __shfl_xor(ss, 2); ss += __shfl_xor(ss, 4);
                const float rstd = 1.0f / sqrtf(ss * (1.0f / 64.0f) + EPS);
#pragma unroll
                for (int i = 0; i < 8; ++i) x[i] = x[i] * rstd * (isq ? gq[i] : gk[i]);
                if (lat) {
#pragma unroll
                    for (int i = 0; i < 8; ++i) { const float o = __shfl_xor(x[i], 2); x[i] = second ? (o * sn[i] + x[i] * cs[i]) : (x[i] * cs[i] - o * sn[i]); }
                }
                v4u w; w.x = pk2(x[0], x[1]); w.y = pk2(x[2], x[3]); w.z = pk2(x[4], x[5]); w.w = pk2(x[6], x[7]);
                *(v4u*)(rowp + ch * 8) = w; } }
    }
}
constexpr int KP = 144;
__device__ __forceinline__ s16x4 vtr(const LAS unsigned char* p) { typedef short v4i16_t __attribute__((ext_vector_type(4)));
    return __builtin_bit_cast(s16x4, __builtin_amdgcn_ds_read_tr16_b64_v4i16((LAS v4i16_t*)p)); }
__device__ __forceinline__ int crow(int r, int hi) { return (r & 3) + 8 * (r >> 2) + 4 * hi; }

template <bool MASK>
__device__ __forceinline__ void attn_qk(const LAS unsigned char* Kb, const bf16x8 (&qr)[4], float nb2, float& lsum, v4u (&pw)[4], int lane, int kpos0, int qpos) {
    const int r32 = lane & 31, hi = lane >> 5;
    const LAS unsigned char* kp = Kb + r32 * KP + hi * 16;
    float acc = 0.f;
#pragma unroll
    for (int h = 0; h < 2; ++h) {
        f32x16 sc;
#pragma unroll
        for (int r = 0; r < 16; ++r) sc[r] = nb2;
#pragma unroll
        for (int d0 = 0; d0 < 4; ++d0) { const bf16x8 a0 = *(const LAS bf16x8*)(kp + h * 32 * KP + d0 * 32); sc = __builtin_amdgcn_mfma_f32_32x32x16_bf16(a0, qr[d0], sc, 0, 0, 0); }
#pragma unroll
        for (int r = 0; r < 16; ++r) { float p = __builtin_amdgcn_exp2f(sc[r]);
            if (MASK) { const int dd = kpos0 + 32 * h + crow(r, hi) - qpos; if (dd < -128 || dd > 128) p = 0.f; }
            sc[r] = p; acc += p; }
#pragma unroll
        for (int i = 0; i < 4; ++i) { pw[2 * h][i] = pk2(sc[2 * i], sc[2 * i + 1]); pw[2 * h + 1][i] = pk2(sc[8 + 2 * i], sc[8 + 2 * i + 1]); }
        asm volatile("" :: "v"(pw[2 * h]), "v"(pw[2 * h + 1]));
    }
    lsum += acc;
}
template <int NDV, int VP>
__device__ __forceinline__ void attn_pv(const LAS unsigned char* Vb, const v4u (&pw)[4], f32x16 (&o)[NDV], int lane) {
    const int hi = lane >> 5, i16 = lane & 15, rh = (lane >> 4) & 1;
    const LAS unsigned char* vp = Vb + (4 * hi + (i16 >> 2)) * VP + rh * 32 + (i16 & 3) * 8;
#pragma unroll
    for (int t = 0; t < NDV; ++t)
#pragma unroll
        for (int ks = 0; ks < 4; ++ks) {
            const s16x4 lo = vtr(vp + (16 * ks) * VP + t * 64), hh = vtr(vp + (16 * ks + 8) * VP + t * 64);
            const bf16x8 vf = (bf16x8){lo[0], lo[1], lo[2], lo[3], hh[0], hh[1], hh[2], hh[3]};
            o[t] = __builtin_amdgcn_mfma_f32_32x32x16_bf16(vf, __builtin_bit_cast(bf16x8, pw[ks]), o[t], 0, 0, 0);
        }
}
template <int NDV  , int VP, bool MASK>
__device__ __forceinline__ void attn_tile(const LAS unsigned char* Kb, const LAS unsigned char* Vb, const bf16x8 (&qr)[4], float nb2, f32x16 (&o)[NDV], float& lsum, int lane, int kpos0, int qpos) {
    const int r32 = lane & 31, hi = lane >> 5;
    f32x16 s0, s1;
#pragma unroll
    for (int r = 0; r < 16; ++r) { s0[r] = nb2; s1[r] = nb2; }
    const LAS unsigned char* kp = Kb + r32 * KP + hi * 16;
#pragma unroll
    for (int d0 = 0; d0 < 4; ++d0) {
        const bf16x8 a0 = *(const LAS bf16x8*)(kp + d0 * 32), a1 = *(const LAS bf16x8*)(kp + 32 * KP + d0 * 32);
        s0 = __builtin_amdgcn_mfma_f32_32x32x16_bf16(a0, qr[d0], s0, 0, 0, 0);
        s1 = __builtin_amdgcn_mfma_f32_32x32x16_bf16(a1, qr[d0], s1, 0, 0, 0);
    }
    float acc = 0.f;
#pragma unroll
    for (int r = 0; r < 16; ++r) {
        float p0 = __builtin_amdgcn_exp2f(s0[r]), p1 = __builtin_amdgcn_exp2f(s1[r]);
        if (MASK) { const int k0 = kpos0 + crow(r, hi), k1 = k0 + 32; const int d0 = k0 - qpos, d1 = k1 - qpos;
            if (d0 < -128 || d0 > 128) p0 = 0.f; if (d1 < -128 || d1 > 128) p1 = 0.f; }
        s0[r] = p0; s1[r] = p1; acc += p0 + p1;
    }
    lsum += acc;
    v4u pw[4];
#pragma unroll
    for (int i = 0; i < 4; ++i) { pw[0][i] = pk2(s0[2 * i], s0[2 * i + 1]); pw[1][i] = pk2(s0[8 + 2 * i], s0[8 + 2 * i + 1]); pw[2][i] = pk2(s1[2 * i], s1[2 * i + 1]); pw[3][i] = pk2(s1[8 + 2 * i], s1[8 + 2 * i + 1]); }
    const int i16 = lane & 15, rh = (lane >> 4) & 1;
    const LAS unsigned char* vp = Vb + (4 * hi + (i16 >> 2)) * VP + rh * 32 + (i16 & 3) * 8;
#pragma unroll
    for (int t = 0; t < NDV; ++t)
#pragma unroll
        for (int ks = 0; ks < 4; ++ks) {
            const s16x4 lo = vtr(vp + (16 * ks) * VP + t * 64), hh = vtr(vp + (16 * ks + 8) * VP + t * 64);
            const bf16x8 vf = (bf16x8){lo[0], lo[1], lo[2], lo[3], hh[0], hh[1], hh[2], hh[3]};
            o[t] = __builtin_amdgcn_mfma_f32_32x32x16_bf16(vf, __builtin_bit_cast(bf16x8, pw[ks]), o[t], 0, 0, 0);
        }
}

__device__ __forceinline__ void diff_attn_phase(const Args& a, const Grp& c, LAS unsigned char* lds, int vcu, int G, int tid, int wave, int lane) {
    constexpr int VP = 320, KBUF = 64 * KP, VBUF = 64 * VP, BUF = KBUF + VBUF;
    const bf16* QKV = c.H; bf16* O = c.S;
    const float* lp = a.in[I_DALAM];
    float l01 = lp[lane] * lp[64 + lane], l23 = lp[128 + lane] * lp[192 + lane];
    l01 = wave_sum(l01); l23 = wave_sum(l23);
    const float lam_init = 0.8f - 0.6f * 0.7408182206817179f;
    const float lam = __expf(l01) - __expf(l23) + lam_init;
    float mq = fabsf(a.in[I_DAQG][lane]), mk = fabsf(a.in[I_DAKG][lane]);
#pragma unroll
    for (int o = 1; o < 64; o <<= 1) { mq = fmaxf(mq, __shfl_xor(mq, o)); mk = fmaxf(mk, __shfl_xor(mk, o)); }
    const float nb2 = -(8.0f * mq * mk * LOG2E * 1.001f + 0.01f);
    const float* subg = a.in[I_DASUB];
    const int r32 = lane & 31, hi = lane >> 5;
    const int krow = tid >> 3, kch = tid & 7;
    const unsigned koff = (unsigned)(krow * 6144 + kch * 16), voff = (unsigned)((tid >> 4) * 6144 + (tid & 15) * 16);
    for (int id = vcu; id < NB * 8 * 16 + NB * 8; id += G) {
        int b, h, nkt; size_t qrow0;
        if (id < NB * 8 * 16) { const int bh = id >> 4, qb = id & 15; b = bh >> 3; h = bh & 7; nkt = 68; qrow0 = (size_t)b * SEQ + qb * 256; }
        else { const int bh = id - NB * 8 * 16; b = bh >> 3; h = bh & 7; nkt = 4; qrow0 = (size_t)TLAT + b * CTXL; }
        const size_t ctx0 = (size_t)TLAT + b * CTXL, lat0 = (size_t)b * SEQ;
        const size_t qrow = qrow0 + wave * 32 + r32;
        v4u* o0l = (v4u*)((unsigned char*)c.A + (size_t)vcu * 65536 + wave * 8192) + lane;
#pragma unroll 1
        for (int map = 0; map < 2; ++map) {
            const int kh = 2 * h + map;
            bf16x8 qr[4];
#pragma unroll
            for (int d0 = 0; d0 < 4; ++d0) qr[d0] = *(const bf16x8*)(QKV + qrow * 3072 + kh * 64 + d0 * 16 + hi * 8);
            f32x16 o[4];
#pragma unroll
            for (int t = 0; t < 4; ++t)
#pragma unroll
                for (int r = 0; r < 16; ++r) o[t][r] = 0.f;
            float lsum = 0.f;
            v4u kreg, vreg0, vreg1;
            auto ld_tile = [&](int t) { const size_t r0 = (t < 4) ? ctx0 + t * 64 : lat0 + (size_t)(t - 4) * 64;
                const char* kb = (const char*)(QKV + r0 * 3072 + 1024 + kh * 64); const char* vb = (const char*)(QKV + r0 * 3072 + 2048 + h * 128);
                kreg = *(const v4u*)(kb + koff); vreg0 = *(const v4u*)(vb + voff); vreg1 = *(const v4u*)(vb + 32 * 6144 + voff); };
            auto st_tile = [&](int buf) { LAS unsigned char* base = lds + buf * BUF;
                *(LAS v4u*)(base + krow * KP + kch * 16) = kreg;
                *(LAS v4u*)(base + KBUF + (tid >> 4) * VP + (tid & 15) * 16) = vreg0;
                *(LAS v4u*)(base + KBUF + (32 + (tid >> 4)) * VP + (tid & 15) * 16) = vreg1; };
            ld_tile(0); st_tile(0); ld_tile(1); __syncthreads();
            if (wave < 4) {
                int bcur = 0;
#pragma unroll 1
                for (int t = 0; t < nkt; ++t) {
                    const int bnext = (bcur == 2) ? 0 : bcur + 1;
                    if (t + 1 < nkt) st_tile(bnext);
                    if (t + 2 < nkt) ld_tile(t + 2);
                    const LAS unsigned char* base = lds + bcur * BUF; v4u pw[4];
                    attn_qk<false>(base, qr, nb2, lsum, pw, lane, 0, 0); attn_pv<4, VP>(base + KBUF, pw, o, lane);
                    asm volatile("s_waitcnt lgkmcnt(0)\n\ts_barrier" ::: "memory");
                    bcur = bnext;
                }
            } else {
                int bcur = 0, bprev = 2; v4u pw[4];
#pragma unroll
                for (int i = 0; i < 4; ++i) pw[i] = (v4u){0u, 0u, 0u, 0u};
#pragma unroll 1
                for (int t = 0; t < nkt; ++t) {
                    const int bnext = (bcur == 2) ? 0 : bcur + 1;
                    if (t + 1 < nkt) st_tile(bnext);
                    if (t + 2 < nkt) ld_tile(t + 2);
                    if (t > 0) attn_pv<4, VP>(lds + bprev * BUF + KBUF, pw, o, lane);
                    attn_qk<false>(lds + bcur * BUF, qr, nb2, lsum, pw, lane, 0, 0);
                    asm volatile("s_waitcnt lgkmcnt(0)\n\ts_barrier" ::: "memory");
                    bprev = bcur; bcur = bnext;
                }
                attn_pv<4, VP>(lds + bprev * BUF + KBUF, pw, o, lane);
            }
            asm volatile("s_waitcnt lgkmcnt(0)\n\ts_barrier" ::: "memory");
            const float l = lsum + __shfl_xor(lsum, 32); const float inv = 1.0f / l;
            if (map == 0) {
#pragma unroll
                for (int t = 0; t < 4; ++t)
#pragma unroll
                    for (int r4 = 0; r4 < 2; ++r4) { v4u w;
#pragma unroll
                        for (int i = 0; i < 4; ++i) w[i] = pk2(o[t][8 * r4 + 2 * i] * inv, o[t][8 * r4 + 2 * i + 1] * inv);
                        o0l[(t * 2 + r4) * 64] = w; }
            } else {
                const float li = lam * inv; float ss = 0.f;
#pragma unroll
                for (int t = 0; t < 4; ++t)
#pragma unroll
                    for (int r4 = 0; r4 < 2; ++r4) { const v4u w = o0l[(t * 2 + r4) * 64];
#pragma unroll
                        for (int i = 0; i < 4; ++i) { const unsigned u = w[i]; const int r = 4 * r4 + i; const float d0 = bflo(u) - li * o[t][2 * r], d1 = bfhi(u) - li * o[t][2 * r + 1]; o[t][2 * r] = d0; o[t][2 * r + 1] = d1; ss += d0 * d0 + d1 * d1; } }
                ss += __shfl_xor(ss, 32);
                const float rs = (1.0f / sqrtf(ss * (1.0f / 128.0f) + EPS)) * (1.0f - lam_init);
                bf16* orow = O + qrow * 1024 + h * 128;
#pragma unroll
                for (int t = 0; t < 4; ++t)
#pragma unroll
                    for (int g = 0; g < 4; ++g) { const int dv = 32 * t + 8 * g + 4 * hi; const f32x4 sg = *(const f32x4*)(subg + dv);
                        v2u w; w.x = pk2(o[t][4 * g] * rs * sg.x, o[t][4 * g + 1] * rs * sg.y); w.y = pk2(o[t][4 * g + 2] * rs * sg.z, o[t][4 * g + 3] * rs * sg.w);
                        *(v2u*)(orow + dv) = w; }
            }
        }
    }
}

__device__ __forceinline__ void swa_attn_phase(const Args& a, const Grp& c, LAS unsigned char* lds, int vcu, int G, int tid, int wave, int lane) {
    constexpr int VP = 192, KBUF = 64 * KP, VBUF = 64 * VP, BUF = KBUF + VBUF;
    const bf16* QKV = c.H; bf16* O = c.S;
    float mq = fabsf(a.in[I_SWQG][lane]), mk = fabsf(a.in[I_SWKG][lane]); float ms = (lane < 16) ? a.in[I_SWSINK][lane] : -INFINITY;
#pragma unroll
    for (int o = 1; o < 64; o <<= 1) { mq = fmaxf(mq, __shfl_xor(mq, o)); mk = fmaxf(mk, __shfl_xor(mk, o)); ms = fmaxf(ms, __shfl_xor(ms, o)); }
    const float b2 = fmaxf(8.0f * mq * mk * 1.001f + 0.01f, ms) * LOG2E; const float nb2 = -b2;
    const int r32 = lane & 31, hi = lane >> 5;
    const int krow = tid >> 3, kch = tid & 7;
    for (int id = vcu; id < NB * 4 * 64; id += G) {
        const int qb = id & 63, kvh = (id >> 6) & 3, b = id >> 8;
        const int q0 = qb * 64; const int qh = kvh * 4 + (wave & 3); const int qpos = q0 + (wave >> 2) * 32 + r32;
        const size_t ctx0 = (size_t)TLAT + b * CTXL, lat0 = (size_t)b * SEQ;
        const size_t qrow = lat0 + qpos;
        int bt_lo = (128 - q0) / 64; if (bt_lo < 0) bt_lo = 0; int bt_hi = (SEQ + 128 - q0) / 64; if (bt_hi > 5) bt_hi = 5;
        const int nkt = 4 + (bt_hi - bt_lo);
        bf16x8 qr[4];
#pragma unroll
        for (int d0 = 0; d0 < 4; ++d0) qr[d0] = *(const bf16x8*)(QKV + qrow * 1536 + qh * 64 + d0 * 16 + hi * 8);
        f32x16 o[2];
#pragma unroll
        for (int t = 0; t < 2; ++t)
#pragma unroll
            for (int r = 0; r < 16; ++r) o[t][r] = 0.f;
        float lsum = 0.f;
        v4u kreg, vreg;
        auto tile_row0 = [&](int t) -> size_t { return (t < 4) ? ctx0 + t * 64 : lat0 + (size_t)(q0 - 128 + (t - 4 + bt_lo) * 64); };
        auto ld_tile = [&](int t) { const size_t r0 = tile_row0(t);
            kreg = *(const v4u*)(QKV + (r0 + krow) * 1536 + 1024 + kvh * 64 + kch * 8);
            vreg = *(const v4u*)(QKV + (r0 + krow) * 1536 + 1280 + kvh * 64 + kch * 8); };
        auto st_tile = [&](int buf) { LAS unsigned char* base = lds + buf * BUF;
            *(LAS v4u*)(base + krow * KP + kch * 16) = kreg;
            *(LAS v4u*)(base + KBUF + krow * VP + kch * 16) = vreg; };
        ld_tile(0); st_tile(0); __syncthreads();
#pragma unroll 1
        for (int t = 0; t < nkt; ++t) {
            if (t + 1 < nkt) ld_tile(t + 1);
            const LAS unsigned char* base = lds + (t & 1) * BUF;
            if (t < 4) attn_tile<2, VP, false>(base, base + KBUF, qr, nb2, o, lsum, lane, 0, 0);
            else attn_tile<2, VP, true>(base, base + KBUF, qr, nb2, o, lsum, lane, q0 - 128 + (t - 4 + bt_lo) * 64, qpos);
            if (t + 1 < nkt) st_tile((t + 1) & 1);
            __syncthreads();
        }
        const float l = lsum + __shfl_xor(lsum, 32) + __builtin_amdgcn_exp2f(a.in[I_SWSINK][qh] * LOG2E - b2); const float inv = 1.0f / l;
        bf16* orow = O + qrow * 1024 + qh * 64;
#pragma unroll
        for (int t = 0; t < 2; ++t)
#pragma unroll
            for (int g = 0; g < 4; ++g) { const int dv = 32 * t + 8 * g + 4 * hi;
                v2u w; w.x = pk2(o[t][4 * g] * inv, o[t][4 * g + 1] * inv); w.y = pk2(o[t][4 * g + 2] * inv, o[t][4 * g + 3] * inv);
                *(v2u*)(orow + dv) = w; }
    }
}

__device__ __forceinline__ void gate_phase(const Args& a, const Grp& c, LAS unsigned char* lds, int vcu, int G, int tid, int wave, int lane) {
    constexpr int WP = 272, VP = 576, TP = 528;
    LAS unsigned char* Wl = lds; LAS unsigned char* Vl = lds + 128 * WP; LAS float* rstd = (LAS float*)(lds + 128 * WP + 128 * VP); LAS float* bsl = rstd + 128;
    const bf16* Zc = c.H; bf16* Gout = c.S;
    const bf16* wsb = (const bf16*)(a.ws + WS_WSB); const float* ssq = c.ssq;
    const float* vg = a.in[I_CMVG];
    const int r32 = lane & 31, hi = lane >> 5, i16 = lane & 15, rh = (lane >> 4) & 1;
    const int q0 = tid >> 5, c8 = tid & 31;
    for (int i = tid; i < 1024; i += NTHR) bsl[i] = a.in[I_CMBS][i];
    const int NU = (TTOT / 128) * 8;
    v4u vraw[8], wraw[4]; f32x4 sq0, sq1;
    auto issue_vw = [&](int id) { const int n = id >> 3, g = id & 7; const size_t row0 = (size_t)n * 128;
        const bf16* zb = Zc + (row0 + q0) * 4096 + g * 256 + c8 * 8 + 2048;
#pragma unroll
        for (int i = 0; i < 8; ++i) vraw[i] = *(const v4u*)(zb + (size_t)i * 16 * 4096);
#pragma unroll
        for (int i = 0; i < 4; ++i) { const int ch = tid + NTHR * i, p = ch >> 4, c16 = ch & 15; wraw[i] = *(const v4u*)(wsb + ((size_t)g * 128 + p) * 128 + c16 * 8); }
        const f32x4* sp = (const f32x4*)(ssq + (row0 + (tid >> 2)) * 32 + (tid & 3) * 8); sq0 = sp[0]; sq1 = sp[1]; };
    if (vcu < NU) issue_vw(vcu);
    for (int id = vcu; id < NU; id += G) {
        const int n = id >> 3, g = id & 7; const size_t row0 = (size_t)n * 128;
        const f32x4 g0 = *(const f32x4*)(vg + g * 256 + c8 * 8), g1 = *(const f32x4*)(vg + g * 256 + c8 * 8 + 4);
        { float t = ((sq0.x + sq0.y) + (sq0.z + sq0.w)) + ((sq1.x + sq1.y) + (sq1.z + sq1.w)); t += __shfl_xor(t, 1); t += __shfl_xor(t, 2);
          if ((tid & 3) == 0) rstd[tid >> 2] = 1.0f / sqrtf(t * (1.0f / 2048.0f) + EPS); }
#pragma unroll
        for (int i = 0; i < 4; ++i) { const int ch = tid + NTHR * i, p = ch >> 4, c16 = ch & 15; *(LAS v4u*)(Wl + p * WP + c16 * 16) = wraw[i]; }
        __syncthreads();
#pragma unroll
        for (int i = 0; i < 8; ++i) { const int q = q0 + 16 * i; const float rs = rstd[q]; const v4u raw = vraw[i];
            v4u w; w.x = pk2(bflo(raw.x) * rs * g0.x, bfhi(raw.x) * rs * g0.y); w.y = pk2(bflo(raw.y) * rs * g0.z, bfhi(raw.y) * rs * g0.w);
            w.z = pk2(bflo(raw.z) * rs * g1.x, bfhi(raw.z) * rs * g1.y); w.w = pk2(bflo(raw.w) * rs * g1.z, bfhi(raw.w) * rs * g1.w);
            *(LAS v4u*)(Vl + q * VP + c8 * 16) = w; }
        __syncthreads();
        v4u uraw[8];
        { const bf16* zb = Zc + (row0 + q0) * 4096 + g * 256 + c8 * 8;
#pragma unroll
          for (int i = 0; i < 8; ++i) uraw[i] = *(const v4u*)(zb + (size_t)i * 16 * 4096); }
        if (id + G < NU) issue_vw(id + G);
        f32x16 d[4];
#pragma unroll
        for (int t = 0; t < 4; ++t)
#pragma unroll
            for (int r = 0; r < 16; ++r) d[t][r] = bsl[g * 128 + 32 * t + crow(r, hi)];
        const LAS unsigned char* vp = Vl + (8 * hi + (i16 >> 2)) * VP + (wave * 32 + rh * 16 + (i16 & 3) * 4) * 2;
        const LAS unsigned char* wp = Wl + r32 * WP + hi * 16;
#pragma unroll
        for (int ks = 0; ks < 8; ++ks) {
            const s16x4 lo = vtr(vp + (16 * ks) * VP), hh = vtr(vp + (16 * ks + 4) * VP);
            const bf16x8 bfr = (bf16x8){lo[0], lo[1], lo[2], lo[3], hh[0], hh[1], hh[2], hh[3]};
#pragma unroll
            for (int t = 0; t < 4; ++t) { const bf16x8 af = *(const LAS bf16x8*)(wp + (32 * t) * WP + ks * 32);
                d[t] = __builtin_amdgcn_mfma_f32_32x32x16_bf16(af, bfr, d[t], 0, 0, 0); }
        }
        asm volatile("s_waitcnt lgkmcnt(0)\n\ts_barrier" ::: "memory");
        { LAS bf16* T = (LAS bf16*)Vl; const int cc = wave * 32 + r32;
#pragma unroll
          for (int t = 0; t < 4; ++t)
#pragma unroll
            for (int r = 0; r < 16; ++r) { const int p = 32 * t + crow(r, hi); T[p * (TP / 2) + cc] = (bf16)f2bf(d[t][r]); } }
        asm volatile("s_waitcnt lgkmcnt(0)\n\ts_barrier" ::: "memory");
        bf16* gb = Gout + (row0 + q0) * 2048 + g * 256 + c8 * 8;
#pragma unroll
        for (int i = 0; i < 8; ++i) { const int p = q0 + 16 * i; const v4u sv = *(const LAS v4u*)(Vl + p * TP + c8 * 16); const v4u u = uraw[i];
            v4u w; w.x = pk2(bflo(u.x) * bflo(sv.x), bfhi(u.x) * bfhi(sv.x)); w.y = pk2(bflo(u.y) * bflo(sv.y), bfhi(u.y) * bfhi(sv.y));
            w.z = pk2(bflo(u.z) * bflo(sv.z), bfhi(u.z) * bfhi(sv.z)); w.w = pk2(bflo(u.w) * bflo(sv.w), bfhi(u.w) * bfhi(sv.w));
            *(v4u*)(gb + (size_t)i * 16 * 2048) = w; }
        asm volatile("s_waitcnt lgkmcnt(0)\n\ts_barrier" ::: "memory");
    }
}

constexpr int N_PHASES = 34;
__device__ __forceinline__ void wait_flag(gu32* flag) {
    if (threadIdx.x == 0) { unsigned sp = 0; while (__hip_atomic_load(flag, RLX_AGENT) == 0u) { __builtin_amdgcn_s_sleep(4); if (++sp > (1u << 22)) break; }
        __builtin_amdgcn_fence(__ATOMIC_ACQUIRE, "agent"); asm volatile("s_waitcnt vmcnt(0)" ::: "memory"); }
    __syncthreads();
}
__global__ void __launch_bounds__(NTHR, 2) mk_fwd(Args args) {
    extern __shared__ __attribute__((aligned(16))) unsigned char lds_raw[];
    LAS unsigned char* lds = (LAS unsigned char*)lds_raw;
    volatile LAS unsigned* MISC = (volatile LAS unsigned*)(lds + MISC_OFF);
#define PH_IDS int tid = threadIdx.x; asm volatile("" : "+v"(tid)); const int lane = tid & 63, wave = __builtin_amdgcn_readfirstlane(tid >> 6); const int gw = vcu * NWAVES + wave; (void)gw; (void)lane; \
        unsigned char* ws = args.ws; asm volatile("" : "+s"(ws));   \
        float* const MOD = (float*)(ws + WS_MOD); \
        Grp c; \
        c.b0 = grp * NB; \
        c.x = args.in[I_X] + (size_t)grp * TLAT * 1024; c.ctx = args.in[I_CTX] + (size_t)grp * TCTX * 1024; c.out = args.out + (size_t)grp * TLAT * 1024; c.hc = (float*)(ws + WS_HC) + (size_t)grp * TCTX * 1024; \
        c.S = (bf16*)(ws + WS_S + grp * S_STRIDE); c.H = (bf16*)(ws + WS_H + grp * H_STRIDE); c.A = (bf16*)(ws + WS_H + grp * H_STRIDE + A_IN_H); \
        { unsigned char* t = ws + WS_TOK + grp * TOK_STRIDE; c.toke = (int*)t; c.tokg = (float*)(t + T_TOKG); c.toks = (int*)(t + T_TOKS); c.sgate = (float*)(t + T_SGATE); c.wgcnt = (int*)(t + T_WGCNT); c.panel = (int*)(t + T_PANEL); } \
        c.ssq = (float*)(ws + WS_SSQ + grp * SSQ_STRIDE); \
        bf16* const HL = (bf16*)c.out; bf16* const HCX = (bf16*)c.hc; bf16* const ABUF = c.A; bf16* const SBUF = c.S; bf16* const HBUF = c.H; \
        const int b0 = c.b0; (void)MOD; (void)HL; (void)HCX; (void)ABUF; (void)SBUF; (void)HBUF; (void)b0
    const int bx = blockIdx.x; const int grp = (NGRP == 2) ? ((bx >> 2) & 1) : 0;
    const int G = GG; const int vcu = (NGRP == 2) ? ((bx & 3) * 32 + (bx >> 3)) : ((bx & 7) * 32 + (bx >> 3));
    const int oid = (NGRP == 2) ? ((bx >> 3) * 4 + (bx & 3)) : bx;
    gu32* ctl = (gu32*)(args.ws + WS_CTL);
    for (int u = threadIdx.x; u < (LDS_BYTES - PERS_OFF) / 4; u += NTHR) ((LAS unsigned*)(lds + PERS_OFF))[u] = 0u;
    __syncthreads();
    const int lo = args.ph_lo, hi = args.ph_hi;
    XcdBarrier bar = xcd_barrier_post((unsigned*)(ctl + CW_BAR) + grp * XCD_BAR_WORDS, MISC + 8, (unsigned)GG);
#ifndef PH_LO
#define PH_LO 0
#define PH_HI 99
#endif
#define IN(k) ((k) >= PH_LO && (k) < PH_HI && lo <= (k) && (k) < hi)
#define SEAM(k) do { if (IN(k) && IN((k) + 1)) xcd_barrier(bar); } while (0)
    const int ngw = G * NWAVES;
    LAS int* const ptab = (LAS int*)(lds + PERS_OFF);

    constexpr int CM_ALL = NE * 3 * 1408, CM0_A = CM_ALL * 18 / 100, CM0_B = CM_ALL * 82 / 100, CM1_A = CM_ALL * 35 / 100;
#define PG8_ER(n, s) pg8::EpiResid<n, s>
#define PG8_ER4(n, s, n8, a8) pg8::EpiResid<n, s, n8, a8>
#define GEMM_GRID8(Abuf, Wt, nM_, nN_, K_, EpiT, Eobj) do { pg8::Gemm g{(const pg8::bf16_t*)(Abuf), (const pg8::bf16_t*)(Wt), (nM_) * 256, (nN_) * 256, (K_)}; pg8::GridOrder S; S.init((nM_), (nN_), G, oid); \
        pg8::gemm_phase<EpiT, pg8::GridOrder, true, true, true>(lds, g, S, (Eobj)); } while (0)
#define GEMM_GRID(Abuf, Wt, nM_, nN_, K_, EpiT, Eobj) do { pg8::Gemm g{(const pg8::bf16_t*)(Abuf), (const pg8::bf16_t*)(Wt), (nM_) * 256, (nN_) * 256, (K_)}; pg8::GridOrder S; S.init((nM_), (nN_), G, oid); \
        pg8::gemm_phase<EpiT, pg8::GridOrder, true, true>(lds, g, S, (Eobj)); } while (0)
#define GEMM_MOE(Abuf, Wt, nNe_, K_, EpiT, Eobj) do { const int* pan = c.panel; const int np = pan[0]; \
        for (int i = tid; i < np; i += NTHR) ptab[i] = pan[1 + i]; __syncthreads(); \
        pg8::Gemm g{(const pg8::bf16_t*)(Abuf), (const pg8::bf16_t*)(Wt), np * 256, (nNe_) * 256, (K_)}; pg8::MoeOrder S; S.g.init(np, (nNe_), G, oid); S.pexp = ptab; S.nNe = (nNe_); \
        pg8::gemm_phase<EpiT, pg8::MoeOrder, true, true>(lds, g, S, (Eobj)); } while (0)
#define GEMM_MOE8(Abuf, Wt, nNe_, K_, EpiT, Eobj) do { const int* pan = c.panel; const int np = pan[0]; \
        for (int i = tid; i < np; i += NTHR) ptab[i] = pan[1 + i]; __syncthreads(); \
        pg8::Gemm g{(const pg8::bf16_t*)(Abuf), (const pg8::bf16_t*)(Wt), np * 256, (nNe_) * 256, (K_)}; pg8::MoeOrderC<(nNe_)> S; S.nM = np; S.c = oid; S.pexp = ptab; \
        pg8::gemm_phase<EpiT, pg8::MoeOrderC<(nNe_)>, true, true, true>(lds, g, S, (Eobj)); } while (0)
    constexpr int NMA = TTOT / 256, NML = TLAT / 256;

    if (IN(0)) {
        if (grp == 0) {
            { PH_IDS; adaln_phase(args, lds, vcu, G, tid);
              if (vcu == 0) rope_table(args, tid);
              { const float* w = args.in[I_CMWS]; bf16* o = (bf16*)(ws + WS_WSB); for (int i = gw * 64 + lane; i < 131072 / 4; i += ngw * 64) { const f32x4 v = ((const f32x4*)w)[i]; v2u p; p.x = pk2(v.x, v.y); p.y = pk2(v.z, v.w); ((v2u*)o)[i] = p; } }
              conv_dense(args, lds, gw, ngw, wave, lane);
            }
            xcd_barrier(bar);
            if (NGRP == 1) { PH_IDS; bias_phase(args, gw, ngw, lane); }
            else { { PH_IDS; bias_phase(args, gw, ngw, lane); } xcd_barrier(bar); }
            if (NGRP == 2 && vcu == 0 && threadIdx.x == 0) { __builtin_amdgcn_fence(__ATOMIC_RELEASE, "agent"); asm volatile("s_waitcnt vmcnt(0)" ::: "memory"); __hip_atomic_store(ctl + CW_FLAG_DENSE, 1u, RLX_AGENT); }
        } else {
            { PH_IDS; conv_moe(args, 0, lds, gw, ngw, wave, lane); conv_moe(args, 1, lds, gw, ngw, wave, lane); }
            xcd_barrier(bar);
            if (vcu == 0 && threadIdx.x == 0) { __builtin_amdgcn_fence(__ATOMIC_RELEASE, "agent"); asm volatile("s_waitcnt vmcnt(0)" ::: "memory"); __hip_atomic_store(ctl + CW_FLAG_MOE, 1u, RLX_AGENT); }
            wait_flag(ctl + CW_FLAG_DENSE);
        }
    }
    if (IN(1)) { PH_IDS; row_phase<false, true, false, true, false>(args, c, lds, c.x, c.ctx, nullptr, nullptr, TTOT, args.in[I_NMIX] + 0 * 1024, MOD + 0 * 9 * 6144, 0, nullptr, nullptr, nullptr, vcu, G, tid, wave, lane); }
    SEAM(1);
    if (IN(2)) { PH_IDS; { pg8::EpiConvIn E{(pg8::bf16_t*)HBUF}; GEMM_GRID(ABUF, ws + W_SCIN, NMA, 12, 1024, pg8::EpiConvIn, E); } }
    SEAM(2);
    if (IN(3)) { PH_IDS; conv_phase(args, c, vcu, G, wave, lane); }
    SEAM(3);
    if (IN(4)) { PH_IDS; { pg8::EpiResid<true, true, D0_IN8, false> E{c.x, c.ctx, (pg8::bf16_t*)HL, (pg8::bf16_t*)HCX, MOD + 0 * 9 * 6144 + 2048, (pg8::bf16_t*)ABUF, args.in[I_NFFN] + 0 * 1024, MOD + 0 * 9 * 6144 + 4096, c.ssq, b0}; GEMM_GRID(SBUF, ws + W_SCOUT, NMA, 4, 1024, PG8_ER4(true, true, D0_IN8, false), E); } }
    if (IN(4)) { if (NGRP == 1 && bx >= 32) { PH_IDS; conv_moe(args, 0, lds, (bx - 32) * NWAVES + wave, 224 * NWAVES, wave, lane, 0, CM0_A); } }
    SEAM(4);
#define PG8_SG(n, a) pg8::EpiSwiGLU<n, a>
#define PG8_SG8(n, g) pg8::EpiSwiGLU8<n, g>
    if (IN(6)) { PH_IDS;
        if (D0_IN8 && D0_H8) { pg8::EpiSwiGLU8<true> E{(unsigned char*)HBUF, c.ssq, (const float*)(ws + BIAS_P6), b0}; GEMM_GRID8(ABUF, ws + W_F13, NMA, 22, 512, pg8::EpiSwiGLU8<true>, E); }
        else if (D0_IN8) { pg8::EpiSwiGLU<true, true> E{(pg8::bf16_t*)HBUF, FF, c.ssq, (const float*)(ws + BIAS_P6), b0}; GEMM_GRID8(ABUF, ws + W_F13, NMA, 22, 512, PG8_SG(true, true), E); }
        else if (D0_H8) { pg8::EpiSwiGLU8<true, false> E{(unsigned char*)HBUF, c.ssq, (const float*)(ws + BIAS_P6), b0}; GEMM_GRID(ABUF, ws + W_F13, NMA, 22, 1024, PG8_SG8(true, false), E); }
        else { pg8::EpiSwiGLU<true> E{(pg8::bf16_t*)HBUF, FF, c.ssq, (const float*)(ws + BIAS_P6), b0}; GEMM_GRID(ABUF, ws + W_F13, NMA, 22, 1024, pg8::EpiSwiGLU<true>, E); } }
    SEAM(6);
    if (IN(7)) { PH_IDS; if (D0_H8) { pg8::EpiResid<true, false, false, true> E{HL, HCX, (pg8::bf16_t*)HL, (pg8::bf16_t*)HCX, MOD + 0 * 9 * 6144 + 5120, (pg8::bf16_t*)ABUF, args.in[I_NMIX] + 1 * 1024, MOD + 1 * 9 * 6144 + 1024, c.ssq, b0}; GEMM_GRID8(HBUF, ws + W_F2, NMA, 4, FF / 2, PG8_ER4(true, false, false, true), E); }
                        else { pg8::EpiResid<true, false> E{HL, HCX, (pg8::bf16_t*)HL, (pg8::bf16_t*)HCX, MOD + 0 * 9 * 6144 + 5120, (pg8::bf16_t*)ABUF, args.in[I_NMIX] + 1 * 1024, MOD + 1 * 9 * 6144 + 1024, c.ssq, b0}; GEMM_GRID(HBUF, ws + W_F2, NMA, 4, FF, PG8_ER(true, false), E); }
               }
    if (IN(7)) { if (NGRP == 1 && bx >= 32) { PH_IDS; conv_moe(args, 0, lds, (bx - 32) * NWAVES + wave, 224 * NWAVES, wave, lane, CM0_A, CM0_B); } }
    SEAM(7);
    if (IN(9)) { PH_IDS; { pg8::EpiQKV E{(pg8::bf16_t*)HBUF, 3072, c.ssq, (const float*)(ws + BIAS_P9), 3072, 4, 4, args.in[I_DAQG], args.in[I_DAKG], (const float*)(ws + WS_RT), QSCALE, b0}; GEMM_GRID(ABUF, ws + W_DAQKV, NMA, 12, 1024, pg8::EpiQKV, E); } }
    SEAM(9);
    if (IN(11)) { PH_IDS; diff_attn_phase(args, c, lds, vcu, G, tid, wave, lane); }
    SEAM(11);
    if (IN(12)) { PH_IDS; { pg8::EpiResid<false, false> E{HL, HCX, (pg8::bf16_t*)HL, (pg8::bf16_t*)HCX, MOD + 1 * 9 * 6144 + 2048, nullptr, nullptr, nullptr, nullptr, b0}; GEMM_GRID(SBUF, ws + W_DAOUT, NMA, 4, 1024, PG8_ER(false, false), E); } }
    if (IN(12)) { if (NGRP == 1 && bx >= 32) { PH_IDS; conv_moe(args, 0, lds, (bx - 32) * NWAVES + wave, 224 * NWAVES, wave, lane, CM0_B, NE * 3 * 1408); } }
    SEAM(12);
    if (IN(13)) { PH_IDS; row_phase<false, true, true, false, false, true>(args, c, lds, HL, HCX, nullptr, nullptr, TTOT, args.in[I_NFFN] + 1 * 1024, MOD + 1 * 9 * 6144, 3072, nullptr, args.in[I_RW] + 0 * 8192, args.in[I_RB] + 0 * 8, vcu, G, tid, wave, lane); }
    SEAM(13);
    if (IN(14)) { PH_IDS; moe_scatter_phase<true>(c, lds, TTOT, vcu, G, tid, wave, lane); }
    if (NGRP == 2 && IN(14) && grp == 0) wait_flag(ctl + CW_FLAG_MOE);
    SEAM(14);
    if (IN(15)) { PH_IDS; { pg8::EpiSwiGLU8<false> E{(unsigned char*)HBUF, nullptr, nullptr, 0}; GEMM_MOE8(SBUF, ws + W_MOE, 22, 512, pg8::EpiSwiGLU8<false>, E); } }
    SEAM(15);
    if (IN(16)) { PH_IDS; { pg8::EpiMoeDown<true> E{(pg8::bf16_t*)SBUF, c.sgate}; GEMM_MOE8(HBUF, ws + W_MOE + 88 * MiB, 4, FF / 2, pg8::EpiMoeDown<true>, E); } }
    SEAM(16);
    if (IN(17)) { PH_IDS; row_phase<true, true, false, false, false>(args, c, lds, HL, HCX, HL, HCX, TTOT, args.in[I_NMIX] + 2 * 1024, MOD + 2 * 9 * 6144, 0, MOD + 1 * 9 * 6144 + 5120, nullptr, nullptr, vcu, G, tid, wave, lane); }
    SEAM(17);
    if (IN(18)) { PH_IDS; { pg8::EpiStore<1> E{(pg8::bf16_t*)HBUF, 4096, args.in[I_CMINB], c.ssq, 8}; GEMM_GRID(ABUF, ws + W_CMIN, NMA, 16, 1024, pg8::EpiStore<1>, E); } }
    SEAM(18);
    if (IN(19)) { PH_IDS; gate_phase(args, c, lds, vcu, G, tid, wave, lane); }
    SEAM(19);
    if (IN(20)) { PH_IDS; { pg8::EpiResid<true, false, true, false> E{HL, HCX, (pg8::bf16_t*)HL, (pg8::bf16_t*)HCX, MOD + 2 * 9 * 6144 + 2048, (pg8::bf16_t*)ABUF, args.in[I_NFFN] + 2 * 1024, MOD + 2 * 9 * 6144 + 4096, c.ssq, b0}; GEMM_GRID(SBUF, ws + W_CMOUT, NMA, 4, 2048, PG8_ER4(true, false, true, false), E); } }
    if (IN(20)) { if (NGRP == 1 && bx >= 32) { PH_IDS; conv_moe(args, 1, lds, (bx - 32) * NWAVES + wave, 224 * NWAVES, wave, lane, 0, CM1_A); } }
    SEAM(20);
    if (IN(22)) { PH_IDS; { pg8::EpiSwiGLU8<true> E{(unsigned char*)HBUF, c.ssq, (const float*)(ws + BIAS_P22), b0}; GEMM_GRID8(ABUF, ws + W_F13 + (size_t)5632 * 1024 * 2, NMA, 22, 512, pg8::EpiSwiGLU8<true>, E); } }
    SEAM(22);
    if (IN(23)) { PH_IDS; { pg8::EpiResid<true, false, false, true> E{HL, HCX, (pg8::bf16_t*)HL, (pg8::bf16_t*)HCX, MOD + 2 * 9 * 6144 + 5120, (pg8::bf16_t*)ABUF, args.in[I_NMIX] + 3 * 1024, MOD + 3 * 9 * 6144 + 1024, c.ssq, b0}; GEMM_GRID8(HBUF, ws + W_F2 + (size_t)1024 * 2816 * 2, NMA, 4, FF / 2, PG8_ER4(true, false, false, true), E); }
               }
    if (IN(23)) { if (NGRP == 1 && bx >= 32) { PH_IDS; conv_moe(args, 1, lds, (bx - 32) * NWAVES + wave, 224 * NWAVES, wave, lane, CM1_A, NE * 3 * 1408); } }
    SEAM(23);
    if (IN(25)) { PH_IDS; { pg8::EpiQKV E{(pg8::bf16_t*)HBUF, 1536, c.ssq, (const float*)(ws + BIAS_P25), 1536, 4, 1, args.in[I_SWQG], args.in[I_SWKG], (const float*)(ws + WS_RT), QSCALE, b0}; GEMM_GRID(ABUF, ws + W_SWQKV, NMA, 6, 1024, pg8::EpiQKV, E); } }
    SEAM(25);
    if (IN(27)) { PH_IDS; swa_attn_phase(args, c, lds, vcu, G, tid, wave, lane); }
    SEAM(27);
    if (IN(28)) { PH_IDS; { pg8::EpiResid<false, false> E{HL, HCX, (pg8::bf16_t*)HL, (pg8::bf16_t*)HCX, MOD + 3 * 9 * 6144 + 2048, nullptr, nullptr, nullptr, nullptr, b0}; GEMM_GRID(SBUF, ws + W_SWOUT, NML, 4, 1024, PG8_ER(false, false), E); } }
    SEAM(28);
    if (IN(29)) { PH_IDS; row_phase<false, true, true, false, false, true>(args, c, lds, HL, HCX, nullptr, nullptr, TLAT, args.in[I_NFFN] + 3 * 1024, MOD + 3 * 9 * 6144, 3072, nullptr, args.in[I_RW] + 1 * 8192, args.in[I_RB] + 1 * 8, vcu, G, tid, wave, lane); }
    SEAM(29);
    if (IN(30)) { PH_IDS; moe_scatter_phase<true>(c, lds, TLAT, vcu, G, tid, wave, lane); }
    SEAM(30);
    if (IN(31)) { PH_IDS; { pg8::EpiSwiGLU8<false> E{(unsigned char*)HBUF, nullptr, nullptr, 0}; GEMM_MOE8(SBUF, ws + W_MOE + W_MOE_STRIDE, 22, 512, pg8::EpiSwiGLU8<false>, E); } }
    SEAM(31);
    if (IN(32)) { PH_IDS; { pg8::EpiMoeDown<true> E{(pg8::bf16_t*)SBUF, c.sgate}; GEMM_MOE8(HBUF, ws + W_MOE + W_MOE_STRIDE + 88 * MiB, 4, FF / 2, pg8::EpiMoeDown<true>, E); } }
    SEAM(32);
    if (IN(33)) { PH_IDS; row_phase<true, false, false, false, true>(args, c, lds, HL, HCX, c.out, nullptr, TLAT, nullptr, nullptr, 0, MOD + 3 * 9 * 6144 + 5120, nullptr, nullptr, vcu, G, tid, wave, lane); }
#undef IN
#undef SEAM
}

extern "C" void kernel_launch(void* const* d_in, const int* in_sizes, int n_in, void* d_out, int out_size, void* d_ws, size_t ws_size, hipStream_t stream) {
    static int grid = 0;
    if (grid == 0) {
        if (n_in != N_IN || in_sizes[0] != NGRP * TLAT * D || out_size != NGRP * TLAT * D || ws_size < WS_END) { fprintf(stderr, "kernel_launch: unexpected shapes / workspace (n_in %d, ws %zu < %zu)\n", n_in, ws_size, (size_t)WS_END); grid = -1; return; }
        int dev = 0, cus = 0;
        if (hipGetDevice(&dev) != hipSuccess || hipDeviceGetAttribute(&cus, hipDeviceAttributeMultiprocessorCount, dev) != hipSuccess) { grid = -1; return; }
        if (hipFuncSetAttribute((const void*)mk_fwd, hipFuncAttributeMaxDynamicSharedMemorySize, LDS_BYTES) != hipSuccess) { fprintf(stderr, "kernel_launch: hipFuncSetAttribute failed\n"); grid = -1; return; }
        int per_cu = 0;
        if (hipOccupancyMaxActiveBlocksPerMultiprocessor(&per_cu, (const void*)mk_fwd, NTHR, LDS_BYTES) != hipSuccess || per_cu < 1) fprintf(stderr, "kernel_launch: occupancy query reports %d\n", per_cu);
        (void)hipGetLastError();
        grid = cus;
        if (grid != NGRP * GG) { fprintf(stderr, "kernel_launch: built for 256 CUs, found %d\n", cus); grid = -1; return; }
    }
    if (grid < 0) return;
    (void)hipMemsetAsync((char*)d_ws + WS_CTL, 0, CTL_ZERO_BYTES, stream);
    Args a{};
    for (int i = 0; i < N_IN; ++i) a.in[i] = (const float*)d_in[i];
    a.out = (float*)d_out; a.ws = (unsigned char*)d_ws;
    a.ph_lo = 0; a.ph_hi = N_PHASES; hipLaunchKernelGGL(mk_fwd, dim3(grid), dim3(NTHR), LDS_BYTES, stream, a);
}
```

```cpp
#include <hip/hip_runtime.h>
#include <cstdio>
#include <cstdint>
#include <cmath>
#ifndef MK_NGRP
#define MK_NGRP 1
#endif
#define MK_TLAT (32768 / MK_NGRP)
namespace pg8 {
#define PG8_LAS __attribute__((address_space(3)))
typedef unsigned short bf16_t;
typedef short bf16x8 __attribute__((ext_vector_type(8)));
typedef float f32x4 __attribute__((ext_vector_type(4)));
typedef unsigned u32x4 __attribute__((ext_vector_type(4)));
constexpr int BM = 256, BK = 64, HALF = 128, HTB = HALF * BK * 2  , STAGE_BYTES = 8 * HTB, NXCD = 8, WGM = 4;

__host__ __device__ __forceinline__ int lds_byte(int r, int c) { const int st = (r >> 4) * 2 + (c >> 5), rr = r & 15, cc = c & 31, ob = rr * 64 + cc * 2; return st * 1024 + (ob ^ (((ob >> 9) & 1) << 5)); }
__host__ __device__ __forceinline__ void stage_rc(int b, int& R, int& C) { const int st = b / 1024, sb = b % 1024, swz = sb ^ (((sb >> 9) & 1) << 5); R = (st >> 1) * 16 + swz / 64; C = (st & 1) * 32 + (swz % 64) / 2; }
__host__ __device__ __forceinline__ int perm32(int rho) { const int n = rho >> 4, i = rho & 15; return 8 * (i >> 2) + 4 * n + (i & 3); }

struct Unit { int pm, pn; };
struct Gemm { const bf16_t* A; const bf16_t* Bt; int M, N, K; };

struct StaticOrder {
    int nM, nN, nwg, G, c;
    __host__ __device__ void init(int M, int N, int G_, int c_) { nM = M / BM; nN = N / BM; nwg = nM * nN; G = G_; c = c_; }
    __host__ __device__ bool next(int i, Unit& u) const {
        const long L = (long)i * G + c; if (L >= nwg) return false;
        int wgid = (int)L; { const int q = nwg / NXCD, r = nwg % NXCD, xcd = wgid % NXCD, off = wgid / NXCD; wgid = (xcd < r ? xcd * (q + 1) : r * (q + 1) + (xcd - r) * q) + off; }
        const int nig = WGM * nN, gid = wgid / nig, fm = gid * WGM, gsz = (nM - fm) < WGM ? (nM - fm) : WGM;
        u.pm = fm + ((wgid % nig) % gsz); u.pn = (wgid % nig) / gsz; return true;
    }
    __device__ __forceinline__ void a_ready(const Unit&) const {}
    __device__ __forceinline__ void done(const Unit&) const {}
};

__device__ __forceinline__ unsigned cvt_pk_bf16(float lo, float hi) { unsigned r; asm volatile("v_cvt_pk_bf16_f32 %0, %1, %2" : "=v"(r) : "v"(lo), "v"(hi)); return r; }
typedef int i32x4_ __attribute__((ext_vector_type(4)));
constexpr float F8_SA = 16.f, F8_SW13 = 32.f, F8_SH = 4.f, F8_SW2 = 64.f, F8_SAU = 8.f;
__device__ __forceinline__ unsigned cvt_pk_fp8x4(float a, float b, float c, float d) {
    a = __builtin_amdgcn_fmed3f(a, -448.f, 448.f); b = __builtin_amdgcn_fmed3f(b, -448.f, 448.f); c = __builtin_amdgcn_fmed3f(c, -448.f, 448.f); d = __builtin_amdgcn_fmed3f(d, -448.f, 448.f);
    unsigned w = 0u; w = (unsigned)__builtin_amdgcn_cvt_pk_fp8_f32(a, b, (int)w, false); w = (unsigned)__builtin_amdgcn_cvt_pk_fp8_f32(c, d, (int)w, true); return w; }
__device__ __forceinline__ float bf_lo(unsigned u) { return __builtin_bit_cast(float, u << 16); }
__device__ __forceinline__ float bf_hi(unsigned u) { return __builtin_bit_cast(float, u & 0xffff0000u); }

typedef float f32x2 __attribute__((ext_vector_type(2)));
__device__ __forceinline__ float gelu_tanh1(float x) {
    const float u = 0.7978845608028654f * (x + 0.044715f * x * x * x);
    const float e = __builtin_amdgcn_exp2f(-2.8853900817779268f * u);
    return x * __builtin_amdgcn_rcpf(1.0f + e);
}
__device__ __forceinline__ float silu1(float x) { return x * __builtin_amdgcn_rcpf(1.0f + __builtin_amdgcn_exp2f(-1.4426950408889634f * x)); }
__device__ __forceinline__ void swiglu8(const float (&g)[8], const float (&u)[8], const float c1, const float K, float (&h)[8]) {
    float t[8], p[8];
#pragma unroll
    for (int j = 0; j < 8; ++j) t[j] = g[j] * c1;
    __builtin_amdgcn_sched_barrier(0);
#pragma unroll
    for (int j = 0; j < 8; ++j) t[j] = __builtin_amdgcn_exp2f(t[j]);
#pragma unroll
    for (int j = 0; j < 8; ++j) p[j] = g[j] * u[j];
    __builtin_amdgcn_sched_barrier(0);
#pragma unroll
    for (int j = 0; j < 8; ++j) t[j] = __builtin_fmaf(t[j], K, K);
    __builtin_amdgcn_sched_barrier(0);
#pragma unroll
    for (int j = 0; j < 8; ++j) t[j] = __builtin_amdgcn_rcpf(t[j]);
    __builtin_amdgcn_sched_barrier(0);
#pragma unroll
    for (int j = 0; j < 8; ++j) h[j] = p[j] * t[j];
}

__device__ __forceinline__ float row_rstd16(const float* ssq, int row) {
    const f32x4* p = (const f32x4*)(ssq + (size_t)row * 32); const f32x4 a = p[0], b = p[1], c = p[2], d = p[3];
    const float t = ((a.x + a.y) + (a.z + a.w)) + ((b.x + b.y) + (b.z + b.w)) + ((c.x + c.y) + (c.z + c.w)) + ((d.x + d.y) + (d.z + d.w));
    return 1.0f / sqrtf(t * (1.0f / 1024.0f) + 1e-6f);
}
template <int ACT> struct EpiStore {
    static constexpr bool PERM = true, AFTER_DRAIN = false;
    bf16_t* O; int ldc; const float* bias; float* ssq; int ssq_pn0;
    __device__ __forceinline__ void operator()(const f32x4 (&acc)[2][2][4][2], const Unit& u, int wr, int wc, int fr, int fq) const {
        const int row0 = u.pm * BM + wr * 64 + fr; const int col0 = u.pn * BM + wc * 32 + 8 * fq;
        f32x4 bv[2][2];
#pragma unroll
        for (int bj = 0; bj < 2; ++bj)
#pragma unroll
            for (int n = 0; n < 2; ++n) bv[bj][n] = bias ? *(const f32x4*)(bias + col0 + bj * HALF + 4 * n) : (f32x4){0.f, 0.f, 0.f, 0.f};
#pragma unroll
        for (int ai = 0; ai < 2; ++ai)
#pragma unroll
            for (int m = 0; m < 4; ++m) { bf16_t* rowp = O + (size_t)(row0 + ai * HALF + m * 16) * ldc + col0; float ss = 0.f;
#pragma unroll
                for (int bj = 0; bj < 2; ++bj) { f32x4 v0 = acc[ai][bj][m][0] + bv[bj][0], v1 = acc[ai][bj][m][1] + bv[bj][1];
                    if (ACT == 1) {
#pragma unroll
                        for (int i = 0; i < 4; ++i) { v0[i] = gelu_tanh1(v0[i]); v1[i] = gelu_tanh1(v1[i]); }
#pragma unroll
                        for (int i = 0; i < 4; ++i) ss += v0[i] * v0[i] + v1[i] * v1[i];
                    }
                    u32x4 w; w.x = cvt_pk_bf16(v0[0], v0[1]); w.y = cvt_pk_bf16(v0[2], v0[3]); w.z = cvt_pk_bf16(v1[0], v1[1]); w.w = cvt_pk_bf16(v1[2], v1[3]);
                    *(u32x4*)(rowp + bj * HALF) = w; }
                if (ACT == 1) { ss += __shfl_xor(ss, 16); ss += __shfl_xor(ss, 32);
                    if (u.pn >= ssq_pn0 && fq == 0) ssq[(size_t)(row0 + ai * HALF + m * 16) * 32 + (u.pn - ssq_pn0) * 4 + wc] = ss; }
            }
    }
};

struct EpiConvIn {
    static constexpr bool PERM = true, AFTER_DRAIN = false;
    bf16_t* O;
    __device__ __forceinline__ void operator()(const f32x4 (&acc)[2][2][4][2], const Unit& u, int wr, int wc, int fr, int fq) const {
        const int row0 = u.pm * BM + wr * 64 + fr;
        if (u.pn < 4) { const int col0 = u.pn * BM + wc * 32 + 8 * fq;
#pragma unroll
            for (int ai = 0; ai < 2; ++ai)
#pragma unroll
                for (int m = 0; m < 4; ++m) { bf16_t* rowp = O + (size_t)(row0 + ai * HALF + m * 16) * 2048 + col0;
#pragma unroll
                    for (int bj = 0; bj < 2; ++bj) { const f32x4 v0 = acc[ai][bj][m][0], v1 = acc[ai][bj][m][1];
                        u32x4 w; w.x = cvt_pk_bf16(v0[0], v0[1]); w.y = cvt_pk_bf16(v0[2], v0[3]); w.z = cvt_pk_bf16(v1[0], v1[1]); w.w = cvt_pk_bf16(v1[2], v1[3]);
                        *(u32x4*)(rowp + bj * HALF) = w; } }
        } else { const int col0 = 1024 + (u.pn - 4) * HALF + wc * 32 + 8 * fq;
#pragma unroll
            for (int ai = 0; ai < 2; ++ai)
#pragma unroll
                for (int m = 0; m < 4; ++m) { const f32x4 v0 = acc[ai][0][m][0] * acc[ai][1][m][0], v1 = acc[ai][0][m][1] * acc[ai][1][m][1];
                    u32x4 w; w.x = cvt_pk_bf16(v0[0], v0[1]); w.y = cvt_pk_bf16(v0[2], v0[3]); w.z = cvt_pk_bf16(v1[0], v1[1]); w.w = cvt_pk_bf16(v1[2], v1[3]);
                    *(u32x4*)(O + (size_t)(row0 + ai * HALF + m * 16) * 2048 + col0) = w; }
        }
    }
};

struct EpiQKV {
    static constexpr bool PERM = true, AFTER_DRAIN = false;
    bf16_t* O; int ldc; const float* ssq; const float* bias  ; int N; int nq_t, nk_t; const float* qg; const float* kg; const float* RT; float qscale; int b0;
    __device__ __forceinline__ void operator()(const f32x4 (&acc)[2][2][4][2], const Unit& u, int wr, int wc, int fr, int fq) const {
        const int prow = u.pm * BM; const bool lat = prow < MK_TLAT; const int cidx = lat ? b0 + (prow >> 12) : 8;
        const int rl0 = wr * 64 + fr; const int ncol0 = u.pn * BM + wc * 32 + 8 * fq;
        const float* bp = bias + (size_t)cidx * N + ncol0;
        f32x4 bv[2][2];
#pragma unroll
        for (int bj = 0; bj < 2; ++bj)
#pragma unroll
            for (int n = 0; n < 2; ++n) bv[bj][n] = *(const f32x4*)(bp + bj * HALF + 4 * n);
        const bool isq = u.pn < nq_t, isqk = u.pn < nq_t + nk_t;
        f32x4 gg[2][2];
        if (isqk) { const float* gp = isq ? qg : kg; const float sc = isq ? qscale : 1.0f;
#pragma unroll
            for (int bj = 0; bj < 2; ++bj)
#pragma unroll
                for (int n = 0; n < 2; ++n) gg[bj][n] = *(const f32x4*)(gp + bj * 32 + 16 * n + 4 * fq) * sc; }
        typedef unsigned u32x2q __attribute__((ext_vector_type(2)));
#pragma unroll
        for (int ai = 0; ai < 2; ++ai) {
            f32x4 csR, snR;
            if (isqk && lat) { const int posr = ((prow + wr * 64 + ai * HALF) & 4095) >> 6;
                const f32x4 t0 = *(const f32x4*)(RT + 2 * (posr * 16 + 4 * fq)), t1 = *(const f32x4*)(RT + 2 * (posr * 16 + 4 * fq) + 4);
                csR = (f32x4){t0.x, t0.z, t1.x, t1.z}; snR = (f32x4){t0.y, t0.w, t1.y, t1.w}; }
#pragma unroll
            for (int m = 0; m < 4; ++m) { const int row = prow + rl0 + ai * HALF + m * 16;
                const float rs = row_rstd16(ssq, row);
                f32x4 v[2][2]; float ss = 0.f;
#pragma unroll
                for (int bj = 0; bj < 2; ++bj)
#pragma unroll
                    for (int n = 0; n < 2; ++n) { v[bj][n] = acc[ai][bj][m][n] * rs + bv[bj][n]; ss += (v[bj][n].x * v[bj][n].x + v[bj][n].y * v[bj][n].y) + (v[bj][n].z * v[bj][n].z + v[bj][n].w * v[bj][n].w); }
                if (isqk) {
                    ss += __shfl_xor(ss, 16); ss += __shfl_xor(ss, 32);
                    const float rh = 1.0f / sqrtf(ss * (1.0f / 64.0f) + 1e-6f);
#pragma unroll
                    for (int bj = 0; bj < 2; ++bj)
#pragma unroll
                        for (int n = 0; n < 2; ++n) v[bj][n] = v[bj][n] * rh * gg[bj][n];
                    if (lat) {
                        { const f32x4 x1 = v[0][0], x2 = v[0][1]; v[0][0] = x1 * csR - x2 * snR; v[0][1] = x1 * snR + x2 * csR; }
                        { const int posc = fr + 16 * m;
                          const f32x4 t0 = *(const f32x4*)(RT + 2 * (posc * 16 + 4 * fq)), t1 = *(const f32x4*)(RT + 2 * (posc * 16 + 4 * fq) + 4);
                          const f32x4 cs = (f32x4){t0.x, t0.z, t1.x, t1.z}, sn = (f32x4){t0.y, t0.w, t1.y, t1.w};
                          const f32x4 x1 = v[1][0], x2 = v[1][1]; v[1][0] = x1 * cs - x2 * sn; v[1][1] = x1 * sn + x2 * cs; }
                    }
                    bf16_t* rowp = O + (size_t)row * ldc + u.pn * BM + wc * 64 + 4 * fq;
#pragma unroll
                    for (int bj = 0; bj < 2; ++bj)
#pragma unroll
                        for (int n = 0; n < 2; ++n) { u32x2q w; w.x = cvt_pk_bf16(v[bj][n][0], v[bj][n][1]); w.y = cvt_pk_bf16(v[bj][n][2], v[bj][n][3]); *(u32x2q*)(rowp + bj * 32 + 16 * n) = w; }
                } else {
                    bf16_t* rowp = O + (size_t)row * ldc + ncol0;
#pragma unroll
                    for (int bj = 0; bj < 2; ++bj) { u32x4 w; w.x = cvt_pk_bf16(v[bj][0][0], v[bj][0][1]); w.y = cvt_pk_bf16(v[bj][0][2], v[bj][0][3]); w.z = cvt_pk_bf16(v[bj][1][0], v[bj][1][1]); w.w = cvt_pk_bf16(v[bj][1][2], v[bj][1][3]);
                        *(u32x4*)(rowp + bj * HALF) = w; }
                }
            }
        }
    }
};

template <bool NIN, bool A8 = false> struct EpiSwiGLU {
    static constexpr bool PERM = true, AFTER_DRAIN = false;
    bf16_t* O; int ldo; const float* ssq; const float* bias  ; int b0;
    __device__ __forceinline__ void operator()(const f32x4 (&acc)[2][2][4][2], const Unit& u, int wr, int wc, int fr, int fq) const {
        const int row0 = u.pm * BM + wr * 64 + fr; const int col0 = (u.pn % 22) * HALF + wc * 32 + 8 * fq;
        f32x4 bv[2][2];
        if (NIN) { const int prow = u.pm * BM; const int cidx = prow < MK_TLAT ? b0 + (prow >> 12) : 8; const float* bp = bias + (size_t)cidx * 5632 + u.pn * BM + wc * 32 + 8 * fq;
#pragma unroll
            for (int bj = 0; bj < 2; ++bj)
#pragma unroll
                for (int n = 0; n < 2; ++n) bv[bj][n] = *(const f32x4*)(bp + bj * HALF + 4 * n); }
#pragma unroll
        for (int ai = 0; ai < 2; ++ai)
#pragma unroll
            for (int m = 0; m < 4; ++m) { const int row = row0 + ai * HALF + m * 16; bf16_t* rowp = O + (size_t)row * ldo + col0;
                float rs = 1.0f; if (NIN) rs = row_rstd16(ssq, row); if (A8) rs *= 1.0f / (F8_SAU * F8_SW13);
                float h[8], gg[8], uu[8];
#pragma unroll
                for (int n = 0; n < 2; ++n)
#pragma unroll
                    for (int i = 0; i < 4; ++i) { float gt = acc[ai][0][m][n][i], up = acc[ai][1][m][n][i]; if (NIN) { gt = gt * rs + bv[0][n][i]; up = up * rs + bv[1][n][i]; } gg[4 * n + i] = gt; uu[4 * n + i] = up; }
                swiglu8(gg, uu, -1.4426950408889634f, 1.0f, h);
                u32x4 w; w.x = cvt_pk_bf16(h[0], h[1]); w.y = cvt_pk_bf16(h[2], h[3]); w.z = cvt_pk_bf16(h[4], h[5]); w.w = cvt_pk_bf16(h[6], h[7]);
                *(u32x4*)rowp = w; }
    }
};

template <bool NIN, bool G8 = true> struct EpiSwiGLU8 {
    static constexpr bool PERM = true, AFTER_DRAIN = false;
    unsigned char* O; const float* ssq; const float* bias  ; int b0;
    static constexpr int ldo = 2816; static constexpr float in_scale = G8 ? 1.0f / ((NIN ? F8_SAU : F8_SA) * F8_SW13) : 1.0f, out_scale = F8_SH;
    __device__ __forceinline__ void operator()(const f32x4 (&acc)[2][2][4][2], const Unit& u, int wr, int wc, int fr, int fq) const {
        const int row0 = u.pm * BM + wr * 64 + fr; const int col0 = (u.pn % 22) * HALF + wc * 32 + 8 * fq;
        f32x4 bv[2][2];
        if (NIN) { const int prow = u.pm * BM; const int cidx = prow < MK_TLAT ? b0 + (prow >> 12) : 8; const float* bp = bias + (size_t)cidx * 5632 + u.pn * BM + wc * 32 + 8 * fq;
#pragma unroll
            for (int bj = 0; bj < 2; ++bj)
#pragma unroll
                for (int n = 0; n < 2; ++n) bv[bj][n] = *(const f32x4*)(bp + bj * HALF + 4 * n); }
#pragma unroll
        for (int ai = 0; ai < 2; ++ai)
#pragma unroll
            for (int m = 0; m < 4; ++m) { const int row = row0 + ai * HALF + m * 16;
                float rs = in_scale; if (NIN) rs = row_rstd16(ssq, row) * in_scale;
                float h[8], gg[8], uu[8];
#pragma unroll
                for (int n = 0; n < 2; ++n)
#pragma unroll
                    for (int i = 0; i < 4; ++i) { float gt = acc[ai][0][m][n][i], up = acc[ai][1][m][n][i]; if (NIN) { gt = gt * rs + bv[0][n][i]; up = up * rs + bv[1][n][i]; } gg[4 * n + i] = gt; uu[4 * n + i] = up; }
                if (NIN) swiglu8(gg, uu, -1.4426950408889634f, 1.0f / out_scale, h);
                else swiglu8(gg, uu, -1.4426950408889634f * in_scale, 1.0f / (in_scale * in_scale * out_scale), h);
                unsigned w0 = cvt_pk_fp8x4(h[0], h[1], h[2], h[3]), w1 = cvt_pk_fp8x4(h[4], h[5], h[6], h[7]);
                typedef unsigned u32x2_ __attribute__((ext_vector_type(2)));
                *(u32x2_*)(O + (size_t)row * ldo + col0) = (u32x2_){w0, w1}; }
    }
};

template <bool NEXT, bool SRC32, bool N8 = false, bool A8S = false> struct EpiResid {
    static constexpr bool PERM = true, AFTER_DRAIN = false; static constexpr float ascale = A8S ? 1.0f / (F8_SH * F8_SW2) : 1.0f;
    static constexpr int HP = 2048;
    const void* src_lat; const void* src_ctx; bf16_t* dst_lat; bf16_t* dst_ctx; const float* gate;
    bf16_t* An; const float* gn; const float* scn; float* ssq; int b0;
    __device__ __forceinline__ void operator()(const f32x4 (&acc)[2][2][4][2], const Unit& u, int wr, int wc, int fr, int fq) const {
        const int prow = u.pm * BM; const bool lat = prow < MK_TLAT; const int cidx = lat ? b0 + (prow >> 12) : 8;
        const float* s32 = lat ? (const float*)src_lat + (size_t)prow * 1024 : (const float*)src_ctx + (size_t)(prow - MK_TLAT) * 1024;
        const bf16_t* s16 = lat ? (const bf16_t*)src_lat + (size_t)prow * HP : (const bf16_t*)src_ctx + (size_t)(prow - MK_TLAT) * HP;
        bf16_t* d = lat ? dst_lat + (size_t)prow * HP : dst_ctx + (size_t)(prow - MK_TLAT) * HP;
        const int rl0 = wr * 64 + fr; const int col0 = u.pn * BM + wc * 32 + 8 * fq;
        const float* g = gate + (size_t)cidx * 6144 + col0;
        float ss[2][4];
#pragma unroll
        for (int ai = 0; ai < 2; ++ai)
#pragma unroll
            for (int m = 0; m < 4; ++m) ss[ai][m] = 0.f;
#pragma unroll
        for (int bj = 0; bj < 2; ++bj) {
            asm volatile("" ::: "memory");
            f32x4 gv[2], Gn[2];
#pragma unroll
            for (int n = 0; n < 2; ++n) { gv[n] = *(const f32x4*)(g + bj * HALF + 4 * n); if (A8S) gv[n] = gv[n] * ascale;
                if (NEXT) { Gn[n] = *(const f32x4*)(gn + col0 + bj * HALF + 4 * n) * (*(const f32x4*)(scn + (size_t)cidx * 6144 + col0 + bj * HALF + 4 * n) + 1.0f); if (N8) Gn[n] = Gn[n] * F8_SAU; } }
#pragma unroll
            for (int ai = 0; ai < 2; ++ai)
#pragma unroll
                for (int m = 0; m < 4; ++m) { if (m == 0) asm volatile("" ::: "memory");
                    const int rl = rl0 + ai * HALF + m * 16; f32x4 hn[2];
                    if (SRC32) { const size_t ro = (size_t)rl * 1024 + col0 + bj * HALF; hn[0] = *(const f32x4*)(s32 + ro); hn[1] = *(const f32x4*)(s32 + ro + 4); }
                    else { const u32x4 p = *(const u32x4*)(s16 + (size_t)rl * HP + col0 + bj * HALF);
                        hn[0] = f32x4{bf_lo(p.x), bf_hi(p.x), bf_lo(p.y), bf_hi(p.y)}; hn[1] = f32x4{bf_lo(p.z), bf_hi(p.z), bf_lo(p.w), bf_hi(p.w)}; }
#pragma unroll
                    for (int n = 0; n < 2; ++n) hn[n] = hn[n] + gv[n] * acc[ai][bj][m][n];
                    { u32x4 w; w.x = cvt_pk_bf16(hn[0][0], hn[0][1]); w.y = cvt_pk_bf16(hn[0][2], hn[0][3]); w.z = cvt_pk_bf16(hn[1][0], hn[1][1]); w.w = cvt_pk_bf16(hn[1][2], hn[1][3]);
                      *(u32x4*)(d + (size_t)rl * HP + col0 + bj * HALF) = w; }
                    if (NEXT) { ss[ai][m] += (hn[0].x * hn[0].x + hn[0].y * hn[0].y) + (hn[0].z * hn[0].z + hn[0].w * hn[0].w) + (hn[1].x * hn[1].x + hn[1].y * hn[1].y) + (hn[1].z * hn[1].z + hn[1].w * hn[1].w);
                        const f32x4 a0 = hn[0] * Gn[0], a1 = hn[1] * Gn[1];
                        if (N8) { typedef unsigned u32x2_ __attribute__((ext_vector_type(2)));
                            *(u32x2_*)((unsigned char*)An + (size_t)(prow + rl) * 1024 + col0 + bj * HALF) = (u32x2_){cvt_pk_fp8x4(a0[0], a0[1], a0[2], a0[3]), cvt_pk_fp8x4(a1[0], a1[1], a1[2], a1[3])}; }
                        else { u32x4 w; w.x = cvt_pk_bf16(a0[0], a0[1]); w.y = cvt_pk_bf16(a0[2], a0[3]); w.z = cvt_pk_bf16(a1[0], a1[1]); w.w = cvt_pk_bf16(a1[2], a1[3]);
                            *(u32x4*)(An + (size_t)(prow + rl) * 1024 + col0 + bj * HALF) = w; } } }
        }
        if (NEXT) {
#pragma unroll
            for (int ai = 0; ai < 2; ++ai)
#pragma unroll
                for (int m = 0; m < 4; ++m) { float t = ss[ai][m]; t += __shfl_xor(t, 16); t += __shfl_xor(t, 32); if (fq == 0) ssq[(size_t)(prow + rl0 + ai * HALF + m * 16) * 32 + u.pn * 4 + wc] = t; }
        }
    }
};

template <bool F8S> struct EpiMoeDown {
    static constexpr bool PERM = true, AFTER_DRAIN = false; static constexpr float scale = F8S ? 1.0f / (F8_SH * F8_SW2) : 1.0f;
    bf16_t* Y; const float* slot_gate;
    __device__ __forceinline__ void operator()(const f32x4 (&acc)[2][2][4][2], const Unit& u, int wr, int wc, int fr, int fq) const {
        const int row0 = u.pm * BM + wr * 64 + fr; const int col0 = (u.pn & 3) * BM + wc * 32 + 8 * fq;
#pragma unroll
        for (int ai = 0; ai < 2; ++ai)
#pragma unroll
            for (int m = 0; m < 4; ++m) { const int row = row0 + ai * HALF + m * 16; const float sg = slot_gate[row] * scale; bf16_t* rowp = Y + (size_t)row * 1024 + col0;
#pragma unroll
                for (int bj = 0; bj < 2; ++bj) { const f32x4 v0 = acc[ai][bj][m][0] * sg, v1 = acc[ai][bj][m][1] * sg;
                    u32x4 w; w.x = cvt_pk_bf16(v0[0], v0[1]); w.y = cvt_pk_bf16(v0[2], v0[3]); w.z = cvt_pk_bf16(v1[0], v1[1]); w.w = cvt_pk_bf16(v1[2], v1[3]);
                    *(u32x4*)(rowp + bj * HALF) = w; } }
    }
};

struct GridOrder {
    int nM, nN, nwg, G, c;
    __device__ void init(int nM_, int nN_, int G_, int c_) { nM = nM_; nN = nN_; nwg = nM * nN; G = G_; c = c_; }
    __device__ bool next(int i, Unit& u) const {
        const long L = (long)i * G + c; if (L >= nwg) return false;
        int wgid = (int)L; { const int q = nwg / NXCD, r = nwg % NXCD, xcd = wgid % NXCD, off = wgid / NXCD; wgid = (xcd < r ? xcd * (q + 1) : r * (q + 1) + (xcd - r) * q) + off; }
        const int nig = WGM * nN, gid = wgid / nig, fm = gid * WGM, gsz = (nM - fm) < WGM ? (nM - fm) : WGM;
        u.pm = fm + ((wgid % nig) % gsz); u.pn = (wgid % nig) / gsz; return true;
    }
    __device__ __forceinline__ void a_ready(const Unit&) const {}
    __device__ __forceinline__ void done(const Unit&) const {}
};
struct MoeOrder {
    GridOrder g; const PG8_LAS int* pexp; int nNe;
    __device__ bool next(int i, Unit& u) const { if (!g.next(i, u)) return false; u.pn += pexp[u.pm] * nNe; return true; }
    __device__ __forceinline__ void a_ready(const Unit&) const {}
    __device__ __forceinline__ void done(const Unit&) const {}
};
template <int NNE> struct MoeOrderC {
    int nM, c; const PG8_LAS int* pexp;
    __device__ bool next(int i, Unit& u) const {
        const int nwg = nM * NNE; const long L = (long)i * 256 + c; if (L >= nwg) return false;
        int wgid = (int)L; { const int q = nwg / NXCD, r = nwg % NXCD, xcd = wgid % NXCD, off = wgid / NXCD; wgid = (xcd < r ? xcd * (q + 1) : r * (q + 1) + (xcd - r) * q) + off; }
        constexpr int nig = WGM * NNE; const int gid = wgid / nig, fm = gid * WGM, gsz = (nM - fm) < WGM ? (nM - fm) : WGM;
        u.pm = fm + ((wgid % nig) % gsz); u.pn = (wgid % nig) / gsz; u.pn += pexp[u.pm] * NNE; return true;
    }
    __device__ __forceinline__ void a_ready(const Unit&) const {}
    __device__ __forceinline__ void done(const Unit&) const {}
};
__device__ __forceinline__ const char* sgpr_ptr(const char* p) { const unsigned long long v = (unsigned long long)p; const unsigned lo = __builtin_amdgcn_readfirstlane((unsigned)v), hi = __builtin_amdgcn_readfirstlane((unsigned)(v >> 32)); return (const char*)(((unsigned long long)hi << 32) | lo); }
template <class Epi, class Sched, bool ALIGN_EPI = false, bool SP2 = false, bool F8 = false>
__device__ __forceinline__ void gemm_phase(PG8_LAS unsigned char* lds, const Gemm g, const Sched& S, const Epi& E) {
    int tid_ = threadIdx.x; asm volatile("" : "+v"(tid_));
    const int tid = tid_, wid = __builtin_amdgcn_readfirstlane(tid >> 6), lane = tid & 63, wr = wid >> 2, wc = wid & 3, fr = lane & 15, fq = lane >> 4;
    const int K = g.K, nt = K / BK;
    unsigned voffA[2], voffB[2];
#pragma unroll
    for (int i = 0; i < 2; ++i) { int R, C; stage_rc(tid * 16 + i * 8192, R, C); const int Rb = Epi::PERM ? ((R & ~31) + perm32(R & 31)) : R;
        voffA[i] = (unsigned)(R * K + C) * 2u; voffB[i] = (unsigned)(Rb * K + C) * 2u; }
    const size_t kstep = (size_t)(BK * 2);
    const size_t hstep = (size_t)HALF * K * 2;
    const size_t tstep = 2 * hstep;
    const unsigned ldsw = (unsigned)wid * 1024u;
    const int aoff = lds_byte(wr * 64 + fr, fq * 8), boff = lds_byte(wc * 32 + fr, fq * 8);
#define PG8_SA(b, h) (((b) * 2 + (h)) * HTB)
#define PG8_SB(b, h) ((4 + (b) * 2 + (h)) * HTB)
#define PG8_STAGE(bufoff, gbase, voff) do { _Pragma("unroll") for (int _i = 0; _i < 2; ++_i) { unsigned _vo = (voff)[_i]; asm volatile("" : "+v"(_vo)); unsigned _lw = ldsw; asm volatile("" : "+s"(_lw)); \
        __builtin_amdgcn_global_load_lds((const unsigned*)((const char*)(gbase) + _vo), (PG8_LAS unsigned*)(lds + (bufoff) + _lw + _i * 8192), 16, 0, 0); } } while (0)
#define PG8_LDA(dst, b, h) do { _Pragma("unroll") for (int m = 0; m < 4; ++m) _Pragma("unroll") for (int k = 0; k < 2; ++k) dst[m][k] = *(const PG8_LAS bf16x8*)(lds + PG8_SA(b, h) + aoff + m * 2048 + k * 1024); } while (0)
#define PG8_LDB(dst, b, h) do { _Pragma("unroll") for (int n = 0; n < 2; ++n) _Pragma("unroll") for (int k = 0; k < 2; ++k) dst[n][k] = *(const PG8_LAS bf16x8*)(lds + PG8_SB(b, h) + boff + n * 2048 + k * 1024); } while (0)
#define PG8_CAT8(x0, x1) __builtin_shufflevector(__builtin_bit_cast(i32x4_, x0), __builtin_bit_cast(i32x4_, x1), 0, 1, 2, 3, 4, 5, 6, 7)
#define PG8_MMA(ai, bj, At, Bt) do { __builtin_amdgcn_s_setprio(1); if constexpr (F8) { _Pragma("unroll") for (int m = 0; m < 4; ++m) _Pragma("unroll") for (int n = 0; n < 2; ++n) \
        acc[ai][bj][m][n] = __builtin_amdgcn_mfma_scale_f32_16x16x128_f8f6f4(PG8_CAT8(Bt[n][0], Bt[n][1]), PG8_CAT8(At[m][0], At[m][1]), acc[ai][bj][m][n], 0, 0, 0, 0, 0, 0); } else { \
        _Pragma("unroll") for (int m = 0; m < 4; ++m) _Pragma("unroll") for (int n = 0; n < 2; ++n) _Pragma("unroll") for (int k = 0; k < 2; ++k) \
        acc[ai][bj][m][n] = __builtin_amdgcn_mfma_f32_16x16x32_bf16(Bt[n][k], At[m][k], acc[ai][bj][m][n], 0, 0, 0); } __builtin_amdgcn_s_setprio(0); } while (0)
#define PG8_WAIT_V(n) asm volatile("s_waitcnt vmcnt(" #n ")" ::: "memory")
#define PG8_WAIT_L(n) asm volatile("s_waitcnt lgkmcnt(" #n ")" ::: "memory")
#define PG8_BAR __builtin_amdgcn_s_barrier()
#define PG8_SCHED __builtin_amdgcn_sched_barrier(0)
    Unit cur, nxt; int ui = 0;
    if (!S.next(0, cur)) return;
    f32x4 acc[2][2][4][2];
#pragma unroll
    for (int a = 0; a < 2; ++a)
#pragma unroll
        for (int b = 0; b < 2; ++b)
#pragma unroll
            for (int m = 0; m < 4; ++m)
#pragma unroll
                for (int n = 0; n < 2; ++n) acc[a][b][m][n] = (f32x4){0.f, 0.f, 0.f, 0.f};
    bf16x8 At[4][2], B0[2][2], B1[2][2];
    const char* cA = (const char*)g.A + (size_t)cur.pm * tstep; const char* cB = (const char*)g.Bt + (size_t)cur.pn * tstep;
    S.a_ready(cur);
    if constexpr (SP2) {
        PG8_STAGE(PG8_SB(0, 0), cB, voffB); PG8_STAGE(PG8_SB(0, 1), cB + hstep, voffB); PG8_STAGE(PG8_SA(0, 0), cA, voffA); PG8_STAGE(PG8_SA(0, 1), cA + hstep, voffA);
        if (wr == 1) PG8_BAR;
        PG8_WAIT_V(2); PG8_BAR;
        PG8_STAGE(PG8_SB(1, 0), cB + kstep, voffB); PG8_STAGE(PG8_SA(1, 0), cA + kstep, voffA); PG8_STAGE(PG8_SB(1, 1), cB + hstep + kstep, voffB);
        PG8_WAIT_V(6); PG8_BAR;
    } else {
        PG8_STAGE(PG8_SB(0, 0), cB, voffB); PG8_STAGE(PG8_SA(0, 0), cA, voffA); PG8_STAGE(PG8_SB(0, 1), cB + hstep, voffB); PG8_STAGE(PG8_SA(0, 1), cA + hstep, voffA);
        if (wr == 1) PG8_BAR;
        PG8_WAIT_V(4); PG8_BAR;
        PG8_STAGE(PG8_SB(1, 0), cB + kstep, voffB); PG8_STAGE(PG8_SA(1, 0), cA + kstep, voffA); PG8_STAGE(PG8_SB(1, 1), cB + hstep + kstep, voffB);
        PG8_WAIT_V(6); PG8_BAR;
    }
    for (;;) {
        const bool has_next = S.next(ui + 1, nxt);
        const char* nA = has_next ? (const char*)g.A + (size_t)nxt.pm * tstep : cA; const char* nB = has_next ? (const char*)g.Bt + (size_t)nxt.pn * tstep : cB;
        for (int t = 0; t < nt; t += 2) {
            const bool last = (t == nt - 2);
            const char* a1 = cA + (size_t)(t + 1) * kstep;
            const char* a2 = last ? nA : cA + (size_t)(t + 2) * kstep; const char* b2 = last ? nB : cB + (size_t)(t + 2) * kstep;
            const char* a3 = a2 + kstep; const char* b3 = b2 + kstep;
            if (last && has_next) S.a_ready(nxt);
            if constexpr (SP2) {
            PG8_LDB(B0, 0, 0); PG8_LDB(B1, 0, 1); PG8_SCHED; PG8_LDA(At, 0, 0); PG8_STAGE(PG8_SA(1, 1), a1 + hstep, voffA);
            PG8_WAIT_V(8); PG8_WAIT_L(0); PG8_BAR; PG8_MMA(0, 0, At, B0); PG8_MMA(0, 1, At, B1); PG8_BAR; PG8_SCHED;
            PG8_LDA(At, 0, 1); PG8_STAGE(PG8_SB(0, 0), b2, voffB); PG8_STAGE(PG8_SB(0, 1), b2 + hstep, voffB); PG8_STAGE(PG8_SA(0, 0), a2, voffA);
            PG8_WAIT_V(8); PG8_WAIT_L(0); PG8_BAR; PG8_MMA(1, 0, At, B0); PG8_MMA(1, 1, At, B1); PG8_BAR; PG8_SCHED;
            PG8_LDB(B0, 1, 0); PG8_LDB(B1, 1, 1); PG8_SCHED; PG8_LDA(At, 1, 0); PG8_STAGE(PG8_SA(0, 1), a2 + hstep, voffA);
            PG8_WAIT_V(8); PG8_WAIT_L(0); PG8_BAR; PG8_MMA(0, 0, At, B0); PG8_MMA(0, 1, At, B1); PG8_BAR; PG8_SCHED;
            PG8_LDA(At, 1, 1); PG8_STAGE(PG8_SB(1, 0), b3, voffB); PG8_STAGE(PG8_SB(1, 1), b3 + hstep, voffB); PG8_STAGE(PG8_SA(1, 0), a3, voffA);
            PG8_WAIT_V(8); PG8_WAIT_L(0); PG8_BAR; PG8_MMA(1, 0, At, B0); PG8_MMA(1, 1, At, B1); PG8_BAR; PG8_SCHED;
            } else {
            PG8_LDB(B0, 0, 0); PG8_SCHED; PG8_LDA(At, 0, 0); PG8_STAGE(PG8_SA(1, 1), a1 + hstep, voffA);
            PG8_WAIT_L(8); PG8_BAR; PG8_WAIT_L(0); PG8_MMA(0, 0, At, B0); PG8_BAR; PG8_SCHED;
            PG8_LDB(B1, 0, 1); PG8_STAGE(PG8_SB(0, 0), b2, voffB);
            PG8_BAR; PG8_WAIT_L(0); PG8_MMA(0, 1, At, B1); PG8_BAR;
            PG8_LDA(At, 0, 1); PG8_STAGE(PG8_SA(0, 0), a2, voffA);
            PG8_BAR; PG8_WAIT_L(0); PG8_MMA(1, 0, At, B0); PG8_BAR; PG8_SCHED;
            PG8_STAGE(PG8_SB(0, 1), b2 + hstep, voffB);
            PG8_WAIT_V(6); PG8_BAR; PG8_MMA(1, 1, At, B1); PG8_BAR;
            PG8_LDB(B0, 1, 0); PG8_SCHED; PG8_LDA(At, 1, 0); PG8_STAGE(PG8_SA(0, 1), a2 + hstep, voffA);
            PG8_WAIT_L(8); PG8_BAR; PG8_WAIT_L(0); PG8_MMA(0, 0, At, B0); PG8_BAR; PG8_SCHED;
            PG8_LDB(B1, 1, 1); PG8_STAGE(PG8_SB(1, 0), b3, voffB);
            PG8_BAR; PG8_WAIT_L(0); PG8_MMA(0, 1, At, B1); PG8_BAR;
            PG8_LDA(At, 1, 1); PG8_STAGE(PG8_SA(1, 0), a3, voffA);
            PG8_BAR; PG8_WAIT_L(0); PG8_MMA(1, 0, At, B0); PG8_BAR; PG8_SCHED;
            PG8_STAGE(PG8_SB(1, 1), b3 + hstep, voffB);
            PG8_WAIT_V(6); PG8_BAR; PG8_MMA(1, 1, At, B1); PG8_BAR;
            }
        }
        if constexpr (ALIGN_EPI) { if (wr == 0) PG8_BAR; }
        if constexpr (!Epi::AFTER_DRAIN) { E(acc, cur, wr, wc, fr, fq); S.done(cur); }
        if (!has_next) break;
#pragma unroll
        for (int a = 0; a < 2; ++a)
#pragma unroll
            for (int b = 0; b < 2; ++b)
#pragma unroll
                for (int m = 0; m < 4; ++m)
#pragma unroll
                    for (int n = 0; n < 2; ++n) acc[a][b][m][n] = (f32x4){0.f, 0.f, 0.f, 0.f};
        cur = nxt; cA = nA; cB = nB; ++ui;
        if constexpr (ALIGN_EPI) { if (wr == 1) PG8_BAR; }
    }
    PG8_WAIT_V(0);
    if constexpr (!ALIGN_EPI) { if (wr == 0) PG8_BAR; }
    PG8_BAR;
    if constexpr (Epi::AFTER_DRAIN) { E.fused(acc, cur, wr, wc, fr, fq, lds, wid, lane); S.done(cur); }
#undef PG8_SA
#undef PG8_SB
#undef PG8_STAGE
#undef PG8_LDA
#undef PG8_LDB
#undef PG8_MMA
#undef PG8_CAT8
#undef PG8_WAIT_V
#undef PG8_WAIT_L
#undef PG8_BAR
#undef PG8_SCHED
}
}

#define GAS __attribute__((address_space(1)))
#define LAS __attribute__((address_space(3)))
typedef unsigned short bf16;
typedef unsigned v4u __attribute__((ext_vector_type(4)));
typedef unsigned v2u __attribute__((ext_vector_type(2)));
typedef float f32x4 __attribute__((ext_vector_type(4)));
typedef float f32x16 __attribute__((ext_vector_type(16)));
typedef short bf16x8 __attribute__((ext_vector_type(8)));
typedef short s16x4 __attribute__((ext_vector_type(4)));
typedef GAS unsigned gu32;
#define RLX_AGENT __ATOMIC_RELAXED, __HIP_MEMORY_SCOPE_AGENT
#define LDS_WAIT() asm volatile("s_waitcnt lgkmcnt(0)" ::: "memory")

#ifndef MK_NGRP
#define MK_NGRP 1
#endif
constexpr int D = 1024, NGRP = MK_NGRP, NB = 8 / NGRP, SEQ = 4096, CTXL = 256, TLAT = NB * SEQ, TCTX = NB * CTXL, TTOT = TLAT + TCTX;
constexpr int FF = 2816, NE = 8, MAXSLOT = 73728 / NGRP;
constexpr float EPS = 1e-6f;
constexpr int NWAVES = 8, NTHR = 512, GG = 256 / NGRP;
constexpr float LOG2E = 1.4426950408889634f;
constexpr float QSCALE = 0.125f * LOG2E;

enum { I_X = 0, I_C, I_CTX, I_CCTX, I_ADAW, I_ADAB, I_NMIX, I_NFFN, I_SCIN, I_SCCONV, I_SCOUT, I_DAQKV, I_DAOUT, I_DAQG, I_DAKG, I_DALAM, I_DASUB,
       I_CMIN, I_CMINB, I_CMVG, I_CMWS, I_CMBS, I_CMOUT, I_SWQKV, I_SWOUT, I_SWQG, I_SWKG, I_SWSINK, I_W1, I_W3, I_W2, I_RW, I_RB, I_MW1, I_MW3, I_MW2, N_IN };

constexpr size_t MiB = 1u << 20;
constexpr size_t WS_CTL = 0, CTL_ZERO_BYTES = 1 * MiB;
constexpr size_t WS_ZERO = 256 * 1024;
constexpr size_t WS_MOD = 1 * MiB;
constexpr size_t WS_RT = 2 * MiB;
constexpr size_t WS_WSB = 2 * MiB + 65536;
constexpr size_t WS_BIAS = 3 * MiB;
constexpr size_t BIAS_P6 = WS_BIAS, BIAS_P9 = BIAS_P6 + 9 * 5632 * 4, BIAS_P22 = BIAS_P9 + 9 * 3072 * 4, BIAS_P25 = BIAS_P22 + 9 * 5632 * 4;
constexpr size_t T_TOKG = (size_t)TTOT * 4, T_TOKS = T_TOKG + (size_t)TTOT * 8, T_SGATE = T_TOKS + (size_t)TTOT * 8, T_WGCNT = T_SGATE + (size_t)MAXSLOT * 4, T_PANEL = T_WGCNT + (size_t)GG * 32, T_END = T_PANEL + 4096;
static_assert(T_END <= 1 * MiB, "per-group token tables");
constexpr size_t WS_TOK = 4 * MiB, TOK_STRIDE = 1 * MiB;
constexpr size_t WS_SSQ = 6 * MiB, SSQ_STRIDE = (size_t)TTOT * 32 * 4;
constexpr size_t WS_HC = 11 * MiB;
constexpr size_t WS_W = 19 * MiB;
constexpr size_t W_SCIN = WS_W, W_SCOUT = W_SCIN + 6 * MiB, W_DAQKV = W_SCOUT + 2 * MiB, W_DAOUT = W_DAQKV + 6 * MiB, W_CMIN = W_DAOUT + 2 * MiB, W_CMOUT = W_CMIN + 8 * MiB,
                 W_SWQKV = W_CMOUT + 4 * MiB, W_SWOUT = W_SWQKV + 3 * MiB, W_F13 = W_SWOUT + 2 * MiB  , W_F2 = W_F13 + 22 * MiB  , W_MOE = W_F2 + 11 * MiB,
                 W_MOE_STRIDE = 132 * MiB  , W_END = W_MOE + 2 * W_MOE_STRIDE;
static_assert(W_END == 349 * MiB, "weight map");
static_assert(WS_ZERO + 512 * 1024 <= CTL_ZERO_BYTES && BIAS_P25 + 9 * 1536 * 4 <= WS_TOK && WS_SSQ + NGRP * SSQ_STRIDE <= WS_HC && WS_HC + (size_t)NGRP * TCTX * 4096 <= WS_W, "small-buffer map");
constexpr size_t WS_S = 349 * MiB, S_STRIDE = (size_t)MAXSLOT * 1024 * 2;
constexpr size_t WS_H = WS_S + NGRP * S_STRIDE, H_STRIDE = (size_t)MAXSLOT * 2816 * 2;
constexpr size_t A_IN_H = (size_t)TTOT * 4096 * 2;
constexpr size_t WS_END = WS_H + NGRP * H_STRIDE;
static_assert(WS_END == 889 * MiB && (size_t)TTOT * 4096 * 2 <= A_IN_H && A_IN_H + (size_t)TTOT * 1024 * 2 <= H_STRIDE && (size_t)TTOT * 2048 * 2 <= S_STRIDE, "ws map");

constexpr int CW_BAR = 4096;
constexpr int CW_FLAG_DENSE = 64, CW_FLAG_MOE = 128;

constexpr int RING_BYTES = 131072;
constexpr int PERS_OFF = RING_BYTES;
constexpr int MISC_OFF = PERS_OFF + 4096;
constexpr int LDS_BYTES = 147456;

__device__ __forceinline__ unsigned f2bf(float f) { unsigned u = __builtin_bit_cast(unsigned, f); return (u + 0x7fffu + ((u >> 16) & 1u)) >> 16; }
__device__ __forceinline__ unsigned pk2(float lo, float hi) { unsigned r; asm volatile("v_cvt_pk_bf16_f32 %0, %1, %2" : "=v"(r) : "v"(lo), "v"(hi)); return r; }
__device__ __forceinline__ float bflo(unsigned u) { return __builtin_bit_cast(float, u << 16); }
__device__ __forceinline__ float bfhi(unsigned u) { return __builtin_bit_cast(float, u & 0xffff0000u); }
constexpr int HPITCH = 2048;
__device__ __forceinline__ float wave_sum(float v) {
#pragma unroll
    for (int o = 1; o < 64; o <<= 1) v += __shfl_xor(v, o);
    return v;
}
#define XB_TMO      128
#define XB_XCNT(j)  (256  + 64 * (j))
#define XB_XSUB(j)  (1280 + 64 * (j))
#define XB_XGEN(j)  (2304 + 64 * (j))
#define XB_TOP      3328
#define XB_TOPGEN   3392
#define XCD_BAR_WORDS 3456
#define XB_SPIN_CAP (1u << 18)

__device__ __forceinline__ unsigned xb_ld(unsigned* p)              { return __hip_atomic_load(p, __ATOMIC_RELAXED, __HIP_MEMORY_SCOPE_AGENT); }
__device__ __forceinline__ unsigned xb_add(unsigned* p, unsigned v) { return __hip_atomic_fetch_add(p, v, __ATOMIC_RELAXED, __HIP_MEMORY_SCOPE_AGENT); }
__device__ __forceinline__ unsigned xb_xcc_id() { return (unsigned)__builtin_amdgcn_s_getreg((3 << 11) | 20) & 0xFu; }
#define XB_SPIN(cond, bar) do { unsigned _sp = 0; while (cond) { __builtin_amdgcn_s_sleep(1); \
    if ((++_sp & 255u) == 0u) { if (xb_ld(&(bar)[XB_TMO])) break; if (_sp > XB_SPIN_CAP) { atomicAdd(&(bar)[XB_TMO], 1u); break; } } } } while (0)

struct XcdBarrier {
    unsigned* bar; unsigned x; unsigned gsz;
    volatile LAS unsigned* st;
};

__device__ __forceinline__ XcdBarrier xcd_barrier_post(unsigned* bar, volatile LAS unsigned* st, unsigned gsz) {
    XcdBarrier b; b.bar = bar; b.x = xb_xcc_id(); b.st = st; b.gsz = gsz;
    if (threadIdx.x == 0) (void)xb_add(&bar[XB_XCNT(b.x)], 1u);
    return b;
}
__device__ __forceinline__ void xcd_barrier_complete(unsigned* bar, unsigned x, unsigned& nloc, unsigned& nx, unsigned G) {
    unsigned sum, cnt, mine, sp = 0u;
    for (;;) {
        sum = 0u; cnt = 0u; mine = 0u;
#pragma unroll
        for (unsigned j = 0; j < 16; ++j) { const unsigned c = xb_ld(&bar[XB_XCNT(j)]); sum += c; cnt += (c > 0u) ? 1u : 0u; mine = (j == x) ? c : mine; }
        if (sum == G) break;
        __builtin_amdgcn_s_sleep(1);
        if ((++sp & 255u) == 0u) { if (xb_ld(&bar[XB_TMO])) break; if (sp > XB_SPIN_CAP) { atomicAdd(&bar[XB_TMO], 1u); break; } }
    }
    nloc = mine > 0u ? mine : 1u; nx = cnt > 0u ? cnt : 1u;
}

__device__ __forceinline__ void xcd_barrier(const XcdBarrier& b) {
    asm volatile("s_waitcnt vmcnt(0)" ::: "memory");
    __syncthreads();
    if (threadIdx.x == 0) {
        unsigned* bar = b.bar;
        __builtin_amdgcn_s_waitcnt(0);
        unsigned nloc = b.st[0], nx = b.st[1];
        if (nloc == 0u) { xcd_barrier_complete(bar, b.x, nloc, nx, b.gsz); b.st[0] = nloc; b.st[1] = nx; }
        const unsigned old = xb_add(&bar[XB_XSUB(b.x)], 1u);
        const unsigned gen = old / nloc;
        if (old + 1u == (gen + 1u) * nloc) {
            __builtin_amdgcn_fence(__ATOMIC_RELEASE, "agent");
            asm volatile("s_waitcnt vmcnt(0)" ::: "memory");
            const unsigned og = xb_add(&bar[XB_TOP], 1u);
            const unsigned tg = og / nx;
            if (og + 1u == (tg + 1u) * nx) xb_add(&bar[XB_TOPGEN], 1u);
            else XB_SPIN(xb_ld(&bar[XB_TOPGEN]) == tg, bar);
            __builtin_amdgcn_fence(__ATOMIC_ACQUIRE, "agent");
            xb_add(&bar[XB_XGEN(b.x)], 1u);
            asm volatile("s_waitcnt vmcnt(0)" ::: "memory");
        } else {
            XB_SPIN(xb_ld(&bar[XB_XGEN(b.x)]) == gen, bar);
            __builtin_amdgcn_fence(__ATOMIC_ACQUIRE, "agent");
            asm volatile("s_waitcnt vmcnt(0)" ::: "memory");
        }
    }
    __syncthreads();
}

struct Args { const float* in[N_IN]; float* out; unsigned char* ws; int ph_lo, ph_hi; };
struct Grp {
    const float* x; const float* ctx; float* out; float* hc; bf16* A; bf16* S; bf16* H;
    int* toke; float* tokg; int* toks; float* sgate; int* wgcnt; int* panel; float* ssq; int b0;
};

template <bool RP = false> __device__ __forceinline__ void transpose_item(const float* __restrict__ W, int K, int N, bf16* WT, int k0, int n0, int drow0, LAS float* scr, int lane) {
    { f32x4 v[8]; const int r8 = lane >> 3, c4 = lane & 7;
#pragma unroll
      for (int i = 0; i < 8; ++i) v[i] = *(const f32x4*)(W + (size_t)(k0 + 8 * i + r8) * N + n0 + 4 * c4);
#pragma unroll
      for (int i = 0; i < 8; ++i) { LAS float* d = scr + (8 * i + r8) * 33 + 4 * c4; d[0] = v[i].x; d[1] = v[i].y; d[2] = v[i].z; d[3] = v[i].w; } }
    LDS_WAIT(); asm volatile("" ::: "memory");
    const int c = lane & 7;
#pragma unroll
    for (int j = 0; j < 4; ++j) { const int n = (lane >> 3) + 8 * j; const LAS float* s = scr + (8 * c) * 33 + n;
        v4u o; o.x = f2bf(s[0 * 33]) | (f2bf(s[1 * 33]) << 16); o.y = f2bf(s[2 * 33]) | (f2bf(s[3 * 33]) << 16); o.z = f2bf(s[4 * 33]) | (f2bf(s[5 * 33]) << 16); o.w = f2bf(s[6 * 33]) | (f2bf(s[7 * 33]) << 16);
        const int dn = RP ? (8 * ((n & 15) >> 2) + 4 * (n >> 4) + (n & 3)) : n;
        *(GAS v4u*)(WT + (size_t)(drow0 + dn) * K + k0 + 8 * c) = o; }
    LDS_WAIT(); asm volatile("" ::: "memory");
}
__device__ __forceinline__ void transpose_item8(const float* __restrict__ W, int K, int N, unsigned char* WT8, int k0, int n0, int drow0, float sc, LAS float* scr, int lane) {
    { f32x4 v[8]; const int r8 = lane >> 3, c4 = lane & 7;
#pragma unroll
      for (int i = 0; i < 8; ++i) v[i] = *(const f32x4*)(W + (size_t)(k0 + 8 * i + r8) * N + n0 + 4 * c4);
#pragma unroll
      for (int i = 0; i < 8; ++i) { LAS float* d = scr + (8 * i + r8) * 33 + 4 * c4; d[0] = v[i].x; d[1] = v[i].y; d[2] = v[i].z; d[3] = v[i].w; } }
    LDS_WAIT(); asm volatile("" ::: "memory");
    const int c = lane & 7;
#pragma unroll
    for (int j = 0; j < 4; ++j) { const int n = (lane >> 3) + 8 * j; const LAS float* s = scr + (8 * c) * 33 + n;
        v2u o; o.x = pg8::cvt_pk_fp8x4(s[0 * 33] * sc, s[1 * 33] * sc, s[2 * 33] * sc, s[3 * 33] * sc); o.y = pg8::cvt_pk_fp8x4(s[4 * 33] * sc, s[5 * 33] * sc, s[6 * 33] * sc, s[7 * 33] * sc);
        *(GAS v2u*)(WT8 + (size_t)(drow0 + n) * K + k0 + 8 * c) = o; }
    LDS_WAIT(); asm volatile("" ::: "memory");
}
template <int MODE> __device__ __forceinline__ void conv_item8(const float* W, int K, int N, unsigned char* WT8, int r, float sc, LAS float* scr, int lane) {
    const int nblk = N / 32, kb = r / nblk, nb = r % nblk, n0 = nb * 32;
    const int drow = (MODE == 0) ? n0 : ((n0 >> 7) * 256 + (n0 & 127) + (MODE == 2 ? 128 : 0));
    transpose_item8(W, K, N, WT8, kb * 64, n0, drow, sc, scr, lane);
}
template <int MODE> __device__ __forceinline__ void conv_item(const float* W, int K, int N, bf16* WT, int r, LAS float* scr, int lane, int nqk = 0) {
    const int nblk = N / 32, kb = r / nblk, nb = r % nblk, n0 = nb * 32;
    int drow = (MODE == 0) ? n0 : ((n0 >> 7) * 256 + (n0 & 127) + (MODE == 2 ? 128 : 0));
    if (MODE == 4) drow = (n0 < 1024) ? n0 : (1024 + (((n0 - 1024) & 1023) >> 7) * 256 + (n0 >= 2048 ? 128 : 0) + (n0 & 127));
    if (MODE == 3) { drow = (n0 < nqk) ? ((n0 >> 8) * 256 + ((n0 >> 5) & 1) * 128 + ((n0 >> 6) & 3) * 32) : n0;
        if (n0 < nqk) { transpose_item<true>(W, K, N, WT, kb * 64, n0, drow, scr, lane); return; } }
    transpose_item(W, K, N, WT, kb * 64, n0, drow, scr, lane);
}
constexpr bool D0_IN8 = true, D0_H8 = true;
constexpr bool D2_8 = true;
constexpr bool MOE8_L[2] = {true, true};
using pg8::F8_SA; using pg8::F8_SW13; using pg8::F8_SW2; using pg8::F8_SAU;
__device__ __forceinline__ void conv_moe(const Args& a, int f, LAS unsigned char* lds, int gw, int ngw, int wave, int lane, int it_lo = 0, int it_hi = NE * 3 * 1408) {
    LAS float* scr = (LAS float*)(lds + wave * 16384);
    constexpr int PER = 1408;
    bf16* w13 = (bf16*)(a.ws + W_MOE + (size_t)f * W_MOE_STRIDE); bf16* w2 = (bf16*)(a.ws + W_MOE + (size_t)f * W_MOE_STRIDE + 88 * MiB);
    for (int it = it_lo + gw; it < it_hi; it += ngw) {
        const int e = it / (3 * PER), rem = it % (3 * PER), which = rem / PER, r = rem % PER;
        const size_t eo = ((size_t)f * NE + e) * 1024 * 2816;
        if (MOE8_L[f]) {
            unsigned char* w13b = (unsigned char*)w13; unsigned char* w2b = (unsigned char*)w2;
            if (which == 0)      conv_item8<1>(a.in[I_MW1] + eo, 1024, 2816, w13b + (size_t)e * 5632 * 1024, r, F8_SW13, scr, lane);
            else if (which == 1) conv_item8<2>(a.in[I_MW3] + eo, 1024, 2816, w13b + (size_t)e * 5632 * 1024, r, F8_SW13, scr, lane);
            else                 conv_item8<0>(a.in[I_MW2] + eo, 2816, 1024, w2b + (size_t)e * 1024 * 2816, r, F8_SW2, scr, lane);
            continue; }
        if (which == 0)      conv_item<1>(a.in[I_MW1] + eo, 1024, 2816, w13 + (size_t)e * 5632 * 1024, r, scr, lane);
        else if (which == 1) conv_item<2>(a.in[I_MW3] + eo, 1024, 2816, w13 + (size_t)e * 5632 * 1024, r, scr, lane);
        else                 conv_item<0>(a.in[I_MW2] + eo, 2816, 1024, w2 + (size_t)e * 1024 * 2816, r, scr, lane);
    }
}
__device__ __forceinline__ void conv_dense(const Args& a, LAS unsigned char* lds, int gw, int ngw, int wave, int lane) {
    LAS float* scr = (LAS float*)(lds + wave * 16384);
    constexpr int N_SCIN = 16 * 96, N_1K = 16 * 32, N_CMIN = 16 * 128, N_CMOUT = 32 * 32, N_SWQKV = 16 * 48, N_FF = 1408;
    constexpr int TOTAL = N_SCIN + N_1K + N_SCIN + N_1K + N_CMIN + N_CMOUT + N_SWQKV + N_1K + 6 * N_FF;
    unsigned char* ws = a.ws;
    for (int it = gw; it < TOTAL; it += ngw) {
        int r = it;
        if (r < N_SCIN) { conv_item<4>(a.in[I_SCIN], 1024, 3072, (bf16*)(ws + W_SCIN), r, scr, lane); continue; } r -= N_SCIN;
        if (r < N_1K) { conv_item<0>(a.in[I_SCOUT], 1024, 1024, (bf16*)(ws + W_SCOUT), r, scr, lane); continue; } r -= N_1K;
        if (r < N_SCIN) { conv_item<3>(a.in[I_DAQKV], 1024, 3072, (bf16*)(ws + W_DAQKV), r, scr, lane, 2048); continue; } r -= N_SCIN;
        if (r < N_1K) { conv_item<0>(a.in[I_DAOUT], 1024, 1024, (bf16*)(ws + W_DAOUT), r, scr, lane); continue; } r -= N_1K;
        if (r < N_CMIN) { conv_item<0>(a.in[I_CMIN], 1024, 4096, (bf16*)(ws + W_CMIN), r, scr, lane); continue; } r -= N_CMIN;
        if (r < N_CMOUT) { conv_item<0>(a.in[I_CMOUT], 2048, 1024, (bf16*)(ws + W_CMOUT), r, scr, lane); continue; } r -= N_CMOUT;
        if (r < N_SWQKV) { conv_item<3>(a.in[I_SWQKV], 1024, 1536, (bf16*)(ws + W_SWQKV), r, scr, lane, 1280); continue; } r -= N_SWQKV;
        if (r < N_1K) { conv_item<0>(a.in[I_SWOUT], 1024, 1024, (bf16*)(ws + W_SWOUT), r, scr, lane); continue; } r -= N_1K;
        const int f = r / (3 * N_FF), rem = r % (3 * N_FF), which = rem / N_FF, rr = rem % N_FF; const size_t fo = (size_t)f * 1024 * 2816;
        if ((which < 2) ? (f == 0 ? D0_IN8 : D2_8) : (f == 0 ? D0_H8 : D2_8)) {
            unsigned char* w13b = ws + W_F13 + (size_t)f * 5632 * 1024 * 2; unsigned char* w2b = ws + W_F2 + (size_t)f * 1024 * 2816 * 2;
            if (which == 0)      conv_item8<1>(a.in[I_W1] + fo, 1024, 2816, w13b, rr, F8_SW13, scr, lane);
            else if (which == 1) conv_item8<2>(a.in[I_W3] + fo, 1024, 2816, w13b, rr, F8_SW13, scr, lane);
            else                 conv_item8<0>(a.in[I_W2] + fo, 2816, 1024, w2b, rr, F8_SW2, scr, lane);
            continue; }
        if (which == 0)      conv_item<1>(a.in[I_W1] + fo, 1024, 2816, (bf16*)(ws + W_F13) + (size_t)f * 5632 * 1024, rr, scr, lane);
        else if (which == 1) conv_item<2>(a.in[I_W3] + fo, 1024, 2816, (bf16*)(ws + W_F13) + (size_t)f * 5632 * 1024, rr, scr, lane);
        else                 conv_item<0>(a.in[I_W2] + fo, 2816, 1024, (bf16*)(ws + W_F2) + (size_t)f * 1024 * 2816, rr, scr, lane);
    }
}
__device__ __forceinline__ void adaln_phase(const Args& a, LAS unsigned char* lds, int vcu, int G, int tid) {
    LAS float* sl = (LAS float*)lds;
    LAS float* red = sl + 9 * 1024;
    for (int i = tid; i < 9 * 1024; i += NTHR) { const float cv = (i < 8192) ? a.in[I_C][i] : a.in[I_CCTX][i - 8192]; sl[i] = cv / (1.0f + __expf(-cv)); }
    __syncthreads();
    float* MOD = (float*)(a.ws + WS_MOD);
    const int c4 = tid & 63, kg = tid >> 6;
    for (int u = vcu; u < 4 * 24; u += G) {
        const int l = u / 24, n0 = (u % 24) * 256;
        const float* w = a.in[I_ADAW] + (size_t)l * 1024 * 6144 + n0 + 4 * c4;
        f32x4 acc[9];
#pragma unroll
        for (int ci = 0; ci < 9; ++ci) acc[ci] = (f32x4){0.f, 0.f, 0.f, 0.f};
#pragma unroll 1
        for (int k0 = kg * 128; k0 < kg * 128 + 128; k0 += 8) { f32x4 wv[8];
#pragma unroll
            for (int j = 0; j < 8; ++j) wv[j] = *(const f32x4*)(w + (size_t)(k0 + j) * 6144);
#pragma unroll
            for (int j = 0; j < 8; ++j)
#pragma unroll
                for (int ci = 0; ci < 9; ++ci) acc[ci] += wv[j] * sl[ci * 1024 + k0 + j]; }
#pragma unroll
        for (int ci = 0; ci < 9; ++ci) *(LAS f32x4*)(red + (kg * 9 + ci) * 256 + 4 * c4) = acc[ci];
        __syncthreads();
        for (int o = tid; o < 9 * 256; o += NTHR) { const int ci = o >> 8, cc = o & 255; float s = a.in[I_ADAB][l * 6144 + n0 + cc];
#pragma unroll
            for (int k2 = 0; k2 < 8; ++k2) s += red[(k2 * 9 + ci) * 256 + cc];
            MOD[(size_t)(l * 9 + ci) * 6144 + n0 + cc] = s; }
        __syncthreads();
    }
}
__device__ __forceinline__ void rope_table(const Args& a, int tid) {
    float* RT = (float*)(a.ws + WS_RT);
    for (int i = tid; i < 1024; i += NTHR) {
        const int p = i >> 4, f = i & 15;
        double inv = 1.0; for (int j = 0; j < f; ++j) inv *= 0.56234132519034908;
        const float ang = (float)p * (float)inv;
        const double x = (double)ang;
        const double kq = __builtin_rint(x * 0.63661977236758134);
        const double r = (x - kq * 1.5707963267948966) - kq * 6.123233995736766e-17;
        const double r2 = r * r;
        double sn = 1.0, cs = 1.0;
        sn = 1.0 - r2 / (18.0 * 19.0) * sn; sn = 1.0 - r2 / (16.0 * 17.0) * sn; sn = 1.0 - r2 / (14.0 * 15.0) * sn; sn = 1.0 - r2 / (12.0 * 13.0) * sn; sn = 1.0 - r2 / (10.0 * 11.0) * sn;
        sn = 1.0 - r2 / (8.0 * 9.0) * sn; sn = 1.0 - r2 / (6.0 * 7.0) * sn; sn = 1.0 - r2 / (4.0 * 5.0) * sn; sn = 1.0 - r2 / (2.0 * 3.0) * sn; sn *= r;
        cs = 1.0 - r2 / (17.0 * 18.0) * cs; cs = 1.0 - r2 / (15.0 * 16.0) * cs; cs = 1.0 - r2 / (13.0 * 14.0) * cs; cs = 1.0 - r2 / (11.0 * 12.0) * cs; cs = 1.0 - r2 / (9.0 * 10.0) * cs;
        cs = 1.0 - r2 / (7.0 * 8.0) * cs; cs = 1.0 - r2 / (5.0 * 6.0) * cs; cs = 1.0 - r2 / (3.0 * 4.0) * cs; cs = 1.0 - r2 / (1.0 * 2.0) * cs;
        const int q = ((int)kq) & 3;
        const double c = (q == 0) ? cs : (q == 1) ? -sn : (q == 2) ? -cs : sn;
        const double s = (q == 0) ? sn : (q == 1) ? cs : (q == 2) ? -sn : -cs;
        RT[2 * i] = (float)c; RT[2 * i + 1] = (float)s;
    }
}

__device__ __forceinline__ void bias_rows(const bf16* Wt, int N, const float* sh  , float* B, int first, int gw, int ngw, int lane) {
    for (int n = gw - first; n < N; n += ngw) { if (n < 0) continue;
        const v4u w0 = ((const v4u*)(Wt + (size_t)n * 1024))[lane], w1 = ((const v4u*)(Wt + (size_t)n * 1024))[lane + 64];
        const float wf[16] = {bflo(w0.x), bfhi(w0.x), bflo(w0.y), bfhi(w0.y), bflo(w0.z), bfhi(w0.z), bflo(w0.w), bfhi(w0.w), bflo(w1.x), bfhi(w1.x), bflo(w1.y), bfhi(w1.y), bflo(w1.z), bfhi(w1.z), bflo(w1.w), bfhi(w1.w)};
#pragma unroll 1
        for (int ci = 0; ci < 9; ++ci) { const f32x4* sp = (const f32x4*)(sh + (size_t)ci * 6144); const f32x4 a = sp[2 * lane], b = sp[2 * lane + 1], c = sp[128 + 2 * lane], d = sp[128 + 2 * lane + 1];
            float t = (a.x * wf[0] + a.y * wf[1]) + (a.z * wf[2] + a.w * wf[3]) + (b.x * wf[4] + b.y * wf[5]) + (b.z * wf[6] + b.w * wf[7]) + (c.x * wf[8] + c.y * wf[9]) + (c.z * wf[10] + c.w * wf[11]) + (d.x * wf[12] + d.y * wf[13]) + (d.z * wf[14] + d.w * wf[15]);
            t = wave_sum(t); if (lane == 0) B[(size_t)ci * N + n] = t; }
    }
}
__device__ __forceinline__ void bias_rows8(const unsigned char* Wt8, int N, float winv, const float* sh, float* B, int gw, int ngw, int lane) {
    typedef float f32x2_ __attribute__((ext_vector_type(2)));
    for (int n = gw; n < N; n += ngw) {
        const v4u w = ((const v4u*)(Wt8 + (size_t)n * 1024))[lane];
        float wf[16];
#pragma unroll
        for (int q = 0; q < 4; ++q) { const int wd = (int)(q == 0 ? w.x : q == 1 ? w.y : q == 2 ? w.z : w.w);
            const f32x2_ lo = __builtin_amdgcn_cvt_pk_f32_fp8(wd, false), hi = __builtin_amdgcn_cvt_pk_f32_fp8(wd, true); wf[4 * q] = lo.x; wf[4 * q + 1] = lo.y; wf[4 * q + 2] = hi.x; wf[4 * q + 3] = hi.y; }
#pragma unroll 1
        for (int ci = 0; ci < 9; ++ci) { const f32x4* sp = (const f32x4*)(sh + (size_t)ci * 6144); const f32x4 a = sp[4 * lane], b = sp[4 * lane + 1], c = sp[4 * lane + 2], d = sp[4 * lane + 3];
            float t = (a.x * wf[0] + a.y * wf[1]) + (a.z * wf[2] + a.w * wf[3]) + (b.x * wf[4] + b.y * wf[5]) + (b.z * wf[6] + b.w * wf[7]) + (c.x * wf[8] + c.y * wf[9]) + (c.z * wf[10] + c.w * wf[11]) + (d.x * wf[12] + d.y * wf[13]) + (d.z * wf[14] + d.w * wf[15]);
            t = wave_sum(t); if (lane == 0) B[(size_t)ci * N + n] = t * winv; }
    }
}
__device__ __forceinline__ void bias_phase(const Args& a, int gw, int ngw, int lane) {
    const float* MOD = (const float*)(a.ws + WS_MOD);
    if (D0_IN8) bias_rows8(a.ws + W_F13, 5632, 1.0f / F8_SW13, MOD + 0 * 9 * 6144 + 3072, (float*)(a.ws + BIAS_P6), gw, ngw, lane);
    else bias_rows((const bf16*)(a.ws + W_F13), 5632, MOD + 0 * 9 * 6144 + 3072, (float*)(a.ws + BIAS_P6), 0, gw, ngw, lane);
    bias_rows((const bf16*)(a.ws + W_DAQKV), 3072, MOD + 1 * 9 * 6144 + 0, (float*)(a.ws + BIAS_P9), 0, gw, ngw, lane);
    if (D2_8) bias_rows8(a.ws + W_F13 + (size_t)5632 * 1024 * 2, 5632, 1.0f / F8_SW13, MOD + 2 * 9 * 6144 + 3072, (float*)(a.ws + BIAS_P22), gw, ngw, lane);
    else bias_rows((const bf16*)(a.ws + W_F13) + (size_t)5632 * 1024, 5632, MOD + 2 * 9 * 6144 + 3072, (float*)(a.ws + BIAS_P22), 0, gw, ngw, lane);
    bias_rows((const bf16*)(a.ws + W_SWQKV), 1536, MOD + 3 * 9 * 6144 + 0, (float*)(a.ws + BIAS_P25), 0, gw, ngw, lane);
}

template <bool COMBINE, bool NORM, bool ROUTER, bool SRC32, bool OUT32, bool A8 = false>
__device__ __forceinline__ void row_phase(const Args& a, const Grp& c, LAS unsigned char* lds, const void* src_lat, const void* src_ctx, void* dst_lat, void* dst_ctx, int nrows,
                                          const float* gn, const float* mod  , int sh_off  , const float* mod_prev_g2  ,
                                          const float* rw, const float* rb, int vcu, int G, int tid, int wave, int lane) {
    LAS float* wrT = (LAS float*)lds;
    LAS int* hist = (LAS int*)(lds + 32768);
    if (ROUTER) {
        for (int i = tid; i < 8192; i += NTHR) { const int k = i >> 3, e = i & 7; wrT[e * 1024 + k] = rw[i]; }
        if (tid < 8) hist[tid] = 0;
        __syncthreads();
    }
    bf16* A = c.A;
    const bf16* Y = c.S;
    const int* toks = c.toks;
    int* toke = c.toke; float* tokg = c.tokg;
    f32x4 gv[4];
    if (NORM) {
#pragma unroll
        for (int j = 0; j < 4; ++j) gv[j] = ((const f32x4*)gn)[lane + 64 * j];
    }
    const int gw = vcu * NWAVES + wave, ngw = G * NWAVES;
    struct RowRegs { f32x4 v[4]; v2u hraw[4]; v2u q0[4], q1[4]; };
    auto ld = [&](const int m, RowRegs& r) __attribute__((always_inline)) {
        const bool lat = m < TLAT;
        if (SRC32) { const float* hr = lat ? (const float*)src_lat + (size_t)m * 1024 : (const float*)src_ctx + (size_t)(m - TLAT) * 1024;
#pragma unroll
            for (int j = 0; j < 4; ++j) r.v[j] = ((const f32x4*)hr)[lane + 64 * j];
        } else { const bf16* hr = lat ? (const bf16*)src_lat + (size_t)m * HPITCH : (const bf16*)src_ctx + (size_t)(m - TLAT) * HPITCH;
#pragma unroll
            for (int j = 0; j < 4; ++j) r.hraw[j] = ((const v2u*)hr)[lane + 64 * j];
        }
        if (COMBINE) {
            const int s0 = toks[2 * m], s1 = toks[2 * m + 1];
            const v2u* y0 = (const v2u*)(Y + (size_t)s0 * 1024); const v2u* y1 = (const v2u*)(Y + (size_t)s1 * 1024);
#pragma unroll
            for (int j = 0; j < 4; ++j) { r.q0[j] = y0[lane + 64 * j]; r.q1[j] = y1[lane + 64 * j]; }
        }
    };
    auto body = [&](const int m, RowRegs& r) __attribute__((always_inline)) {
        const bool lat = m < TLAT; const int cidx = lat ? c.b0 + (m >> 12) : 8;
        f32x4 (&v)[4] = r.v;
        if (!SRC32) {
#pragma unroll
            for (int j = 0; j < 4; ++j) { const v2u p = r.hraw[j]; v[j] = f32x4{bflo(p.x), bfhi(p.x), bflo(p.y), bfhi(p.y)}; }
        }
        if (COMBINE) {
            const f32x4* g2 = (const f32x4*)(mod_prev_g2 + (size_t)cidx * 6144);
            float* hw32 = (float*)dst_lat + (size_t)m * 1024;
            bf16* hw = lat ? (bf16*)dst_lat + (size_t)m * HPITCH : (bf16*)dst_ctx + (size_t)(m - TLAT) * HPITCH;
            if (OUT32) asm volatile("" ::: "memory");
#pragma unroll
            for (int j = 0; j < 4; ++j) { const v2u p0 = r.q0[j], p1 = r.q1[j]; const f32x4 g = g2[lane + 64 * j];
                f32x4 ys; ys.x = bflo(p0.x) + bflo(p1.x); ys.y = bfhi(p0.x) + bfhi(p1.x); ys.z = bflo(p0.y) + bflo(p1.y); ys.w = bfhi(p0.y) + bfhi(p1.y);
                v[j] = v[j] + g * ys;
                if (OUT32) ((f32x4*)hw32)[lane + 64 * j] = v[j]; else { v2u o; o.x = pk2(v[j].x, v[j].y); o.y = pk2(v[j].z, v[j].w); ((v2u*)hw)[lane + 64 * j] = o; } }
        }
        if (NORM) {
            float ss = 0.f;
#pragma unroll
            for (int j = 0; j < 4; ++j) ss += (v[j].x * v[j].x + v[j].y * v[j].y) + (v[j].z * v[j].z + v[j].w * v[j].w);
            const float rstd = 1.0f / sqrtf(wave_sum(ss) * (1.0f / 1024.0f) + EPS);
            const f32x4* shp = (const f32x4*)(mod + (size_t)cidx * 6144 + sh_off); const f32x4* scp = shp + 256;
            v2u* ar = (v2u*)(A + (size_t)m * 1024);
#pragma unroll
            for (int j = 0; j < 4; ++j) { const f32x4 sh = shp[lane + 64 * j], sc = scp[lane + 64 * j];
                v[j] = (v[j] * rstd * gv[j]) * (sc + 1.0f) + sh;
                if (A8) ((unsigned*)((unsigned char*)A + (size_t)m * 1024))[lane + 64 * j] = pg8::cvt_pk_fp8x4(v[j].x * F8_SA, v[j].y * F8_SA, v[j].z * F8_SA, v[j].w * F8_SA);
                else { v2u o; o.x = pk2(v[j].x, v[j].y); o.y = pk2(v[j].z, v[j].w); ar[lane + 64 * j] = o; } }
            if (ROUTER) {
                float lg[8];
#pragma unroll
                for (int e = 0; e < 8; ++e) { float s = 0.f;
#pragma unroll
                    for (int j = 0; j < 4; ++j) { const f32x4 w = ((const LAS f32x4*)(wrT + e * 1024))[lane + 64 * j]; s += (v[j].x * w.x + v[j].y * w.y) + (v[j].z * w.z + v[j].w * w.w); }
                    lg[e] = wave_sum(s) + rb[e]; }
                int i0 = 0; float v0 = lg[0];
#pragma unroll
                for (int e = 1; e < 8; ++e) if (lg[e] > v0) { v0 = lg[e]; i0 = e; }
                int i1 = -1; float v1 = -INFINITY;
#pragma unroll
                for (int e = 0; e < 8; ++e) if (e != i0 && lg[e] > v1) { v1 = lg[e]; i1 = e; }
                const float ex = __expf(v1 - v0); const float g0 = 1.0f / (1.0f + ex), g1 = ex * g0;
                if (lane == 0) { toke[m] = i0 | (i1 << 8); tokg[2 * m] = g0; tokg[2 * m + 1] = g1; atomicAdd((int*)(hist + i0), 1); atomicAdd((int*)(hist + i1), 1); }
            }
        }
    };
    for (int m = gw; m < nrows; m += 2 * ngw) {
        RowRegs ra, rb; const int mb = m + ngw; const bool hb = mb < nrows;
        ld(m, ra); ld(hb ? mb : m, rb);
        body(m, ra); if (hb) body(mb, rb);
    }
    if (ROUTER) { __syncthreads(); if (tid < 8) c.wgcnt[vcu * 8 + tid] = hist[tid]; }
}

template <bool A8>
__device__ __forceinline__ void moe_scatter_phase(const Grp& c, LAS unsigned char* lds, int nrows, int vcu, int G, int tid, int wave, int lane) {
    LAS int* cnt = (LAS int*)lds;
    LAS int* base = cnt + 2048;
    LAS int* tot = base + 8;
    LAS int* slots = tot + 8;
    const int* wg = c.wgcnt;
    for (int i = tid; i < GG * 8; i += NTHR) cnt[i] = wg[i];
    __syncthreads();
    if (tid < 8) { int t = 0, b = 0; for (int w = 0; w < G; ++w) { const int c = cnt[w * 8 + tid]; if (w < vcu) b += c; t += c; } tot[tid] = t; base[tid] = b; }
    __syncthreads();
    if (tid == 0) { int ps = 0; int* pan = c.panel; int np = 0;
        for (int e = 0; e < 8; ++e) { const int t = tot[e]; base[e] += ps; const int npe = (t + 255) >> 8;
            if (vcu == 0) for (int p = 0; p < npe; ++p) pan[1 + np + p] = e;
            np += npe; ps += npe * 256; }
        if (vcu == 0) pan[0] = np; }
    __syncthreads();
    const int* toke = c.toke; const float* tokg = c.tokg;
    int* toks = c.toks; float* sgate = c.sgate;
    const int ntok = (nrows / (G * NWAVES)) * NWAVES;
    if (wave == 0) {
        int run[8];
#pragma unroll
        for (int e = 0; e < 8; ++e) run[e] = base[e];
        for (int p0 = 0; p0 < ntok; p0 += 64) {
            const int j = p0 + lane; const bool ok = j < ntok; const int m = (vcu * NWAVES + (j & 7)) + (G * NWAVES) * (j >> 3);
            int e0 = -1, e1 = -1; if (ok) { const int ee = toke[m]; e0 = ee & 255; e1 = ee >> 8; }
            int s0 = 0, s1 = 0;
            const unsigned long long below = (lane == 0) ? 0ull : (~0ull >> (64 - lane));
#pragma unroll
            for (int e = 0; e < 8; ++e) { const unsigned long long mk = __ballot(e0 == e || e1 == e); const int rk = __popcll(mk & below);
                if (e0 == e) s0 = run[e] + rk; if (e1 == e) s1 = run[e] + rk; run[e] += __popcll(mk); }
            if (ok) { slots[2 * j] = s0; slots[2 * j + 1] = s1; toks[2 * m] = s0; toks[2 * m + 1] = s1; sgate[s0] = tokg[2 * m]; sgate[s1] = tokg[2 * m + 1]; }
        }
    }
    __syncthreads();
    const bf16* A = c.A; bf16* S = c.S;
    constexpr int RE = A8 ? 512 : 1024;
    for (int j0 = wave; j0 < ntok; j0 += 4 * NWAVES) {
        v4u x[4][2]; int sl[4][2];
#pragma unroll
        for (int r = 0; r < 4; ++r) { const int j = j0 + r * NWAVES; if (j < ntok) { const int m = (vcu * NWAVES + (j & 7)) + (G * NWAVES) * (j >> 3);
            const v4u* src = (const v4u*)(A + (size_t)m * RE); x[r][0] = src[lane]; if (!A8) x[r][1] = src[lane + 64]; sl[r][0] = slots[2 * j]; sl[r][1] = slots[2 * j + 1]; } }
#pragma unroll
        for (int r = 0; r < 4; ++r) { const int j = j0 + r * NWAVES; if (j < ntok) {
            v4u* d0 = (v4u*)(S + (size_t)sl[r][0] * RE); v4u* d1 = (v4u*)(S + (size_t)sl[r][1] * RE);
            d0[lane] = x[r][0]; d1[lane] = x[r][0]; if (!A8) { d0[lane + 64] = x[r][1]; d1[lane + 64] = x[r][1]; } } }
    }
}

__device__ __forceinline__ void conv_phase(const Args& a, const Grp& c, int vcu, int G, int wave, int lane) {
    const bf16* U = c.H; bf16* Z = c.S;
    const float* cw = a.in[I_SCCONV];
    const int gw = vcu * NWAVES + wave, ngw = G * NWAVES;
    for (int it = gw; it < (TTOT / 16) * 2; it += ngw) {
        const int strip = it >> 1, c0 = (it & 1) * 512 + lane * 8, t0 = strip * 16;
        const int seqlen = (t0 < TLAT) ? SEQ : CTXL; const int tin = (t0 < TLAT) ? (t0 & (SEQ - 1)) : ((t0 - TLAT) & (CTXL - 1));
        float w0[8], w1[8], w2[8];
#pragma unroll
        for (int i = 0; i < 8; ++i) { w0[i] = cw[c0 + i]; w1[i] = cw[1024 + c0 + i]; w2[i] = cw[2048 + c0 + i]; }
        float yp[8], yc[8], yn[8];
        auto ld_y = [&](int t, float (&y)[8]) { const v4u yv = *(const v4u*)(U + (size_t)t * 2048 + 1024 + c0);
            y[0] = bflo(yv.x); y[1] = bfhi(yv.x); y[2] = bflo(yv.y); y[3] = bfhi(yv.y); y[4] = bflo(yv.z); y[5] = bfhi(yv.z); y[6] = bflo(yv.w); y[7] = bfhi(yv.w); };
        if (tin > 0) ld_y(t0 - 1, yp); else {
#pragma unroll
            for (int i = 0; i < 8; ++i) yp[i] = 0.f; }
        ld_y(t0, yc);
#pragma unroll 4
        for (int r = 0; r < 16; ++r) {
            const int t = t0 + r;
            if (tin + r + 1 < seqlen) ld_y(t + 1, yn); else {
#pragma unroll
                for (int i = 0; i < 8; ++i) yn[i] = 0.f; }
            const v4u bg = *(const v4u*)(U + (size_t)t * 2048 + c0);
            float b[8] = {bflo(bg.x), bfhi(bg.x), bflo(bg.y), bfhi(bg.y), bflo(bg.z), bfhi(bg.z), bflo(bg.w), bfhi(bg.w)};
            float z[8];
#pragma unroll
            for (int i = 0; i < 8; ++i) z[i] = b[i] * (w0[i] * yp[i] + w1[i] * yc[i] + w2[i] * yn[i]);
            v4u o; o.x = pk2(z[0], z[1]); o.y = pk2(z[2], z[3]); o.z = pk2(z[4], z[5]); o.w = pk2(z[6], z[7]);
            *(v4u*)(Z + (size_t)t * 1024 + c0) = o;
#pragma unroll
            for (int i = 0; i < 8; ++i) { yp[i] = yc[i]; yc[i] = yn[i]; }
        }
    }
}

__device__ __forceinline__ void qknorm_phase(const Args& a, const Grp& c, int ld, int nq, int nk, const float* qg, const float* kg, int vcu, int G, int wave, int lane) {
    bf16* QKV = c.H; const float* RT = (const float*)(a.ws + WS_RT);
    const int j8 = lane & 7;
    const int fb = 8 * (j8 & 1); const bool second = (j8 >> 1) & 1; const bool usecol = j8 >= 4;
    float gq[8], gk[8];
#pragma unroll
    for (int i = 0; i < 8; ++i) { gq[i] = qg[8 * j8 + i] * QSCALE; gk[i] = kg[8 * j8 + i]; }
    const int nch = (nq + nk) * 8;
    const int gw = vcu * NWAVES + wave, ngw = G * NWAVES;
    for (int m = gw; m < TTOT; m += ngw) {
        const bool lat = m < TLAT; const int s = m & (SEQ - 1); const int pos = usecol ? (s & 63) : (s >> 6);
        bf16* rowp = QKV + (size_t)m * ld;
        v4u raw[4];
#pragma unroll
        for (int k = 0; k < 4; ++k) { const int ch = lane + 64 * k; if (ch < nch) raw[k] = *(const v4u*)(rowp + ch * 8); }
        float cs[8], sn[8];
        if (lat) {
#pragma unroll
            for (int i = 0; i < 8; ++i) { const float2 t = *(const float2*)(RT + 2 * (pos * 16 + fb + i)); cs[i] = t.x; sn[i] = t.y; }
        }
#pragma unroll
        for (int k = 0; k < 4; ++k) { const int ch = lane + 64 * k;
            if (ch < nch) {
                const bool isq = (ch >> 3) < nq;
                float x[8] = {bflo(raw[k].x), bfhi(raw[k].x), bflo(raw[k].y), bfhi(raw[k].y), bflo(raw[k].z), bfhi(raw[k].z), bflo(raw[k].w), bfhi(raw[k].w)};
                float ss = 0.f;
#pragma unroll
                for (int i = 0; i < 8; ++i) ss += x[i] * x[i];
                ss += __shfl_xor(ss, 1); ss += __shfl_xor(ss, 2); ss += __shfl_xor(ss, 4);
                const float rstd = 1.0f / sqrtf(ss * (1.0f / 64.0f) + EPS);
#pragma unroll
                for (int i = 0; i < 8; ++i) x[i] = x[i] * rstd * (isq ? gq[i] : gk[i]);
                if (lat) {
#pragma unroll
                    for (int i = 0; i < 8; ++i) { const float o = __shfl_xor(x[i], 2); x[i] = second ? (o * sn[i] + x[i] * cs[i]) : (x[i] * cs[i] - o * sn[i]); }
                }
                v4u w; w.x = pk2(x[0], x[1]); w.y = pk2(x[2], x[3]); w.z = pk2(x[4], x[5]); w.w = pk2(x[6], x[7]);
                *(v4u*)(rowp + ch * 8) = w; } }
    }
}
constexpr int KP = 144;
__device__ __forceinline__ s16x4 vtr(const LAS unsigned char* p) { typedef short v4i16_t __attribute__((ext_vector_type(4)));
    return __builtin_bit_cast(s16x4, __builtin_amdgcn_ds_read_tr16_b64_v4i16((LAS v4i16_t*)p)); }
__device__ __forceinline__ int crow(int r, int hi) { return (r & 3) + 8 * (r >> 2) + 4 * hi; }

template <bool MASK>
__device__ __forceinline__ void attn_qk(const LAS unsigned char* Kb, const bf16x8 (&qr)[4], float nb2, float& lsum, v4u (&pw)[4], int lane, int kpos0, int qpos) {
    const int r32 = lane & 31, hi = lane >> 5;
    const LAS unsigned char* kp = Kb + r32 * KP + hi * 16;
    float acc = 0.f;
#pragma unroll
    for (int h = 0; h < 2; ++h) {
        f32x16 sc;
#pragma unroll
        for (int r = 0; r < 16; ++r) sc[r] = nb2;
#pragma unroll
        for (int d0 = 0; d0 < 4; ++d0) { const bf16x8 a0 = *(const LAS bf16x8*)(kp + h * 32 * KP + d0 * 32); sc = __builtin_amdgcn_mfma_f32_32x32x16_bf16(a0, qr[d0], sc, 0, 0, 0); }
#pragma unroll
        for (int r = 0; r < 16; ++r) { float p = __builtin_amdgcn_exp2f(sc[r]);
            if (MASK) { const int dd = kpos0 + 32 * h + crow(r, hi) - qpos; if (dd < -128 || dd > 128) p = 0.f; }
            sc[r] = p; acc += p; }
#pragma unroll
        for (int i = 0; i < 4; ++i) { pw[2 * h][i] = pk2(sc[2 * i], sc[2 * i + 1]); pw[2 * h + 1][i] = pk2(sc[8 + 2 * i], sc[8 + 2 * i + 1]); }
        asm volatile("" :: "v"(pw[2 * h]), "v"(pw[2 * h + 1]));
    }
    lsum += acc;
}
template <int NDV, int VP>
__device__ __forceinline__ void attn_pv(const LAS unsigned char* Vb, const v4u (&pw)[4], f32x16 (&o)[NDV], int lane) {
    const int hi = lane >> 5, i16 = lane & 15, rh = (lane >> 4) & 1;
    const LAS unsigned char* vp = Vb + (4 * hi + (i16 >> 2)) * VP + rh * 32 + (i16 & 3) * 8;
#pragma unroll
    for (int t = 0; t < NDV; ++t)
#pragma unroll
        for (int ks = 0; ks < 4; ++ks) {
            const s16x4 lo = vtr(vp + (16 * ks) * VP + t * 64), hh = vtr(vp + (16 * ks + 8) * VP + t * 64);
            const bf16x8 vf = (bf16x8){lo[0], lo[1], lo[2], lo[3], hh[0], hh[1], hh[2], hh[3]};
            o[t] = __builtin_amdgcn_mfma_f32_32x32x16_bf16(vf, __builtin_bit_cast(bf16x8, pw[ks]), o[t], 0, 0, 0);
        }
}
template <int NDV  , int VP, bool MASK>
__device__ __forceinline__ void attn_tile(const LAS unsigned char* Kb, const LAS unsigned char* Vb, const bf16x8 (&qr)[4], float nb2, f32x16 (&o)[NDV], float& lsum, int lane, int kpos0, int qpos) {
    const int r32 = lane & 31, hi = lane >> 5;
    f32x16 s0, s1;
#pragma unroll
    for (int r = 0; r < 16; ++r) { s0[r] = nb2; s1[r] = nb2; }
    const LAS unsigned char* kp = Kb + r32 * KP + hi * 16;
#pragma unroll
    for (int d0 = 0; d0 < 4; ++d0) {
        const bf16x8 a0 = *(const LAS bf16x8*)(kp + d0 * 32), a1 = *(const LAS bf16x8*)(kp + 32 * KP + d0 * 32);
        s0 = __builtin_amdgcn_mfma_f32_32x32x16_bf16(a0, qr[d0], s0, 0, 0, 0);
        s1 = __builtin_amdgcn_mfma_f32_32x32x16_bf16(a1, qr[d0], s1, 0, 0, 0);
    }
    float acc = 0.f;
#pragma unroll
    for (int r = 0; r < 16; ++r) {
        float p0 = __builtin_amdgcn_exp2f(s0[r]), p1 = __builtin_amdgcn_exp2f(s1[r]);
        if (MASK) { const int k0 = kpos0 + crow(r, hi), k1 = k0 + 32; const int d0 = k0 - qpos, d1 = k1 - qpos;
            if (d0 < -128 || d0 > 128) p0 = 0.f; if (d1 < -128 || d1 > 128) p1 = 0.f; }
        s0[r] = p0; s1[r] = p1; acc += p0 + p1;
    }
    lsum += acc;
    v4u pw[4];
#pragma unroll
    for (int i = 0; i < 4; ++i) { pw[0][i] = pk2(s0[2 * i], s0[2 * i + 1]); pw[1][i] = pk2(s0[8 + 2 * i], s0[8 + 2 * i + 1]); pw[2][i] = pk2(s1[2 * i], s1[2 * i + 1]); pw[3][i] = pk2(s1[8 + 2 * i], s1[8 + 2 * i + 1]); }
    const int i16 = lane & 15, rh = (lane >> 4) & 1;
    const LAS unsigned char* vp = Vb + (4 * hi + (i16 >> 2)) * VP + rh * 32 + (i16 & 3) * 8;
#pragma unroll
    for (int t = 0; t < NDV; ++t)
#pragma unroll
        for (int ks = 0; ks < 4; ++ks) {
            const s16x4 lo = vtr(vp + (16 * ks) * VP + t * 64), hh = vtr(vp + (16 * ks + 8) * VP + t * 64);
            const bf16x8 vf = (bf16x8){lo[0], lo[1], lo[2], lo[3], hh[0], hh[1], hh[2], hh[3]};
            o[t] = __builtin_amdgcn_mfma_f32_32x32x16_bf16(vf, __builtin_bit_cast(bf16x8, pw[ks]), o[t], 0, 0, 0);
        }
}

__device__ __forceinline__ void diff_attn_phase(const Args& a, const Grp& c, LAS unsigned char* lds, int vcu, int G, int tid, int wave, int lane) {
    constexpr int VP = 320, KBUF = 64 * KP, VBUF = 64 * VP, BUF = KBUF + VBUF;
    const bf16* QKV = c.H; bf16* O = c.S;
    const float* lp = a.in[I_DALAM];
    float l01 = lp[lane] * lp[64 + lane], l23 = lp[128 + lane] * lp[192 + lane];
    l01 = wave_sum(l01); l23 = wave_sum(l23);
    const float lam_init = 0.8f - 0.6f * 0.7408182206817179f;
    const float lam = __expf(l01) - __expf(l23) + lam_init;
    float mq = fabsf(a.in[I_DAQG][lane]), mk = fabsf(a.in[I_DAKG][lane]);
#pragma unroll
    for (int o = 1; o < 64; o <<= 1) { mq = fmaxf(mq, __shfl_xor(mq, o)); mk = fmaxf(mk, __shfl_xor(mk, o)); }
    const float nb2 = -(8.0f * mq * mk * LOG2E * 1.001f + 0.01f);
    const float* subg = a.in[I_DASUB];
    const int r32 = lane & 31, hi = lane >> 5;
    const int krow = tid >> 3, kch = tid & 7;
    const unsigned koff = (unsigned)(krow * 6144 + kch * 16), voff = (unsigned)((tid >> 4) * 6144 + (tid & 15) * 16);
    for (int id = vcu; id < NB * 8 * 16 + NB * 8; id += G) {
        int b, h, nkt; size_t qrow0;
        if (id < NB * 8 * 16) { const int bh = id >> 4, qb = id & 15; b = bh >> 3; h = bh & 7; nkt = 68; qrow0 = (size_t)b * SEQ + qb * 256; }
        else { const int bh = id - NB * 8 * 16; b = bh >> 3; h = bh & 7; nkt = 4; qrow0 = (size_t)TLAT + b * CTXL; }
        const size_t ctx0 = (size_t)TLAT + b * CTXL, lat0 = (size_t)b * SEQ;
        const size_t qrow = qrow0 + wave * 32 + r32;
        v4u* o0l = (v4u*)((unsigned char*)c.A + (size_t)vcu * 65536 + wave * 8192) + lane;
#pragma unroll 1
        for (int map = 0; map < 2; ++map) {
            const int kh = 2 * h + map;
            bf16x8 qr[4];
#pragma unroll
            for (int d0 = 0; d0 < 4; ++d0) qr[d0] = *(const bf16x8*)(QKV + qrow * 3072 + kh * 64 + d0 * 16 + hi * 8);
            f32x16 o[4];
#pragma unroll
            for (int t = 0; t < 4; ++t)
#pragma unroll
                for (int r = 0; r < 16; ++r) o[t][r] = 0.f;
            float lsum = 0.f;
            v4u kreg, vreg0, vreg1;
            auto ld_tile = [&](int t) { const size_t r0 = (t < 4) ? ctx0 + t * 64 : lat0 + (size_t)(t - 4) * 64;
                const char* kb = (const char*)(QKV + r0 * 3072 + 1024 + kh * 64); const char* vb = (const char*)(QKV + r0 * 3072 + 2048 + h * 128);
                kreg = *(const v4u*)(kb + koff); vreg0 = *(const v4u*)(vb + voff); vreg1 = *(const v4u*)(vb + 32 * 6144 + voff); };
            auto st_tile = [&](int buf) { LAS unsigned char* base = lds + buf * BUF;
                *(LAS v4u*)(base + krow * KP + kch * 16) = kreg;
                *(LAS v4u*)(base + KBUF + (tid >> 4) * VP + (tid & 15) * 16) = vreg0;
                *(LAS v4u*)(base + KBUF + (32 + (tid >> 4)) * VP + (tid & 15) * 16) = vreg1; };
            ld_tile(0); st_tile(0); ld_tile(1); __syncthreads();
            if (wave < 4) {
                int bcur = 0;
#pragma unroll 1
                for (int t = 0; t < nkt; ++t) {
                    const int bnext = (bcur == 2) ? 0 : bcur + 1;
                    if (t + 1 < nkt) st_tile(bnext);
                    if (t + 2 < nkt) ld_tile(t + 2);
                    const LAS unsigned char* base = lds + bcur * BUF; v4u pw[4];
                    attn_qk<false>(base, qr, nb2, lsum, pw, lane, 0, 0); attn_pv<4, VP>(base + KBUF, pw, o, lane);
                    asm volatile("s_waitcnt lgkmcnt(0)\n\ts_barrier" ::: "memory");
                    bcur = bnext;
                }
            } else {
                int bcur = 0, bprev = 2; v4u pw[4];
#pragma unroll
                for (int i = 0; i < 4; ++i) pw[i] = (v4u){0u, 0u, 0u, 0u};
#pragma unroll 1
                for (int t = 0; t < nkt; ++t) {
                    const int bnext = (bcur == 2) ? 0 : bcur + 1;
                    if (t + 1 < nkt) st_tile(bnext);
                    if (t + 2 < nkt) ld_tile(t + 2);
                    if (t > 0) attn_pv<4, VP>(lds + bprev * BUF + KBUF, pw, o, lane);
                    attn_qk<false>(lds + bcur * BUF, qr, nb2, lsum, pw, lane, 0, 0);
                    asm volatile("s_waitcnt lgkmcnt(0)\n\ts_barrier" ::: "memory");
                    bprev = bcur; bcur = bnext;
                }
                attn_pv<4, VP>(lds + bprev * BUF + KBUF, pw, o, lane);
            }
            asm volatile("s_waitcnt lgkmcnt(0)\n\ts_barrier" ::: "memory");
            const float l = lsum + __shfl_xor(lsum, 32); const float inv = 1.0f / l;
            if (map == 0) {
#pragma unroll
                for (int t = 0; t < 4; ++t)
#pragma unroll
                    for (int r4 = 0; r4 < 2; ++r4) { v4u w;
#pragma unroll
                        for (int i = 0; i < 4; ++i) w[i] = pk2(o[t][8 * r4 + 2 * i] * inv, o[t][8 * r4 + 2 * i + 1] * inv);
                        o0l[(t * 2 + r4) * 64] = w; }
            } else {
                const float li = lam * inv; float ss = 0.f;
#pragma unroll
                for (int t = 0; t < 4; ++t)
#pragma unroll
                    for (int r4 = 0; r4 < 2; ++r4) { const v4u w = o0l[(t * 2 + r4) * 64];
#pragma unroll
                        for (int i = 0; i < 4; ++i) { const unsigned u = w[i]; const int r = 4 * r4 + i; const float d0 = bflo(u) - li * o[t][2 * r], d1 = bfhi(u) - li * o[t][2 * r + 1]; o[t][2 * r] = d0; o[t][2 * r + 1] = d1; ss += d0 * d0 + d1 * d1; } }
                ss += __shfl_xor(ss, 32);
                const float rs = (1.0f / sqrtf(ss * (1.0f / 128.0f) + EPS)) * (1.0f - lam_init);
                bf16* orow = O + qrow * 1024 + h * 128;
#pragma unroll
                for (int t = 0; t < 4; ++t)
#pragma unroll
                    for (int g = 0; g < 4; ++g) { const int dv = 32 * t + 8 * g + 4 * hi; const f32x4 sg = *(const f32x4*)(subg + dv);
                        v2u w; w.x = pk2(o[t][4 * g] * rs * sg.x, o[t][4 * g + 1] * rs * sg.y); w.y = pk2(o[t][4 * g + 2] * rs * sg.z, o[t][4 * g + 3] * rs * sg.w);
                        *(v2u*)(orow + dv) = w; }
            }
        }
    }
}

__device__ __forceinline__ void swa_attn_phase(const Args& a, const Grp& c, LAS unsigned char* lds, int vcu, int G, int tid, int wave, int lane) {
    constexpr int VP = 192, KBUF = 64 * KP, VBUF = 64 * VP, BUF = KBUF + VBUF;
    const bf16* QKV = c.H; bf16* O = c.S;
    float mq = fabsf(a.in[I_SWQG][lane]), mk = fabsf(a.in[I_SWKG][lane]); float ms = (lane < 16) ? a.in[I_SWSINK][lane] : -INFINITY;
#pragma unroll
    for (int o = 1; o < 64; o <<= 1) { mq = fmaxf(mq, __shfl_xor(mq, o)); mk = fmaxf(mk, __shfl_xor(mk, o)); ms = fmaxf(ms, __shfl_xor(ms, o)); }
    const float b2 = fmaxf(8.0f * mq * mk * 1.001f + 0.01f, ms) * LOG2E; const float nb2 = -b2;
    const int r32 = lane & 31, hi = lane >> 5;
    const int krow = tid >> 3, kch = tid & 7;
    for (int id = vcu; id < NB * 4 * 64; id += G) {
        const int qb = id & 63, kvh = (id >> 6) & 3, b = id >> 8;
        const int q0 = qb * 64; const int qh = kvh * 4 + (wave & 3); const int qpos = q0 + (wave >> 2) * 32 + r32;
        const size_t ctx0 = (size_t)TLAT + b * CTXL, lat0 = (size_t)b * SEQ;
        const size_t qrow = lat0 + qpos;
        int bt_lo = (128 - q0) / 64; if (bt_lo < 0) bt_lo = 0; int bt_hi = (SEQ + 128 - q0) / 64; if (bt_hi > 5) bt_hi = 5;
        const int nkt = 4 + (bt_hi - bt_lo);
        bf16x8 qr[4];
#pragma unroll
        for (int d0 = 0; d0 < 4; ++d0) qr[d0] = *(const bf16x8*)(QKV + qrow * 1536 + qh * 64 + d0 * 16 + hi * 8);
        f32x16 o[2];
#pragma unroll
        for (int t = 0; t < 2; ++t)
#pragma unroll
            for (int r = 0; r < 16; ++r) o[t][r] = 0.f;
        float lsum = 0.f;
        v4u kreg, vreg;
        auto tile_row0 = [&](int t) -> size_t { return (t < 4) ? ctx0 + t * 64 : lat0 + (size_t)(q0 - 128 + (t - 4 + bt_lo) * 64); };
        auto ld_tile = [&](int t) { const size_t r0 = tile_row0(t);
            kreg = *(const v4u*)(QKV + (r0 + krow) * 1536 + 1024 + kvh * 64 + kch * 8);
            vreg = *(const v4u*)(QKV + (r0 + krow) * 1536 + 1280 + kvh * 64 + kch * 8); };
        auto st_tile = [&](int buf) { LAS unsigned char* base = lds + buf * BUF;
            *(LAS v4u*)(base + krow * KP + kch * 16) = kreg;
            *(LAS v4u*)(base + KBUF + krow * VP + kch * 16) = vreg; };
        ld_tile(0); st_tile(0); __syncthreads();
#pragma unroll 1
        for (int t = 0; t < nkt; ++t) {
            if (t + 1 < nkt) ld_tile(t + 1);
            const LAS unsigned char* base = lds + (t & 1) * BUF;
            if (t < 4) attn_tile<2, VP, false>(base, base + KBUF, qr, nb2, o, lsum, lane, 0, 0);
            else attn_tile<2, VP, true>(base, base + KBUF, qr, nb2, o, lsum, lane, q0 - 128 + (t - 4 + bt_lo) * 64, qpos);
            if (t + 1 < nkt) st_tile((t + 1) & 1);
            __syncthreads();
        }
        const float l = lsum + __shfl_xor(lsum, 32) + __builtin_amdgcn_exp2f(a.in[I_SWSINK][qh] * LOG2E - b2); const float inv = 1.0f / l;
        bf16* orow = O + qrow * 1024 + qh * 64;
#pragma unroll
        for (int t = 0; t < 2; ++t)
#pragma unroll
            for (int g = 0; g < 4; ++g) { const int dv = 32 * t + 8 * g + 4 * hi;
                v2u w; w.x = pk2(o[t][4 * g] * inv, o[t][4 * g + 1] * inv); w.y = pk2(o[t][4 * g + 2] * inv, o[t][4 * g + 3] * inv);
                *(v2u*)(orow + dv) = w; }
    }
}

__device__ __forceinline__ void gate_phase(const Args& a, const Grp& c, LAS unsigned char* lds, int vcu, int G, int tid, int wave, int lane) {
    constexpr int WP = 272, VP = 576, TP = 528;
    LAS unsigned char* Wl = lds; LAS unsigned char* Vl = lds + 128 * WP; LAS float* rstd = (LAS float*)(lds + 128 * WP + 128 * VP); LAS float* bsl = rstd + 128;
    const bf16* Zc = c.H; bf16* Gout = c.S;
    const bf16* wsb = (const bf16*)(a.ws + WS_WSB); const float* ssq = c.ssq;
    const float* vg = a.in[I_CMVG];
    const int r32 = lane & 31, hi = lane >> 5, i16 = lane & 15, rh = (lane >> 4) & 1;
    const int q0 = tid >> 5, c8 = tid & 31;
    for (int i = tid; i < 1024; i += NTHR) bsl[i] = a.in[I_CMBS][i];
    const int NU = (TTOT / 128) * 8;
    v4u vraw[8], wraw[4]; f32x4 sq0, sq1;
    auto issue_vw = [&](int id) { const int n = id >> 3, g = id & 7; const size_t row0 = (size_t)n * 128;
        const bf16* zb = Zc + (row0 + q0) * 4096 + g * 256 + c8 * 8 + 2048;
#pragma unroll
        for (int i = 0; i < 8; ++i) vraw[i] = *(const v4u*)(zb + (size_t)i * 16 * 4096);
#pragma unroll
        for (int i = 0; i < 4; ++i) { const int ch = tid + NTHR * i, p = ch >> 4, c16 = ch & 15; wraw[i] = *(const v4u*)(wsb + ((size_t)g * 128 + p) * 128 + c16 * 8); }
        const f32x4* sp = (const f32x4*)(ssq + (row0 + (tid >> 2)) * 32 + (tid & 3) * 8); sq0 = sp[0]; sq1 = sp[1]; };
    if (vcu < NU) issue_vw(vcu);
    for (int id = vcu; id < NU; id += G) {
        const int n = id >> 3, g = id & 7; const size_t row0 = (size_t)n * 128;
        const f32x4 g0 = *(const f32x4*)(vg + g * 256 + c8 * 8), g1 = *(const f32x4*)(vg + g * 256 + c8 * 8 + 4);
        { float t = ((sq0.x + sq0.y) + (sq0.z + sq0.w)) + ((sq1.x + sq1.y) + (sq1.z + sq1.w)); t += __shfl_xor(t, 1); t += __shfl_xor(t, 2);
          if ((tid & 3) == 0) rstd[tid >> 2] = 1.0f / sqrtf(t * (1.0f / 2048.0f) + EPS); }
#pragma unroll
        for (int i = 0; i < 4; ++i) { const int ch = tid + NTHR * i, p = ch >> 4, c16 = ch & 15; *(LAS v4u*)(Wl + p * WP + c16 * 16) = wraw[i]; }
        __syncthreads();
#pragma unroll
        for (int i = 0; i < 8; ++i) { const int q = q0 + 16 * i; const float rs = rstd[q]; const v4u raw = vraw[i];
            v4u w; w.x = pk2(bflo(raw.x) * rs * g0.x, bfhi(raw.x) * rs * g0.y); w.y = pk2(bflo(raw.y) * rs * g0.z, bfhi(raw.y) * rs * g0.w);
            w.z = pk2(bflo(raw.z) * rs * g1.x, bfhi(raw.z) * rs * g1.y); w.w = pk2(bflo(raw.w) * rs * g1.z, bfhi(raw.w) * rs * g1.w);
            *(LAS v4u*)(Vl + q * VP + c8 * 16) = w; }
        __syncthreads();
        v4u uraw[8];
        { const bf16* zb = Zc + (row0 + q0) * 4096 + g * 256 + c8 * 8;
#pragma unroll
          for (int i = 0; i < 8; ++i) uraw[i] = *(const v4u*)(zb + (size_t)i * 16 * 4096); }
        if (id + G < NU) issue_vw(id + G);
        f32x16 d[4];
#pragma unroll
        for (int t = 0; t < 4; ++t)
#pragma unroll
            for (int r = 0; r < 16; ++r) d[t][r] = bsl[g * 128 + 32 * t + crow(r, hi)];
        const LAS unsigned char* vp = Vl + (8 * hi + (i16 >> 2)) * VP + (wave * 32 + rh * 16 + (i16 & 3) * 4) * 2;
        const LAS unsigned char* wp = Wl + r32 * WP + hi * 16;
#pragma unroll
        for (int ks = 0; ks < 8; ++ks) {
            const s16x4 lo = vtr(vp + (16 * ks) * VP), hh = vtr(vp + (16 * ks + 4) * VP);
            const bf16x8 bfr = (bf16x8){lo[0], lo[1], lo[2], lo[3], hh[0], hh[1], hh[2], hh[3]};
#pragma unroll
            for (int t = 0; t < 4; ++t) { const bf16x8 af = *(const LAS bf16x8*)(wp + (32 * t) * WP + ks * 32);
                d[t] = __builtin_amdgcn_mfma_f32_32x32x16_bf16(af, bfr, d[t], 0, 0, 0); }
        }
        asm volatile("s_waitcnt lgkmcnt(0)\n\ts_barrier" ::: "memory");
        { LAS bf16* T = (LAS bf16*)Vl; const int cc = wave * 32 + r32;
#pragma unroll
          for (int t = 0; t < 4; ++t)
#pragma unroll
            for (int r = 0; r < 16; ++r) { const int p = 32 * t + crow(r, hi); T[p * (TP / 2) + cc] = (bf16)f2bf(d[t][r]); } }
        asm volatile("s_waitcnt lgkmcnt(0)\n\ts_barrier" ::: "memory");
        bf16* gb = Gout + (row0 + q0) * 2048 + g * 256 + c8 * 8;
#pragma unroll
        for (int i = 0; i < 8; ++i) { const int p = q0 + 16 * i; const v4u sv = *(const LAS v4u*)(Vl + p * TP + c8 * 16); const v4u u = uraw[i];
            v4u w; w.x = pk2(bflo(u.x) * bflo(sv.x), bfhi(u.x) * bfhi(sv.x)); w.y = pk2(bflo(u.y) * bflo(sv.y), bfhi(u.y) * bfhi(sv.y));
            w.z = pk2(bflo(u.z) * bflo(sv.z), bfhi(u.z) * bfhi(sv.z)); w.w = pk2(bflo(u.w) * bflo(sv.w), bfhi(u.w) * bfhi(sv.w));
            *(v4u*)(gb + (size_t)i * 16 * 2048) = w; }
        asm volatile("s_waitcnt lgkmcnt(0)\n\ts_barrier" ::: "memory");
    }
}

constexpr int N_PHASES = 34;
__device__ __forceinline__ void wait_flag(gu32* flag) {
    if (threadIdx.x == 0) { unsigned sp = 0; while (__hip_atomic_load(flag, RLX_AGENT) == 0u) { __builtin_amdgcn_s_sleep(4); if (++sp > (1u << 22)) break; }
        __builtin_amdgcn_fence(__ATOMIC_ACQUIRE, "agent"); asm volatile("s_waitcnt vmcnt(0)" ::: "memory"); }
    __syncthreads();
}
__global__ void __launch_bounds__(NTHR, 2) mk_fwd(Args args) {
    extern __shared__ __attribute__((aligned(16))) unsigned char lds_raw[];
    LAS unsigned char* lds = (LAS unsigned char*)lds_raw;
    volatile LAS unsigned* MISC = (volatile LAS unsigned*)(lds + MISC_OFF);
#define PH_IDS int tid = threadIdx.x; asm volatile("" : "+v"(tid)); const int lane = tid & 63, wave = __builtin_amdgcn_readfirstlane(tid >> 6); const int gw = vcu * NWAVES + wave; (void)gw; (void)lane; \
        unsigned char* ws = args.ws; asm volatile("" : "+s"(ws));   \
        float* const MOD = (float*)(ws + WS_MOD); \
        Grp c; \
        c.b0 = grp * NB; \
        c.x = args.in[I_X] + (size_t)grp * TLAT * 1024; c.ctx = args.in[I_CTX] + (size_t)grp * TCTX * 1024; c.out = args.out + (size_t)grp * TLAT * 1024; c.hc = (float*)(ws + WS_HC) + (size_t)grp * TCTX * 1024; \
        c.S = (bf16*)(ws + WS_S + grp * S_STRIDE); c.H = (bf16*)(ws + WS_H + grp * H_STRIDE); c.A = (bf16*)(ws + WS_H + grp * H_STRIDE + A_IN_H); \
        { unsigned char* t = ws + WS_TOK + grp * TOK_STRIDE; c.toke = (int*)t; c.tokg = (float*)(t + T_TOKG); c.toks = (int*)(t + T_TOKS); c.sgate = (float*)(t + T_SGATE); c.wgcnt = (int*)(t + T_WGCNT); c.panel = (int*)(t + T_PANEL); } \
        c.ssq = (float*)(ws + WS_SSQ + grp * SSQ_STRIDE); \
        bf16* const HL = (bf16*)c.out; bf16* const HCX = (bf16*)c.hc; bf16* const ABUF = c.A; bf16* const SBUF = c.S; bf16* const HBUF = c.H; \
        const int b0 = c.b0; (void)MOD; (void)HL; (void)HCX; (void)ABUF; (void)SBUF; (void)HBUF; (void)b0
    const int bx = blockIdx.x; const int grp = (NGRP == 2) ? ((bx >> 2) & 1) : 0;
    const int G = GG; const int vcu = (NGRP == 2) ? ((bx & 3) * 32 + (bx >> 3)) : ((bx & 7) * 32 + (bx >> 3));
    const int oid = (NGRP == 2) ? ((bx >> 3) * 4 + (bx & 3)) : bx;
    gu32* ctl = (gu32*)(args.ws + WS_CTL);
    for (int u = threadIdx.x; u < (LDS_BYTES - PERS_OFF) / 4; u += NTHR) ((LAS unsigned*)(lds + PERS_OFF))[u] = 0u;
    __syncthreads();
    const int lo = args.ph_lo, hi = args.ph_hi;
    XcdBarrier bar = xcd_barrier_post((unsigned*)(ctl + CW_BAR) + grp * XCD_BAR_WORDS, MISC + 8, (unsigned)GG);
#ifndef PH_LO
#define PH_LO 0
#define PH_HI 99
#endif
#define IN(k) ((k) >= PH_LO && (k) < PH_HI && lo <= (k) && (k) < hi)
#define SEAM(k) do { if (IN(k) && IN((k) + 1)) xcd_barrier(bar); } while (0)
    const int ngw = G * NWAVES;
    LAS int* const ptab = (LAS int*)(lds + PERS_OFF);

    constexpr int CM_ALL = NE * 3 * 1408, CM0_A = CM_ALL * 18 / 100, CM0_B = CM_ALL * 82 / 100, CM1_A = CM_ALL * 35 / 100;
#define PG8_ER(n, s) pg8::EpiResid<n, s>
#define PG8_ER4(n, s, n8, a8) pg8::EpiResid<n, s, n8, a8>
#define GEMM_GRID8(Abuf, Wt, nM_, nN_, K_, EpiT, Eobj) do { pg8::Gemm g{(const pg8::bf16_t*)(Abuf), (const pg8::bf16_t*)(Wt), (nM_) * 256, (nN_) * 256, (K_)}; pg8::GridOrder S; S.init((nM_), (nN_), G, oid); \
        pg8::gemm_phase<EpiT, pg8::GridOrder, true, true, true>(lds, g, S, (Eobj)); } while (0)
#define GEMM_GRID(Abuf, Wt, nM_, nN_, K_, EpiT, Eobj) do { pg8::Gemm g{(const pg8::bf16_t*)(Abuf), (const pg8::bf16_t*)(Wt), (nM_) * 256, (nN_) * 256, (K_)}; pg8::GridOrder S; S.init((nM_), (nN_), G, oid); \
        pg8::gemm_phase<EpiT, pg8::GridOrder, true, true>(lds, g, S, (Eobj)); } while (0)
#define GEMM_MOE(Abuf, Wt, nNe_, K_, EpiT, Eobj) do { const int* pan = c.panel; const int np = pan[0]; \
        for (int i = tid; i < np; i += NTHR) ptab[i] = pan[1 + i]; __syncthreads(); \
        pg8::Gemm g{(const pg8::bf16_t*)(Abuf), (const pg8::bf16_t*)(Wt), np * 256, (nNe_) * 256, (K_)}; pg8::MoeOrder S; S.g.init(np, (nNe_), G, oid); S.pexp = ptab; S.nNe = (nNe_); \
        pg8::gemm_phase<EpiT, pg8::MoeOrder, true, true>(lds, g, S, (Eobj)); } while (0)
#define GEMM_MOE8(Abuf, Wt, nNe_, K_, EpiT, Eobj) do { const int* pan = c.panel; const int np = pan[0]; \
        for (int i = tid; i < np; i += NTHR) ptab[i] = pan[1 + i]; __syncthreads(); \
        pg8::Gemm g{(const pg8::bf16_t*)(Abuf), (const pg8::bf16_t*)(Wt), np * 256, (nNe_) * 256, (K_)}; pg8::MoeOrderC<(nNe_)> S; S.nM = np; S.c = oid; S.pexp = ptab; \
        pg8::gemm_phase<EpiT, pg8::MoeOrderC<(nNe_)>, true, true, true>(lds, g, S, (Eobj)); } while (0)
    constexpr int NMA = TTOT / 256, NML = TLAT / 256;

    if (IN(0)) {
        if (grp == 0) {
            { PH_IDS; adaln_phase(args, lds, vcu, G, tid);
              if (vcu == 0) rope_table(args, tid);
              { const float* w = args.in[I_CMWS]; bf16* o = (bf16*)(ws + WS_WSB); for (int i = gw * 64 + lane; i < 131072 / 4; i += ngw * 64) { const f32x4 v = ((const f32x4*)w)[i]; v2u p; p.x = pk2(v.x, v.y); p.y = pk2(v.z, v.w); ((v2u*)o)[i] = p; } }
              conv_dense(args, lds, gw, ngw, wave, lane);
            }
            xcd_barrier(bar);
            if (NGRP == 1) { PH_IDS; bias_phase(args, gw, ngw, lane); }
            else { { PH_IDS; bias_phase(args, gw, ngw, lane); } xcd_barrier(bar); }
            if (NGRP == 2 && vcu == 0 && threadIdx.x == 0) { __builtin_amdgcn_fence(__ATOMIC_RELEASE, "agent"); asm volatile("s_waitcnt vmcnt(0)" ::: "memory"); __hip_atomic_store(ctl + CW_FLAG_DENSE, 1u, RLX_AGENT); }
        } else {
            { PH_IDS; conv_moe(args, 0, lds, gw, ngw, wave, lane); conv_moe(args, 1, lds, gw, ngw, wave, lane); }
            xcd_barrier(bar);
            if (vcu == 0 && threadIdx.x == 0) { __builtin_amdgcn_fence(__ATOMIC_RELEASE, "agent"); asm volatile("s_waitcnt vmcnt(0)" ::: "memory"); __hip_atomic_store(ctl + CW_FLAG_MOE, 1u, RLX_AGENT); }
            wait_flag(ctl + CW_FLAG_DENSE);
        }
    }
    if (IN(1)) { PH_IDS; row_phase<false, true, false, true, false>(args, c, lds, c.x, c.ctx, nullptr, nullptr, TTOT, args.in[I_NMIX] + 0 * 1024, MOD + 0 * 9 * 6144, 0, nullptr, nullptr, nullptr, vcu, G, tid, wave, lane); }
    SEAM(1);
    if (IN(2)) { PH_IDS; { pg8::EpiConvIn E{(pg8::bf16_t*)HBUF}; GEMM_GRID(ABUF, ws + W_SCIN, NMA, 12, 1024, pg8::EpiConvIn, E); } }
    SEAM(2);
    if (IN(3)) { PH_IDS; conv_phase(args, c, vcu, G, wave, lane); }
    SEAM(3);
    if (IN(4)) { PH_IDS; { pg8::EpiResid<true, true, D0_IN8, false> E{c.x, c.ctx, (pg8::bf16_t*)HL, (pg8::bf16_t*)HCX, MOD + 0 * 9 * 6144 + 2048, (pg8::bf16_t*)ABUF, args.in[I_NFFN] + 0 * 1024, MOD + 0 * 9 * 6144 + 4096, c.ssq, b0}; GEMM_GRID(SBUF, ws + W_SCOUT, NMA, 4, 1024, PG8_ER4(true, true, D0_IN8, false), E); } }
    if (IN(4)) { if (NGRP == 1 && bx >= 32) { PH_IDS; conv_moe(args, 0, lds, (bx - 32) * NWAVES + wave, 224 * NWAVES, wave, lane, 0, CM0_A); } }
    SEAM(4);
#define PG8_SG(n, a) pg8::EpiSwiGLU<n, a>
#define PG8_SG8(n, g) pg8::EpiSwiGLU8<n, g>
    if (IN(6)) { PH_IDS;
        if (D0_IN8 && D0_H8) { pg8::EpiSwiGLU8<true> E{(unsigned char*)HBUF, c.ssq, (const float*)(ws + BIAS_P6), b0}; GEMM_GRID8(ABUF, ws + W_F13, NMA, 22, 512, pg8::EpiSwiGLU8<true>, E); }
        else if (D0_IN8) { pg8::EpiSwiGLU<true, true> E{(pg8::bf16_t*)HBUF, FF, c.ssq, (const float*)(ws + BIAS_P6), b0}; GEMM_GRID8(ABUF, ws + W_F13, NMA, 22, 512, PG8_SG(true, true), E); }
        else if (D0_H8) { pg8::EpiSwiGLU8<true, false> E{(unsigned char*)HBUF, c.ssq, (const float*)(ws + BIAS_P6), b0}; GEMM_GRID(ABUF, ws + W_F13, NMA, 22, 1024, PG8_SG8(true, false), E); }
        else { pg8::EpiSwiGLU<true> E{(pg8::bf16_t*)HBUF, FF, c.ssq, (const float*)(ws + BIAS_P6), b0}; GEMM_GRID(ABUF, ws + W_F13, NMA, 22, 1024, pg8::EpiSwiGLU<true>, E); } }
    SEAM(6);
    if (IN(7)) { PH_IDS; if (D0_H8) { pg8::EpiResid<true, false, false, true> E{HL, HCX, (pg8::bf16_t*)HL, (pg8::bf16_t*)HCX, MOD + 0 * 9 * 6144 + 5120, (pg8::bf16_t*)ABUF, args.in[I_NMIX] + 1 * 1024, MOD + 1 * 9 * 6144 + 1024, c.ssq, b0}; GEMM_GRID8(HBUF, ws + W_F2, NMA, 4, FF / 2, PG8_ER4(true, false, false, true), E); }
                        else { pg8::EpiResid<true, false> E{HL, HCX, (pg8::bf16_t*)HL, (pg8::bf16_t*)HCX, MOD + 0 * 9 * 6144 + 5120, (pg8::bf16_t*)ABUF, args.in[I_NMIX] + 1 * 1024, MOD + 1 * 9 * 6144 + 1024, c.ssq, b0}; GEMM_GRID(HBUF, ws + W_F2, NMA, 4, FF, PG8_ER(true, false), E); }
               }
    if (IN(7)) { if (NGRP == 1 && bx >= 32) { PH_IDS; conv_moe(args, 0, lds, (bx - 32) * NWAVES + wave, 224 * NWAVES, wave, lane, CM0_A, CM0_B); } }
    SEAM(7);
    if (IN(9)) { PH_IDS; { pg8::EpiQKV E{(pg8::bf16_t*)HBUF, 3072, c.ssq, (const float*)(ws + BIAS_P9), 3072, 4, 4, args.in[I_DAQG], args.in[I_DAKG], (const float*)(ws + WS_RT), QSCALE, b0}; GEMM_GRID(ABUF, ws + W_DAQKV, NMA, 12, 1024, pg8::EpiQKV, E); } }
    SEAM(9);
    if (IN(11)) { PH_IDS; diff_attn_phase(args, c, lds, vcu, G, tid, wave, lane); }
    SEAM(11);
    if (IN(12)) { PH_IDS; { pg8::EpiResid<false, false> E{HL, HCX, (pg8::bf16_t*)HL, (pg8::bf16_t*)HCX, MOD + 1 * 9 * 6144 + 2048, nullptr, nullptr, nullptr, nullptr, b0}; GEMM_GRID(SBUF, ws + W_DAOUT, NMA, 4, 1024, PG8_ER(false, false), E); } }
    if (IN(12)) { if (NGRP == 1 && bx >= 32) { PH_IDS; conv_moe(args, 0, lds, (bx - 32) * NWAVES + wave, 224 * NWAVES, wave, lane, CM0_B, NE * 3 * 1408); } }
    SEAM(12);
    if (IN(13)) { PH_IDS; row_phase<false, true, true, false, false, true>(args, c, lds, HL, HCX, nullptr, nullptr, TTOT, args.in[I_NFFN] + 1 * 1024, MOD + 1 * 9 * 6144, 3072, nullptr, args.in[I_RW] + 0 * 8192, args.in[I_RB] + 0 * 8, vcu, G, tid, wave, lane); }
    SEAM(13);
    if (IN(14)) { PH_IDS; moe_scatter_phase<true>(c, lds, TTOT, vcu, G, tid, wave, lane); }
    if (NGRP == 2 && IN(14) && grp == 0) wait_flag(ctl + CW_FLAG_MOE);
    SEAM(14);
    if (IN(15)) { PH_IDS; { pg8::EpiSwiGLU8<false> E{(unsigned char*)HBUF, nullptr, nullptr, 0}; GEMM_MOE8(SBUF, ws + W_MOE, 22, 512, pg8::EpiSwiGLU8<false>, E); } }
    SEAM(15);
    if (IN(16)) { PH_IDS; { pg8::EpiMoeDown<true> E{(pg8::bf16_t*)SBUF, c.sgate}; GEMM_MOE8(HBUF, ws + W_MOE + 88 * MiB, 4, FF / 2, pg8::EpiMoeDown<true>, E); } }
    SEAM(16);
    if (IN(17)) { PH_IDS; row_phase<true, true, false, false, false>(args, c, lds, HL, HCX, HL, HCX, TTOT, args.in[I_NMIX] + 2 * 1024, MOD + 2 * 9 * 6144, 0, MOD + 1 * 9 * 6144 + 5120, nullptr, nullptr, vcu, G, tid, wave, lane); }
    SEAM(17);
    if (IN(18)) { PH_IDS; { pg8::EpiStore<1> E{(pg8::bf16_t*)HBUF, 4096, args.in[I_CMINB], c.ssq, 8}; GEMM_GRID(ABUF, ws + W_CMIN, NMA, 16, 1024, pg8::EpiStore<1>, E); } }
    SEAM(18);
    if (IN(19)) { PH_IDS; gate_phase(args, c, lds, vcu, G, tid, wave, lane); }
    SEAM(19);
    if (IN(20)) { PH_IDS; { pg8::EpiResid<true, false, true, false> E{HL, HCX, (pg8::bf16_t*)HL, (pg8::bf16_t*)HCX, MOD + 2 * 9 * 6144 + 2048, (pg8::bf16_t*)ABUF, args.in[I_NFFN] + 2 * 1024, MOD + 2 * 9 * 6144 + 4096, c.ssq, b0}; GEMM_GRID(SBUF, ws + W_CMOUT, NMA, 4, 2048, PG8_ER4(true, false, true, false), E); } }
    if (IN(20)) { if (NGRP == 1 && bx >= 32) { PH_IDS; conv_moe(args, 1, lds, (bx - 32) * NWAVES + wave, 224 * NWAVES, wave, lane, 0, CM1_A); } }
    SEAM(20);
    if (IN(22)) { PH_IDS; { pg8::EpiSwiGLU8<true> E{(unsigned char*)HBUF, c.ssq, (const float*)(ws + BIAS_P22), b0}; GEMM_GRID8(ABUF, ws + W_F13 + (size_t)5632 * 1024 * 2, NMA, 22, 512, pg8::EpiSwiGLU8<true>, E); } }
    SEAM(22);
    if (IN(23)) { PH_IDS; { pg8::EpiResid<true, false, false, true> E{HL, HCX, (pg8::bf16_t*)HL, (pg8::bf16_t*)HCX, MOD + 2 * 9 * 6144 + 5120, (pg8::bf16_t*)ABUF, args.in[I_NMIX] + 3 * 1024, MOD + 3 * 9 * 6144 + 1024, c.ssq, b0}; GEMM_GRID8(HBUF, ws + W_F2 + (size_t)1024 * 2816 * 2, NMA, 4, FF / 2, PG8_ER4(true, false, false, true), E); }
               }
    if (IN(23)) { if (NGRP == 1 && bx >= 32) { PH_IDS; conv_moe(args, 1, lds, (bx - 32) * NWAVES + wave, 224 * NWAVES, wave, lane, CM1_A, NE * 3 * 1408); } }
    SEAM(23);
    if (IN(25)) { PH_IDS; { pg8::EpiQKV E{(pg8::bf16_t*)HBUF, 1536, c.ssq, (const float*)(ws + BIAS_P25), 1536, 4, 1, args.in[I_SWQG], args.in[I_SWKG], (const float*)(ws + WS_RT), QSCALE, b0}; GEMM_GRID(ABUF, ws + W_SWQKV, NMA, 6, 1024, pg8::EpiQKV, E); } }
    SEAM(25);
    if (IN(27)) { PH_IDS; swa_attn_phase(args, c, lds, vcu, G, tid, wave, lane); }
    SEAM(27);
    if (IN(28)) { PH_IDS; { pg8::EpiResid<false, false> E{HL, HCX, (pg8::bf16_t*)HL, (pg8::bf16_t*)HCX, MOD + 3 * 9 * 6144 + 2048, nullptr, nullptr, nullptr, nullptr, b0}; GEMM_GRID(SBUF, ws + W_SWOUT, NML, 4, 1024, PG8_ER(false, false), E); } }
    SEAM(28);
    if (IN(29)) { PH_IDS; row_phase<false, true, true, false, false, true>(args, c, lds, HL, HCX, nullptr, nullptr, TLAT, args.in[I_NFFN] + 3 * 1024, MOD + 3 * 9 * 6144, 3072, nullptr, args.in[I_RW] + 1 * 8192, args.in[I_RB] + 1 * 8, vcu, G, tid, wave, lane); }
    SEAM(29);
    if (IN(30)) { PH_IDS; moe_scatter_phase<true>(c, lds, TLAT, vcu, G, tid, wave, lane); }
    SEAM(30);
    if (IN(31)) { PH_IDS; { pg8::EpiSwiGLU8<false> E{(unsigned char*)HBUF, nullptr, nullptr, 0}; GEMM_MOE8(SBUF, ws + W_MOE + W_MOE_STRIDE, 22, 512, pg8::EpiSwiGLU8<false>, E); } }
    SEAM(31);
    if (IN(32)) { PH_IDS; { pg8::EpiMoeDown<true> E{(pg8::bf16_t*)SBUF, c.sgate}; GEMM_MOE8(HBUF, ws + W_MOE + W_MOE_STRIDE + 88 * MiB, 4, FF / 2, pg8::EpiMoeDown<true>, E); } }
    SEAM(32);
    if (IN(33)) { PH_IDS; row_phase<true, false, false, false, true>(args, c, lds, HL, HCX, c.out, nullptr, TLAT, nullptr, nullptr, 0, MOD + 3 * 9 * 6144 + 5120, nullptr, nullptr, vcu, G, tid, wave, lane); }
#undef IN
#undef SEAM
}

extern "C" void kernel_launch(void* const* d_in, const int* in_sizes, int n_in, void* d_out, int out_size, void* d_ws, size_t ws_size, hipStream_t stream) {
    static int grid = 0;
    if (grid == 0) {
        if (n_in != N_IN || in_sizes[0] != NGRP * TLAT * D || out_size != NGRP * TLAT * D || ws_size < WS_END) { fprintf(stderr, "kernel_launch: unexpected shapes / workspace (n_in %d, ws %zu < %zu)\n", n_in, ws_size, (size_t)WS_END); grid = -1; return; }
        int dev = 0, cus = 0;
        if (hipGetDevice(&dev) != hipSuccess || hipDeviceGetAttribute(&cus, hipDeviceAttributeMultiprocessorCount, dev) != hipSuccess) { grid = -1; return; }
        if (hipFuncSetAttribute((const void*)mk_fwd, hipFuncAttributeMaxDynamicSharedMemorySize, LDS_BYTES) != hipSuccess) { fprintf(stderr, "kernel_launch: hipFuncSetAttribute failed\n"); grid = -1; return; }
        int per_cu = 0;
        if (hipOccupancyMaxActiveBlocksPerMultiprocessor(&per_cu, (const void*)mk_fwd, NTHR, LDS_BYTES) != hipSuccess || per_cu < 1) fprintf(stderr, "kernel_launch: occupancy query reports %d\n", per_cu);
        (void)hipGetLastError();
        grid = cus;
        if (grid != NGRP * GG) { fprintf(stderr, "kernel_launch: built for 256 CUs, found %d\n", cus); grid = -1; return; }
    }
    if (grid < 0) return;
    (void)hipMemsetAsync((char*)d_ws + WS_CTL, 0, CTL_ZERO_BYTES, stream);
    Args a{};
    for (int i = 0; i < N_IN; ++i) a.in[i] = (const float*)d_in[i];
    a.out = (float*)d_out; a.ws = (unsigned char*)d_ws;
    a.ph_lo = 0; a.ph_hi = N_PHASES; hipLaunchKernelGGL(mk_fwd, dim3(grid), dim3(NTHR), LDS_BYTES, stream, a);
}
```

```cpp
#include <hip/hip_runtime.h>
#include <cstdio>
#include <cstdint>
#include <cmath>
#ifndef MK_NGRP
#define MK_NGRP 1
#endif
#define MK_TLAT (32768 / MK_NGRP)
namespace pg8 {
#define PG8_LAS __attribute__((address_space(3)))
typedef unsigned short bf16_t;
typedef short bf16x8 __attribute__((ext_vector_type(8)));
typedef float f32x4 __attribute__((ext_vector_type(4)));
typedef unsigned u32x4 __attribute__((ext_vector_type(4)));
constexpr int BM = 256, BK = 64, HALF = 128, HTB = HALF * BK * 2  , STAGE_BYTES = 8 * HTB, NXCD = 8, WGM = 4;

__host__ __device__ __forceinline__ int lds_byte(int r, int c) { const int st = (r >> 4) * 2 + (c >> 5), rr = r & 15, cc = c & 31, ob = rr * 64 + cc * 2; return st * 1024 + (ob ^ (((ob >> 9) & 1) << 5)); }
__host__ __device__ __forceinline__ void stage_rc(int b, int& R, int& C) { const int st = b / 1024, sb = b % 1024, swz = sb ^ (((sb >> 9) & 1) << 5); R = (st >> 1) * 16 + swz / 64; C = (st & 1) * 32 + (swz % 64) / 2; }
__host__ __device__ __forceinline__ int perm32(int rho) { const int n = rho >> 4, i = rho & 15; return 8 * (i >> 2) + 4 * n + (i & 3); }

struct Unit { int pm, pn; };
struct Gemm { const bf16_t* A; const bf16_t* Bt; int M, N, K; };

struct StaticOrder {
    int nM, nN, nwg, G, c;
    __host__ __device__ void init(int M, int N, int G_, int c_) { nM = M / BM; nN = N / BM; nwg = nM * nN; G = G_; c = c_; }
    __host__ __device__ bool next(int i, Unit& u) const {
        const long L = (long)i * G + c; if (L >= nwg) return false;
        int wgid = (int)L; { const int q = nwg / NXCD, r = nwg % NXCD, xcd = wgid % NXCD, off = wgid / NXCD; wgid = (xcd < r ? xcd * (q + 1) : r * (q + 1) + (xcd - r) * q) + off; }
        const int nig = WGM * nN, gid = wgid / nig, fm = gid * WGM, gsz = (nM - fm) < WGM ? (nM - fm) : WGM;
        u.pm = fm + ((wgid % nig) % gsz); u.pn = (wgid % nig) / gsz; return true;
    }
    __device__ __forceinline__ void a_ready(const Unit&) const {}
    __device__ __forceinline__ void done(const Unit&) const {}
};

__device__ __forceinline__ unsigned cvt_pk_bf16(float lo, float hi) { unsigned r; asm volatile("v_cvt_pk_bf16_f32 %0, %1, %2" : "=v"(r) : "v"(lo), "v"(hi)); return r; }
typedef int i32x4_ __attribute__((ext_vector_type(4)));
constexpr float F8_SA = 16.f, F8_SW13 = 32.f, F8_SH = 4.f, F8_SW2 = 64.f, F8_SAU = 8.f;
__device__ __forceinline__ unsigned cvt_pk_fp8x4(float a, float b, float c, float d) {
    a = __builtin_amdgcn_fmed3f(a, -448.f, 448.f); b = __builtin_amdgcn_fmed3f(b, -448.f, 448.f); c = __builtin_amdgcn_fmed3f(c, -448.f, 448.f); d = __builtin_amdgcn_fmed3f(d, -448.f, 448.f);
    unsigned w = 0u; w = (unsigned)__builtin_amdgcn_cvt_pk_fp8_f32(a, b, (int)w, false); w = (unsigned)__builtin_amdgcn_cvt_pk_fp8_f32(c, d, (int)w, true); return w; }
__device__ __forceinline__ float bf_lo(unsigned u) { return __builtin_bit_cast(float, u << 16); }
__device__ __forceinline__ float bf_hi(unsigned u) { return __builtin_bit_cast(float, u & 0xffff0000u); }

typedef float f32x2 __attribute__((ext_vector_type(2)));
__device__ __forceinline__ float gelu_tanh1(float x) {
    const float u = 0.7978845608028654f * (x + 0.044715f * x * x * x);
    const float e = __builtin_amdgcn_exp2f(-2.8853900817779268f * u);
    return x * __builtin_amdgcn_rcpf(1.0f + e);
}
__device__ __forceinline__ float silu1(float x) { return x * __builtin_amdgcn_rcpf(1.0f + __builtin_amdgcn_exp2f(-1.4426950408889634f * x)); }
__device__ __forceinline__ void swiglu8(const float (&g)[8], const float (&u)[8], const float c1, const float K, float (&h)[8]) {
    float t[8], p[8];
#pragma unroll
    for (int j = 0; j < 8; ++j) t[j] = g[j] * c1;
    __builtin_amdgcn_sched_barrier(0);
#pragma unroll
    for (int j = 0; j < 8; ++j) t[j] = __builtin_amdgcn_exp2f(t[j]);
#pragma unroll
    for (int j = 0; j < 8; ++j) p[j] = g[j] * u[j];
    __builtin_amdgcn_sched_barrier(0);
#pragma unroll
    for (int j = 0; j < 8; ++j) t[j] = __builtin_fmaf(t[j], K, K);
    __builtin_amdgcn_sched_barrier(0);
#pragma unroll
    for (int j = 0; j < 8; ++j) t[j] = __builtin_amdgcn_rcpf(t[j]);
    __builtin_amdgcn_sched_barrier(0);
#pragma unroll
    for (int j = 0; j < 8; ++j) h[j] = p[j] * t[j];
}

#define PG8_GAS __attribute__((address_space(1)))
template <class T> __device__ __forceinline__ T gld(const void* p) { return *(const PG8_GAS T*)p; }
template <class T> __device__ __forceinline__ void gst(void* p, const T v) { *(PG8_GAS T*)p = v; }
__device__ __forceinline__ float row_rstd16(const float* ssq, int row) {
    const PG8_GAS f32x4* p = (const PG8_GAS f32x4*)(ssq + (size_t)row * 32); const f32x4 a = p[0], b = p[1], c = p[2], d = p[3];
    const float t = ((a.x + a.y) + (a.z + a.w)) + ((b.x + b.y) + (b.z + b.w)) + ((c.x + c.y) + (c.z + c.w)) + ((d.x + d.y) + (d.z + d.w));
    return 1.0f / sqrtf(t * (1.0f / 1024.0f) + 1e-6f);
}
__device__ __forceinline__ void rows_rstd8(const float* ssq, int row0, int fq, float (&rs)[2][4]) {
    f32x4 p[2][4];
#pragma unroll
    for (int ai = 0; ai < 2; ++ai)
#pragma unroll
        for (int m = 0; m < 4; ++m) p[ai][m] = gld<f32x4>(ssq + (size_t)(row0 + ai * HALF + m * 16) * 32 + 4 * fq);
#pragma unroll
    for (int ai = 0; ai < 2; ++ai)
#pragma unroll
        for (int m = 0; m < 4; ++m) { float t = (p[ai][m].x + p[ai][m].y) + (p[ai][m].z + p[ai][m].w); t += __shfl_xor(t, 16); t += __shfl_xor(t, 32); rs[ai][m] = 1.0f / sqrtf(t * (1.0f / 1024.0f) + 1e-6f); }
}
template <int ACT> struct EpiStore {
    static constexpr bool PERM = true, AFTER_DRAIN = false;
    bf16_t* O; int ldc; const float* bias; float* ssq; int ssq_pn0;
    __device__ __forceinline__ void operator()(const f32x4 (&acc)[2][2][4][2], const Unit& u, int wr, int wc, int fr, int fq) const {
        const int row0 = u.pm * BM + wr * 64 + fr; const int col0 = u.pn * BM + wc * 32 + 8 * fq;
        f32x4 bv[2][2];
#pragma unroll
        for (int bj = 0; bj < 2; ++bj)
#pragma unroll
            for (int n = 0; n < 2; ++n) bv[bj][n] = bias ? gld<f32x4>(bias + col0 + bj * HALF + 4 * n) : (f32x4){0.f, 0.f, 0.f, 0.f};
#pragma unroll
        for (int ai = 0; ai < 2; ++ai)
#pragma unroll
            for (int m = 0; m < 4; ++m) { bf16_t* rowp = O + (size_t)(row0 + ai * HALF + m * 16) * ldc + col0; float ss = 0.f;
#pragma unroll
                for (int bj = 0; bj < 2; ++bj) { f32x4 v0 = acc[ai][bj][m][0] + bv[bj][0], v1 = acc[ai][bj][m][1] + bv[bj][1];
                    if (ACT == 1) {
#pragma unroll
                        for (int i = 0; i < 4; ++i) { v0[i] = gelu_tanh1(v0[i]); v1[i] = gelu_tanh1(v1[i]); }
#pragma unroll
                        for (int i = 0; i < 4; ++i) ss += v0[i] * v0[i] + v1[i] * v1[i];
                    }
                    u32x4 w; w.x = cvt_pk_bf16(v0[0], v0[1]); w.y = cvt_pk_bf16(v0[2], v0[3]); w.z = cvt_pk_bf16(v1[0], v1[1]); w.w = cvt_pk_bf16(v1[2], v1[3]);
                    gst<u32x4>(rowp + bj * HALF, w); }
                if (ACT == 1) { ss += __shfl_xor(ss, 16); ss += __shfl_xor(ss, 32);
                    if (u.pn >= ssq_pn0 && fq == 0) gst<float>(ssq + (size_t)(row0 + ai * HALF + m * 16) * 32 + (u.pn - ssq_pn0) * 4 + wc, ss); }
            }
    }
};

struct EpiConvIn {
    static constexpr bool PERM = true, AFTER_DRAIN = false;
    bf16_t* O;
    __device__ __forceinline__ void operator()(const f32x4 (&acc)[2][2][4][2], const Unit& u, int wr, int wc, int fr, int fq) const {
        const int row0 = u.pm * BM + wr * 64 + fr;
        if (u.pn < 4) { const int col0 = u.pn * BM + wc * 32 + 8 * fq;
#pragma unroll
            for (int ai = 0; ai < 2; ++ai)
#pragma unroll
                for (int m = 0; m < 4; ++m) { bf16_t* rowp = O + (size_t)(row0 + ai * HALF + m * 16) * 2048 + col0;
#pragma unroll
                    for (int bj = 0; bj < 2; ++bj) { const f32x4 v0 = acc[ai][bj][m][0], v1 = acc[ai][bj][m][1];
                        u32x4 w; w.x = cvt_pk_bf16(v0[0], v0[1]); w.y = cvt_pk_bf16(v0[2], v0[3]); w.z = cvt_pk_bf16(v1[0], v1[1]); w.w = cvt_pk_bf16(v1[2], v1[3]);
                        gst<u32x4>(rowp + bj * HALF, w); } }
        } else { const int col0 = 1024 + (u.pn - 4) * HALF + wc * 32 + 8 * fq;
#pragma unroll
            for (int ai = 0; ai < 2; ++ai)
#pragma unroll
                for (int m = 0; m < 4; ++m) { const f32x4 v0 = acc[ai][0][m][0] * acc[ai][1][m][0], v1 = acc[ai][0][m][1] * acc[ai][1][m][1];
                    u32x4 w; w.x = cvt_pk_bf16(v0[0], v0[1]); w.y = cvt_pk_bf16(v0[2], v0[3]); w.z = cvt_pk_bf16(v1[0], v1[1]); w.w = cvt_pk_bf16(v1[2], v1[3]);
                    gst<u32x4>(O + (size_t)(row0 + ai * HALF + m * 16) * 2048 + col0, w); }
        }
    }
};

struct EpiQKV {
    static constexpr bool PERM = true, AFTER_DRAIN = false;
    bf16_t* O; int ldc; const float* ssq; const float* bias  ; int N; int nq_t, nk_t; const float* qg; const float* kg; const float* RT; float qscale; int b0;
    __device__ __forceinline__ void operator()(const f32x4 (&acc)[2][2][4][2], const Unit& u, int wr, int wc, int fr, int fq) const {
        const int prow = u.pm * BM; const bool lat = prow < MK_TLAT; const int cidx = lat ? b0 + (prow >> 12) : 8;
        const int rl0 = wr * 64 + fr; const int ncol0 = u.pn * BM + wc * 32 + 8 * fq;
        const float* bp = bias + (size_t)cidx * N + ncol0;
        f32x4 bv[2][2];
#pragma unroll
        for (int bj = 0; bj < 2; ++bj)
#pragma unroll
            for (int n = 0; n < 2; ++n) bv[bj][n] = gld<f32x4>(bp + bj * HALF + 4 * n);
        const bool isq = u.pn < nq_t, isqk = u.pn < nq_t + nk_t;
        f32x4 gg[2][2];
        if (isqk) { const float* gp = isq ? qg : kg; const float sc = isq ? qscale : 1.0f;
#pragma unroll
            for (int bj = 0; bj < 2; ++bj)
#pragma unroll
                for (int n = 0; n < 2; ++n) gg[bj][n] = gld<f32x4>(gp + bj * 32 + 16 * n + 4 * fq) * sc; }
        typedef unsigned u32x2q __attribute__((ext_vector_type(2)));
        float rsv[2][4]; rows_rstd8(ssq, prow + rl0, fq, rsv);
#pragma unroll
        for (int ai = 0; ai < 2; ++ai) {
            f32x4 csR, snR;
            if (isqk && lat) { const int posr = ((prow + wr * 64 + ai * HALF) & 4095) >> 6;
                const f32x4 t0 = gld<f32x4>(RT + 2 * (posr * 16 + 4 * fq)), t1 = gld<f32x4>(RT + 2 * (posr * 16 + 4 * fq) + 4);
                csR = (f32x4){t0.x, t0.z, t1.x, t1.z}; snR = (f32x4){t0.y, t0.w, t1.y, t1.w}; }
#pragma unroll
            for (int m = 0; m < 4; ++m) { const int row = prow + rl0 + ai * HALF + m * 16;
                const float rs = rsv[ai][m];
                f32x4 v[2][2]; float ss = 0.f;
#pragma unroll
                for (int bj = 0; bj < 2; ++bj)
#pragma unroll
                    for (int n = 0; n < 2; ++n) { v[bj][n] = acc[ai][bj][m][n] * rs + bv[bj][n]; ss += (v[bj][n].x * v[bj][n].x + v[bj][n].y * v[bj][n].y) + (v[bj][n].z * v[bj][n].z + v[bj][n].w * v[bj][n].w); }
                if (isqk) {
                    ss += __shfl_xor(ss, 16); ss += __shfl_xor(ss, 32);
                    const float rh = 1.0f / sqrtf(ss * (1.0f / 64.0f) + 1e-6f);
#pragma unroll
                    for (int bj = 0; bj < 2; ++bj)
#pragma unroll
                        for (int n = 0; n < 2; ++n) v[bj][n] = v[bj][n] * rh * gg[bj][n];
                    if (lat) {
                        { const f32x4 x1 = v[0][0], x2 = v[0][1]; v[0][0] = x1 * csR - x2 * snR; v[0][1] = x1 * snR + x2 * csR; }
                        { const int posc = fr + 16 * m;
                          const f32x4 t0 = gld<f32x4>(RT + 2 * (posc * 16 + 4 * fq)), t1 = gld<f32x4>(RT + 2 * (posc * 16 + 4 * fq) + 4);
                          const f32x4 cs = (f32x4){t0.x, t0.z, t1.x, t1.z}, sn = (f32x4){t0.y, t0.w, t1.y, t1.w};
                          const f32x4 x1 = v[1][0], x2 = v[1][1]; v[1][0] = x1 * cs - x2 * sn; v[1][1] = x1 * sn + x2 * cs; }
                    }
                    bf16_t* rowp = O + (size_t)row * ldc + u.pn * BM + wc * 64 + 4 * fq;
#pragma unroll
                    for (int bj = 0; bj < 2; ++bj)
#pragma unroll
                        for (int n = 0; n < 2; ++n) { u32x2q w; w.x = cvt_pk_bf16(v[bj][n][0], v[bj][n][1]); w.y = cvt_pk_bf16(v[bj][n][2], v[bj][n][3]); gst<u32x2q>(rowp + bj * 32 + 16 * n, w); }
                } else {
                    bf16_t* rowp = O + (size_t)row * ldc + ncol0;
#pragma unroll
                    for (int bj = 0; bj < 2; ++bj) { u32x4 w; w.x = cvt_pk_bf16(v[bj][0][0], v[bj][0][1]); w.y = cvt_pk_bf16(v[bj][0][2], v[bj][0][3]); w.z = cvt_pk_bf16(v[bj][1][0], v[bj][1][1]); w.w = cvt_pk_bf16(v[bj][1][2], v[bj][1][3]);
                        gst<u32x4>(rowp + bj * HALF, w); }
                }
            }
        }
    }
};

template <bool NIN, bool A8 = false> struct EpiSwiGLU {
    static constexpr bool PERM = true, AFTER_DRAIN = false;
    bf16_t* O; int ldo; const float* ssq; const float* bias  ; int b0;
    __device__ __forceinline__ void operator()(const f32x4 (&acc)[2][2][4][2], const Unit& u, int wr, int wc, int fr, int fq) const {
        const int row0 = u.pm * BM + wr * 64 + fr; const int col0 = (u.pn % 22) * HALF + wc * 32 + 8 * fq;
        f32x4 bv[2][2];
        if (NIN) { const int prow = u.pm * BM; const int cidx = prow < MK_TLAT ? b0 + (prow >> 12) : 8; const float* bp = bias + (size_t)cidx * 5632 + u.pn * BM + wc * 32 + 8 * fq;
#pragma unroll
            for (int bj = 0; bj < 2; ++bj)
#pragma unroll
                for (int n = 0; n < 2; ++n) bv[bj][n] = gld<f32x4>(bp + bj * HALF + 4 * n); }
        float rsv[2][4]; if (NIN) rows_rstd8(ssq, row0, fq, rsv);
#pragma unroll
        for (int ai = 0; ai < 2; ++ai)
#pragma unroll
            for (int m = 0; m < 4; ++m) { const int row = row0 + ai * HALF + m * 16; bf16_t* rowp = O + (size_t)row * ldo + col0;
                float rs = 1.0f; if (NIN) rs = rsv[ai][m]; if (A8) rs *= 1.0f / (F8_SAU * F8_SW13);
                float h[8], gg[8], uu[8];
#pragma unroll
                for (int n = 0; n < 2; ++n)
#pragma unroll
                    for (int i = 0; i < 4; ++i) { float gt = acc[ai][0][m][n][i], up = acc[ai][1][m][n][i]; if (NIN) { gt = gt * rs + bv[0][n][i]; up = up * rs + bv[1][n][i]; } gg[4 * n + i] = gt; uu[4 * n + i] = up; }
                swiglu8(gg, uu, -1.4426950408889634f, 1.0f, h);
                u32x4 w; w.x = cvt_pk_bf16(h[0], h[1]); w.y = cvt_pk_bf16(h[2], h[3]); w.z = cvt_pk_bf16(h[4], h[5]); w.w = cvt_pk_bf16(h[6], h[7]);
                gst<u32x4>(rowp, w); }
    }
};

template <bool NIN, bool G8 = true> struct EpiSwiGLU8 {
    static constexpr bool PERM = true, AFTER_DRAIN = false;
    unsigned char* O; const float* ssq; const float* bias  ; int b0;
    static constexpr int ldo = 2816; static constexpr float in_scale = G8 ? 1.0f / ((NIN ? F8_SAU : F8_SA) * F8_SW13) : 1.0f, out_scale = F8_SH;
    __device__ __forceinline__ void operator()(const f32x4 (&acc)[2][2][4][2], const Unit& u, int wr, int wc, int fr, int fq) const {
        const int row0 = u.pm * BM + wr * 64 + fr; const int col0 = (u.pn % 22) * HALF + wc * 32 + 8 * fq;
        f32x4 bv[2][2];
        if (NIN) { const int prow = u.pm * BM; const int cidx = prow < MK_TLAT ? b0 + (prow >> 12) : 8; const float* bp = bias + (size_t)cidx * 5632 + u.pn * BM + wc * 32 + 8 * fq;
#pragma unroll
            for (int bj = 0; bj < 2; ++bj)
#pragma unroll
                for (int n = 0; n < 2; ++n) bv[bj][n] = gld<f32x4>(bp + bj * HALF + 4 * n); }
        float rsv[2][4]; if (NIN) rows_rstd8(ssq, row0, fq, rsv);
#pragma unroll
        for (int ai = 0; ai < 2; ++ai)
#pragma unroll
            for (int m = 0; m < 4; ++m) { const int row = row0 + ai * HALF + m * 16;
                float rs = in_scale; if (NIN) rs = rsv[ai][m] * in_scale;
                float h[8], gg[8], uu[8];
#pragma unroll
                for (int n = 0; n < 2; ++n)
#pragma unroll
                    for (int i = 0; i < 4; ++i) { float gt = acc[ai][0][m][n][i], up = acc[ai][1][m][n][i]; if (NIN) { gt = gt * rs + bv[0][n][i]; up = up * rs + bv[1][n][i]; } gg[4 * n + i] = gt; uu[4 * n + i] = up; }
                if (NIN) swiglu8(gg, uu, -1.4426950408889634f, 1.0f / out_scale, h);
                else swiglu8(gg, uu, -1.4426950408889634f * in_scale, 1.0f / (in_scale * in_scale * out_scale), h);
                unsigned w0 = cvt_pk_fp8x4(h[0], h[1], h[2], h[3]), w1 = cvt_pk_fp8x4(h[4], h[5], h[6], h[7]);
                typedef unsigned u32x2_ __attribute__((ext_vector_type(2)));
                gst<u32x2_>(O + (size_t)row * ldo + col0, (u32x2_){w0, w1}); }
    }
};

template <bool NEXT, bool SRC32, bool N8 = false, bool A8S = false> struct EpiResid {
    static constexpr bool PERM = true, AFTER_DRAIN = false; static constexpr float ascale = A8S ? 1.0f / (F8_SH * F8_SW2) : 1.0f;
    static constexpr int HP = 2048;
    const void* src_lat; const void* src_ctx; bf16_t* dst_lat; bf16_t* dst_ctx; const float* gate;
    bf16_t* An; const float* gn; const float* scn; float* ssq; int b0;
    __device__ __forceinline__ void operator()(const f32x4 (&acc)[2][2][4][2], const Unit& u, int wr, int wc, int fr, int fq) const {
        const int prow = u.pm * BM; const bool lat = prow < MK_TLAT; const int cidx = lat ? b0 + (prow >> 12) : 8;
        const float* s32 = lat ? (const float*)src_lat + (size_t)prow * 1024 : (const float*)src_ctx + (size_t)(prow - MK_TLAT) * 1024;
        const bf16_t* s16 = lat ? (const bf16_t*)src_lat + (size_t)prow * HP : (const bf16_t*)src_ctx + (size_t)(prow - MK_TLAT) * HP;
        bf16_t* d = lat ? dst_lat + (size_t)prow * HP : dst_ctx + (size_t)(prow - MK_TLAT) * HP;
        const int rl0 = wr * 64 + fr; const int col0 = u.pn * BM + wc * 32 + 8 * fq;
        const float* g = gate + (size_t)cidx * 6144 + col0;
        float ss[2][4];
#pragma unroll
        for (int ai = 0; ai < 2; ++ai)
#pragma unroll
            for (int m = 0; m < 4; ++m) ss[ai][m] = 0.f;
#pragma unroll
        for (int bj = 0; bj < 2; ++bj) {
            asm volatile("" ::: "memory");
            f32x4 gv[2], Gn[2];
#pragma unroll
            for (int n = 0; n < 2; ++n) { gv[n] = gld<f32x4>(g + bj * HALF + 4 * n); if (A8S) gv[n] = gv[n] * ascale;
                if (NEXT) { Gn[n] = gld<f32x4>(gn + col0 + bj * HALF + 4 * n) * (gld<f32x4>(scn + (size_t)cidx * 6144 + col0 + bj * HALF + 4 * n) + 1.0f); if (N8) Gn[n] = Gn[n] * F8_SAU; } }
#pragma unroll
            for (int ai = 0; ai < 2; ++ai)
#pragma unroll
                for (int m = 0; m < 4; ++m) { if (m == 0) asm volatile("" ::: "memory");
                    const int rl = rl0 + ai * HALF + m * 16; f32x4 hn[2];
                    if (SRC32) { const size_t ro = (size_t)rl * 1024 + col0 + bj * HALF; hn[0] = gld<f32x4>(s32 + ro); hn[1] = gld<f32x4>(s32 + ro + 4); }
                    else { const u32x4 p = gld<u32x4>(s16 + (size_t)rl * HP + col0 + bj * HALF);
                        hn[0] = f32x4{bf_lo(p.x), bf_hi(p.x), bf_lo(p.y), bf_hi(p.y)}; hn[1] = f32x4{bf_lo(p.z), bf_hi(p.z), bf_lo(p.w), bf_hi(p.w)}; }
#pragma unroll
                    for (int n = 0; n < 2; ++n) hn[n] = hn[n] + gv[n] * acc[ai][bj][m][n];
                    { u32x4 w; w.x = cvt_pk_bf16(hn[0][0], hn[0][1]); w.y = cvt_pk_bf16(hn[0][2], hn[0][3]); w.z = cvt_pk_bf16(hn[1][0], hn[1][1]); w.w = cvt_pk_bf16(hn[1][2], hn[1][3]);
                      gst<u32x4>(d + (size_t)rl * HP + col0 + bj * HALF, w); }
                    if (NEXT) { ss[ai][m] += (hn[0].x * hn[0].x + hn[0].y * hn[0].y) + (hn[0].z * hn[0].z + hn[0].w * hn[0].w) + (hn[1].x * hn[1].x + hn[1].y * hn[1].y) + (hn[1].z * hn[1].z + hn[1].w * hn[1].w);
                        const f32x4 a0 = hn[0] * Gn[0], a1 = hn[1] * Gn[1];
                        if (N8) { typedef unsigned u32x2_ __attribute__((ext_vector_type(2)));
                            gst<u32x2_>((unsigned char*)An + (size_t)(prow + rl) * 1024 + col0 + bj * HALF, (u32x2_){cvt_pk_fp8x4(a0[0], a0[1], a0[2], a0[3]), cvt_pk_fp8x4(a1[0], a1[1], a1[2], a1[3])}); }
                        else { u32x4 w; w.x = cvt_pk_bf16(a0[0], a0[1]); w.y = cvt_pk_bf16(a0[2], a0[3]); w.z = cvt_pk_bf16(a1[0], a1[1]); w.w = cvt_pk_bf16(a1[2], a1[3]);
                            gst<u32x4>(An + (size_t)(prow + rl) * 1024 + col0 + bj * HALF, w); } } }
        }
        if (NEXT) {
#pragma unroll
            for (int ai = 0; ai < 2; ++ai)
#pragma unroll
                for (int m = 0; m < 4; ++m) { float t = ss[ai][m]; t += __shfl_xor(t, 16); t += __shfl_xor(t, 32); if (fq == 0) gst<float>(ssq + (size_t)(prow + rl0 + ai * HALF + m * 16) * 32 + u.pn * 4 + wc, t); }
        }
    }
};

template <bool F8S> struct EpiMoeDown {
    static constexpr bool PERM = true, AFTER_DRAIN = false; static constexpr float scale = F8S ? 1.0f / (F8_SH * F8_SW2) : 1.0f;
    bf16_t* Y; const float* slot_gate;
    __device__ __forceinline__ void operator()(const f32x4 (&acc)[2][2][4][2], const Unit& u, int wr, int wc, int fr, int fq) const {
        const int row0 = u.pm * BM + wr * 64 + fr; const int col0 = (u.pn & 3) * BM + wc * 32 + 8 * fq;
#pragma unroll
        for (int ai = 0; ai < 2; ++ai)
#pragma unroll
            for (int m = 0; m < 4; ++m) { const int row = row0 + ai * HALF + m * 16; const float sg = gld<float>(slot_gate + row) * scale; bf16_t* rowp = Y + (size_t)row * 1024 + col0;
#pragma unroll
                for (int bj = 0; bj < 2; ++bj) { const f32x4 v0 = acc[ai][bj][m][0] * sg, v1 = acc[ai][bj][m][1] * sg;
                    u32x4 w; w.x = cvt_pk_bf16(v0[0], v0[1]); w.y = cvt_pk_bf16(v0[2], v0[3]); w.z = cvt_pk_bf16(v1[0], v1[1]); w.w = cvt_pk_bf16(v1[2], v1[3]);
                    gst<u32x4>(rowp + bj * HALF, w); } }
    }
};

struct GridOrder {
    int nM, nN, nwg, G, c;
    __device__ void init(int nM_, int nN_, int G_, int c_) { nM = nM_; nN = nN_; nwg = nM * nN; G = G_; c = c_; }
    __device__ bool next(int i, Unit& u) const {
        const long L = (long)i * G + c; if (L >= nwg) return false;
        int wgid = (int)L; { const int q = nwg / NXCD, r = nwg % NXCD, xcd = wgid % NXCD, off = wgid / NXCD; wgid = (xcd < r ? xcd * (q + 1) : r * (q + 1) + (xcd - r) * q) + off; }
        const int nig = WGM * nN, gid = wgid / nig, fm = gid * WGM, gsz = (nM - fm) < WGM ? (nM - fm) : WGM;
        u.pm = fm + ((wgid % nig) % gsz); u.pn = (wgid % nig) / gsz; return true;
    }
    __device__ __forceinline__ void a_ready(const Unit&) const {}
    __device__ __forceinline__ void done(const Unit&) const {}
};
struct MoeOrder {
    GridOrder g; const PG8_LAS int* pexp; int nNe;
    __device__ bool next(int i, Unit& u) const { if (!g.next(i, u)) return false; u.pn += pexp[u.pm] * nNe; return true; }
    __device__ __forceinline__ void a_ready(const Unit&) const {}
    __device__ __forceinline__ void done(const Unit&) const {}
};
template <int NNE> struct MoeOrderC {
    int nM, c; const PG8_LAS int* pexp;
    __device__ bool next(int i, Unit& u) const {
        const int nwg = nM * NNE; const long L = (long)i * 256 + c; if (L >= nwg) return false;
        int wgid = (int)L; { const int q = nwg / NXCD, r = nwg % NXCD, xcd = wgid % NXCD, off = wgid / NXCD; wgid = (xcd < r ? xcd * (q + 1) : r * (q + 1) + (xcd - r) * q) + off; }
        constexpr int nig = WGM * NNE; const int gid = wgid / nig, fm = gid * WGM, gsz = (nM - fm) < WGM ? (nM - fm) : WGM;
        u.pm = fm + ((wgid % nig) % gsz); u.pn = (wgid % nig) / gsz; u.pn += pexp[u.pm] * NNE; return true;
    }
    __device__ __forceinline__ void a_ready(const Unit&) const {}
    __device__ __forceinline__ void done(const Unit&) const {}
};
__device__ __forceinline__ const char* sgpr_ptr(const char* p) { const unsigned long long v = (unsigned long long)p; const unsigned lo = __builtin_amdgcn_readfirstlane((unsigned)v), hi = __builtin_amdgcn_readfirstlane((unsigned)(v >> 32)); return (const char*)(((unsigned long long)hi << 32) | lo); }
template <class Epi, class Sched, bool ALIGN_EPI = false, bool SP2 = false, bool F8 = false>
__device__ __forceinline__ void gemm_phase(PG8_LAS unsigned char* lds, const Gemm g, const Sched& S, const Epi& E) {
    int tid_ = threadIdx.x; asm volatile("" : "+v"(tid_));
    const int tid = tid_, wid = __builtin_amdgcn_readfirstlane(tid >> 6), lane = tid & 63, wr = wid >> 2, wc = wid & 3, fr = lane & 15, fq = lane >> 4;
    const int K = g.K, nt = K / BK;
    unsigned voffA[2], voffB[2];
#pragma unroll
    for (int i = 0; i < 2; ++i) { int R, C; stage_rc(tid * 16 + i * 8192, R, C); const int Rb = Epi::PERM ? ((R & ~31) + perm32(R & 31)) : R;
        voffA[i] = (unsigned)(R * K + C) * 2u; voffB[i] = (unsigned)(Rb * K + C) * 2u; }
    const size_t kstep = (size_t)(BK * 2);
    const size_t hstep = (size_t)HALF * K * 2;
    const size_t tstep = 2 * hstep;
    const unsigned ldsw = (unsigned)wid * 1024u;
    const int aoff = lds_byte(wr * 64 + fr, fq * 8), boff = lds_byte(wc * 32 + fr, fq * 8);
#define PG8_SA(b, h) (((b) * 2 + (h)) * HTB)
#define PG8_SB(b, h) ((4 + (b) * 2 + (h)) * HTB)
#define PG8_STAGE(bufoff, gbase, voff) do { _Pragma("unroll") for (int _i = 0; _i < 2; ++_i) { unsigned _vo = (voff)[_i]; asm volatile("" : "+v"(_vo)); unsigned _lw = ldsw; asm volatile("" : "+s"(_lw)); \
        __builtin_amdgcn_global_load_lds((const unsigned*)((const char*)(gbase) + _vo), (PG8_LAS unsigned*)(lds + (bufoff) + _lw + _i * 8192), 16, 0, 0); } } while (0)
#define PG8_LDA(dst, b, h) do { _Pragma("unroll") for (int m = 0; m < 4; ++m) _Pragma("unroll") for (int k = 0; k < 2; ++k) dst[m][k] = *(const PG8_LAS bf16x8*)(lds + PG8_SA(b, h) + aoff + m * 2048 + k * 1024); } while (0)
#define PG8_LDB(dst, b, h) do { _Pragma("unroll") for (int n = 0; n < 2; ++n) _Pragma("unroll") for (int k = 0; k < 2; ++k) dst[n][k] = *(const PG8_LAS bf16x8*)(lds + PG8_SB(b, h) + boff + n * 2048 + k * 1024); } while (0)
#define PG8_CAT8(x0, x1) __builtin_shufflevector(__builtin_bit_cast(i32x4_, x0), __builtin_bit_cast(i32x4_, x1), 0, 1, 2, 3, 4, 5, 6, 7)
#define PG8_MMA(ai, bj, At, Bt) do { __builtin_amdgcn_s_setprio(1); if constexpr (F8) { _Pragma("unroll") for (int m = 0; m < 4; ++m) _Pragma("unroll") for (int n = 0; n < 2; ++n) \
        acc[ai][bj][m][n] = __builtin_amdgcn_mfma_scale_f32_16x16x128_f8f6f4(PG8_CAT8(Bt[n][0], Bt[n][1]), PG8_CAT8(At[m][0], At[m][1]), acc[ai][bj][m][n], 0, 0, 0, 0, 0, 0); } else { \
        _Pragma("unroll") for (int m = 0; m < 4; ++m) _Pragma("unroll") for (int n = 0; n < 2; ++n) _Pragma("unroll") for (int k = 0; k < 2; ++k) \
        acc[ai][bj][m][n] = __builtin_amdgcn_mfma_f32_16x16x32_bf16(Bt[n][k], At[m][k], acc[ai][bj][m][n], 0, 0, 0); } __builtin_amdgcn_s_setprio(0); } while (0)
#define PG8_WAIT_V(n) asm volatile("s_waitcnt vmcnt(" #n ")" ::: "memory")
#define PG8_WAIT_L(n) asm volatile("s_waitcnt lgkmcnt(" #n ")" ::: "memory")
#define PG8_BAR __builtin_amdgcn_s_barrier()
#define PG8_SCHED __builtin_amdgcn_sched_barrier(0)
    Unit cur, nxt; int ui = 0;
    if (!S.next(0, cur)) return;
    f32x4 acc[2][2][4][2];
#pragma unroll
    for (int a = 0; a < 2; ++a)
#pragma unroll
        for (int b = 0; b < 2; ++b)
#pragma unroll
            for (int m = 0; m < 4; ++m)
#pragma unroll
                for (int n = 0; n < 2; ++n) acc[a][b][m][n] = (f32x4){0.f, 0.f, 0.f, 0.f};
    bf16x8 At[4][2], B0[2][2], B1[2][2];
    const char* cA = (const char*)g.A + (size_t)cur.pm * tstep; const char* cB = (const char*)g.Bt + (size_t)cur.pn * tstep;
    S.a_ready(cur);
    if constexpr (SP2) {
        PG8_STAGE(PG8_SB(0, 0), cB, voffB); PG8_STAGE(PG8_SB(0, 1), cB + hstep, voffB); PG8_STAGE(PG8_SA(0, 0), cA, voffA); PG8_STAGE(PG8_SA(0, 1), cA + hstep, voffA);
        if (wr == 1) PG8_BAR;
        PG8_WAIT_V(2); PG8_BAR;
        PG8_STAGE(PG8_SB(1, 0), cB + kstep, voffB); PG8_STAGE(PG8_SA(1, 0), cA + kstep, voffA); PG8_STAGE(PG8_SB(1, 1), cB + hstep + kstep, voffB);
        PG8_WAIT_V(6); PG8_BAR;
    } else {
        PG8_STAGE(PG8_SB(0, 0), cB, voffB); PG8_STAGE(PG8_SA(0, 0), cA, voffA); PG8_STAGE(PG8_SB(0, 1), cB + hstep, voffB); PG8_STAGE(PG8_SA(0, 1), cA + hstep, voffA);
        if (wr == 1) PG8_BAR;
        PG8_WAIT_V(4); PG8_BAR;
        PG8_STAGE(PG8_SB(1, 0), cB + kstep, voffB); PG8_STAGE(PG8_SA(1, 0), cA + kstep, voffA); PG8_STAGE(PG8_SB(1, 1), cB + hstep + kstep, voffB);
        PG8_WAIT_V(6); PG8_BAR;
    }
    for (;;) {
        const bool has_next = S.next(ui + 1, nxt);
        const char* nA = has_next ? (const char*)g.A + (size_t)nxt.pm * tstep : cA; const char* nB = has_next ? (const char*)g.Bt + (size_t)nxt.pn * tstep : cB;
        for (int t = 0; t < nt; t += 2) {
            const bool last = (t == nt - 2);
            const char* a1 = cA + (size_t)(t + 1) * kstep;
            const char* a2 = last ? nA : cA + (size_t)(t + 2) * kstep; const char* b2 = last ? nB : cB + (size_t)(t + 2) * kstep;
            const char* a3 = a2 + kstep; const char* b3 = b2 + kstep;
            if (last && has_next) S.a_ready(nxt);
            if constexpr (SP2) {
            PG8_LDB(B0, 0, 0); PG8_LDB(B1, 0, 1); PG8_SCHED; PG8_LDA(At, 0, 0); PG8_STAGE(PG8_SA(1, 1), a1 + hstep, voffA);
            PG8_WAIT_V(8); PG8_WAIT_L(0); PG8_BAR; PG8_MMA(0, 0, At, B0); PG8_MMA(0, 1, At, B1); PG8_BAR; PG8_SCHED;
            PG8_LDA(At, 0, 1); PG8_STAGE(PG8_SB(0, 0), b2, voffB); PG8_STAGE(PG8_SB(0, 1), b2 + hstep, voffB); PG8_STAGE(PG8_SA(0, 0), a2, voffA);
            PG8_WAIT_V(8); PG8_WAIT_L(0); PG8_BAR; PG8_MMA(1, 0, At, B0); PG8_MMA(1, 1, At, B1); PG8_BAR; PG8_SCHED;
            PG8_LDB(B0, 1, 0); PG8_LDB(B1, 1, 1); PG8_SCHED; PG8_LDA(At, 1, 0); PG8_STAGE(PG8_SA(0, 1), a2 + hstep, voffA);
            PG8_WAIT_V(8); PG8_WAIT_L(0); PG8_BAR; PG8_MMA(0, 0, At, B0); PG8_MMA(0, 1, At, B1); PG8_BAR; PG8_SCHED;
            PG8_LDA(At, 1, 1); PG8_STAGE(PG8_SB(1, 0), b3, voffB); PG8_STAGE(PG8_SB(1, 1), b3 + hstep, voffB); PG8_STAGE(PG8_SA(1, 0), a3, voffA);
            PG8_WAIT_V(8); PG8_WAIT_L(0); PG8_BAR; PG8_MMA(1, 0, At, B0); PG8_MMA(1, 1, At, B1); PG8_BAR; PG8_SCHED;
            } else {
            PG8_LDB(B0, 0, 0); PG8_SCHED; PG8_LDA(At, 0, 0); PG8_STAGE(PG8_SA(1, 1), a1 + hstep, voffA);
            PG8_WAIT_L(8); PG8_BAR; PG8_WAIT_L(0); PG8_MMA(0, 0, At, B0); PG8_BAR; PG8_SCHED;
            PG8_LDB(B1, 0, 1); PG8_STAGE(PG8_SB(0, 0), b2, voffB);
            PG8_BAR; PG8_WAIT_L(0); PG8_MMA(0, 1, At, B1); PG8_BAR;
            PG8_LDA(At, 0, 1); PG8_STAGE(PG8_SA(0, 0), a2, voffA);
            PG8_BAR; PG8_WAIT_L(0); PG8_MMA(1, 0, At, B0); PG8_BAR; PG8_SCHED;
            PG8_STAGE(PG8_SB(0, 1), b2 + hstep, voffB);
            PG8_WAIT_V(6); PG8_BAR; PG8_MMA(1, 1, At, B1); PG8_BAR;
            PG8_LDB(B0, 1, 0); PG8_SCHED; PG8_LDA(At, 1, 0); PG8_STAGE(PG8_SA(0, 1), a2 + hstep, voffA);
            PG8_WAIT_L(8); PG8_BAR; PG8_WAIT_L(0); PG8_MMA(0, 0, At, B0); PG8_BAR; PG8_SCHED;
            PG8_LDB(B1, 1, 1); PG8_STAGE(PG8_SB(1, 0), b3, voffB);
            PG8_BAR; PG8_WAIT_L(0); PG8_MMA(0, 1, At, B1); PG8_BAR;
            PG8_LDA(At, 1, 1); PG8_STAGE(PG8_SA(1, 0), a3, voffA);
            PG8_BAR; PG8_WAIT_L(0); PG8_MMA(1, 0, At, B0); PG8_BAR; PG8_SCHED;
            PG8_STAGE(PG8_SB(1, 1), b3 + hstep, voffB);
            PG8_WAIT_V(6); PG8_BAR; PG8_MMA(1, 1, At, B1); PG8_BAR;
            }
        }
        if constexpr (ALIGN_EPI) { if (wr == 0) PG8_BAR; }
        if constexpr (!Epi::AFTER_DRAIN) { E(acc, cur, wr, wc, fr, fq); S.done(cur); }
        if (!has_next) break;
#pragma unroll
        for (int a = 0; a < 2; ++a)
#pragma unroll
            for (int b = 0; b < 2; ++b)
#pragma unroll
                for (int m = 0; m < 4; ++m)
#pragma unroll
                    for (int n = 0; n < 2; ++n) acc[a][b][m][n] = (f32x4){0.f, 0.f, 0.f, 0.f};
        cur = nxt; cA = nA; cB = nB; ++ui;
        if constexpr (ALIGN_EPI) { if (wr == 1) PG8_BAR; }
    }
    PG8_WAIT_V(0);
    if constexpr (!ALIGN_EPI) { if (wr == 0) PG8_BAR; }
    PG8_BAR;
    if constexpr (Epi::AFTER_DRAIN) { E.fused(acc, cur, wr, wc, fr, fq, lds, wid, lane); S.done(cur); }
#undef PG8_SA
#undef PG8_SB
#undef PG8_STAGE
#undef PG8_LDA
#undef PG8_LDB
#undef PG8_MMA
#undef PG8_CAT8
#undef PG8_WAIT_V
#undef PG8_WAIT_L
#undef PG8_BAR
#undef PG8_SCHED
}
}

#define GAS __attribute__((address_space(1)))
#define LAS __attribute__((address_space(3)))
typedef unsigned short bf16;
typedef unsigned v4u __attribute__((ext_vector_type(4)));
typedef unsigned v2u __attribute__((ext_vector_type(2)));
typedef float f32x4 __attribute__((ext_vector_type(4)));
typedef float f32x16 __attribute__((ext_vector_type(16)));
typedef short bf16x8 __attribute__((ext_vector_type(8)));
typedef short s16x4 __attribute__((ext_vector_type(4)));
typedef GAS unsigned gu32;
#define RLX_AGENT __ATOMIC_RELAXED, __HIP_MEMORY_SCOPE_AGENT
#define LDS_WAIT() asm volatile("s_waitcnt lgkmcnt(0)" ::: "memory")

#ifndef MK_NGRP
#define MK_NGRP 1
#endif
constexpr int D = 1024, NGRP = MK_NGRP, NB = 8 / NGRP, SEQ = 4096, CTXL = 256, TLAT = NB * SEQ, TCTX = NB * CTXL, TTOT = TLAT + TCTX;
constexpr int FF = 2816, NE = 8, MAXSLOT = 73728 / NGRP;
constexpr float EPS = 1e-6f;
constexpr int NWAVES = 8, NTHR = 512, GG = 256 / NGRP;
constexpr float LOG2E = 1.4426950408889634f;
constexpr float QSCALE = 0.125f * LOG2E;

enum { I_X = 0, I_C, I_CTX, I_CCTX, I_ADAW, I_ADAB, I_NMIX, I_NFFN, I_SCIN, I_SCCONV, I_SCOUT, I_DAQKV, I_DAOUT, I_DAQG, I_DAKG, I_DALAM, I_DASUB,
       I_CMIN, I_CMINB, I_CMVG, I_CMWS, I_CMBS, I_CMOUT, I_SWQKV, I_SWOUT, I_SWQG, I_SWKG, I_SWSINK, I_W1, I_W3, I_W2, I_RW, I_RB, I_MW1, I_MW3, I_MW2, N_IN };

constexpr size_t MiB = 1u << 20;
constexpr size_t WS_CTL = 0, CTL_ZERO_BYTES = 1 * MiB;
constexpr size_t WS_ZERO = 256 * 1024;
constexpr size_t WS_MOD = 1 * MiB;
constexpr size_t WS_RT = 2 * MiB;
constexpr size_t WS_WSB = 2 * MiB + 65536;
constexpr size_t WS_BIAS = 3 * MiB;
constexpr size_t BIAS_P6 = WS_BIAS, BIAS_P9 = BIAS_P6 + 9 * 5632 * 4, BIAS_P22 = BIAS_P9 + 9 * 3072 * 4, BIAS_P25 = BIAS_P22 + 9 * 5632 * 4;
constexpr size_t T_TOKG = (size_t)TTOT * 4, T_TOKS = T_TOKG + (size_t)TTOT * 8, T_SGATE = T_TOKS + (size_t)TTOT * 8, T_WGCNT = T_SGATE + (size_t)MAXSLOT * 4, T_PANEL = T_WGCNT + (size_t)GG * 32, T_END = T_PANEL + 4096;
static_assert(T_END <= 1 * MiB, "per-group token tables");
constexpr size_t WS_TOK = 4 * MiB, TOK_STRIDE = 1 * MiB;
constexpr size_t WS_SSQ = 6 * MiB, SSQ_STRIDE = (size_t)TTOT * 32 * 4;
constexpr size_t WS_HC = 11 * MiB;
constexpr size_t WS_W = 19 * MiB;
constexpr size_t W_SCIN = WS_W, W_SCOUT = W_SCIN + 6 * MiB, W_DAQKV = W_SCOUT + 2 * MiB, W_DAOUT = W_DAQKV + 6 * MiB, W_CMIN = W_DAOUT + 2 * MiB, W_CMOUT = W_CMIN + 8 * MiB,
                 W_SWQKV = W_CMOUT + 4 * MiB, W_SWOUT = W_SWQKV + 3 * MiB, W_F13 = W_SWOUT + 2 * MiB  , W_F2 = W_F13 + 22 * MiB  , W_MOE = W_F2 + 11 * MiB,
                 W_MOE_STRIDE = 132 * MiB  , W_END = W_MOE + 2 * W_MOE_STRIDE;
static_assert(W_END == 349 * MiB, "weight map");
static_assert(WS_ZERO + 512 * 1024 <= CTL_ZERO_BYTES && BIAS_P25 + 9 * 1536 * 4 <= WS_TOK && WS_SSQ + NGRP * SSQ_STRIDE <= WS_HC && WS_HC + (size_t)NGRP * TCTX * 4096 <= WS_W, "small-buffer map");
constexpr size_t WS_S = 349 * MiB, S_STRIDE = (size_t)MAXSLOT * 1024 * 2;
constexpr size_t WS_H = WS_S + NGRP * S_STRIDE, H_STRIDE = (size_t)MAXSLOT * 2816 * 2;
constexpr size_t A_IN_H = (size_t)TTOT * 4096 * 2;
constexpr size_t WS_END = WS_H + NGRP * H_STRIDE;
static_assert(WS_END == 889 * MiB && (size_t)TTOT * 4096 * 2 <= A_IN_H && A_IN_H + (size_t)TTOT * 1024 * 2 <= H_STRIDE && (size_t)TTOT * 2048 * 2 <= S_STRIDE, "ws map");

constexpr int CW_BAR = 4096;
constexpr int CW_FLAG_DENSE = 64, CW_FLAG_MOE = 128;

constexpr int RING_BYTES = 131072;
constexpr int PERS_OFF = RING_BYTES;
constexpr int MISC_OFF = PERS_OFF + 4096;
constexpr int LDS_BYTES = 147456;

__device__ __forceinline__ unsigned f2bf(float f) { unsigned u = __builtin_bit_cast(unsigned, f); return (u + 0x7fffu + ((u >> 16) & 1u)) >> 16; }
__device__ __forceinline__ unsigned pk2(float lo, float hi) { unsigned r; asm volatile("v_cvt_pk_bf16_f32 %0, %1, %2" : "=v"(r) : "v"(lo), "v"(hi)); return r; }
__device__ __forceinline__ float bflo(unsigned u) { return __builtin_bit_cast(float, u << 16); }
__device__ __forceinline__ float bfhi(unsigned u) { return __builtin_bit_cast(float, u & 0xffff0000u); }
constexpr int HPITCH = 2048;
__device__ __forceinline__ float wave_sum(float v) {
#pragma unroll
    for (int o = 1; o < 64; o <<= 1) v += __shfl_xor(v, o);
    return v;
}
#define XB_TMO      128
#define XB_XCNT(j)  (256  + 64 * (j))
#define XB_XSUB(j)  (1280 + 64 * (j))
#define XB_XGEN(j)  (2304 + 64 * (j))
#define XB_TOP      3328
#define XB_TOPGEN   3392
#define XCD_BAR_WORDS 3456
#define XB_SPIN_CAP (1u << 18)

__device__ __forceinline__ unsigned xb_ld(unsigned* p)              { return __hip_atomic_load(p, __ATOMIC_RELAXED, __HIP_MEMORY_SCOPE_AGENT); }
__device__ __forceinline__ unsigned xb_add(unsigned* p, unsigned v) { return __hip_atomic_fetch_add(p, v, __ATOMIC_RELAXED, __HIP_MEMORY_SCOPE_AGENT); }
__device__ __forceinline__ unsigned xb_xcc_id() { return (unsigned)__builtin_amdgcn_s_getreg((3 << 11) | 20) & 0xFu; }
#define XB_SPIN(cond, bar) do { unsigned _sp = 0; while (cond) { __builtin_amdgcn_s_sleep(1); \
    if ((++_sp & 255u) == 0u) { if (xb_ld(&(bar)[XB_TMO])) break; if (_sp > XB_SPIN_CAP) { atomicAdd(&(bar)[XB_TMO], 1u); break; } } } } while (0)

struct XcdBarrier {
    unsigned* bar; unsigned x; unsigned gsz;
    volatile LAS unsigned* st;
};

__device__ __forceinline__ XcdBarrier xcd_barrier_post(unsigned* bar, volatile LAS unsigned* st, unsigned gsz) {
    XcdBarrier b; b.bar = bar; b.x = xb_xcc_id(); b.st = st; b.gsz = gsz;
    if (threadIdx.x == 0) (void)xb_add(&bar[XB_XCNT(b.x)], 1u);
    return b;
}
__device__ __forceinline__ void xcd_barrier_complete(unsigned* bar, unsigned x, unsigned& nloc, unsigned& nx, unsigned G) {
    unsigned sum, cnt, mine, sp = 0u;
    for (;;) {
        sum = 0u; cnt = 0u; mine = 0u;
#pragma unroll
        for (unsigned j = 0; j < 16; ++j) { const unsigned c = xb_ld(&bar[XB_XCNT(j)]); sum += c; cnt += (c > 0u) ? 1u : 0u; mine = (j == x) ? c : mine; }
        if (sum == G) break;
        __builtin_amdgcn_s_sleep(1);
        if ((++sp & 255u) == 0u) { if (xb_ld(&bar[XB_TMO])) break; if (sp > XB_SPIN_CAP) { atomicAdd(&bar[XB_TMO], 1u); break; } }
    }
    nloc = mine > 0u ? mine : 1u; nx = cnt > 0u ? cnt : 1u;
}

__device__ __forceinline__ void xcd_barrier(const XcdBarrier& b) {
    asm volatile("s_waitcnt vmcnt(0)" ::: "memory");
    __syncthreads();
    if (threadIdx.x == 0) {
        unsigned* bar = b.bar;
        __builtin_amdgcn_s_waitcnt(0);
        unsigned nloc = b.st[0], nx = b.st[1];
        if (nloc == 0u) { xcd_barrier_complete(bar, b.x, nloc, nx, b.gsz); b.st[0] = nloc; b.st[1] = nx; }
        const unsigned old = xb_add(&bar[XB_XSUB(b.x)], 1u);
        const unsigned gen = old / nloc;
        if (old + 1u == (gen + 1u) * nloc) {
            __builtin_amdgcn_fence(__ATOMIC_RELEASE, "agent");
            asm volatile("s_waitcnt vmcnt(0)" ::: "memory");
            const unsigned og = xb_add(&bar[XB_TOP], 1u);
            const unsigned tg = og / nx;
            if (og + 1u == (tg + 1u) * nx) xb_add(&bar[XB_TOPGEN], 1u);
            else XB_SPIN(xb_ld(&bar[XB_TOPGEN]) == tg, bar);
            __builtin_amdgcn_fence(__ATOMIC_ACQUIRE, "agent");
            xb_add(&bar[XB_XGEN(b.x)], 1u);
            asm volatile("s_waitcnt vmcnt(0)" ::: "memory");
        } else {
            XB_SPIN(xb_ld(&bar[XB_XGEN(b.x)]) == gen, bar);
            __builtin_amdgcn_fence(__ATOMIC_ACQUIRE, "agent");
            asm volatile("s_waitcnt vmcnt(0)" ::: "memory");
        }
    }
    __syncthreads();
}

struct Args { const float* in[N_IN]; float* out; unsigned char* ws; int ph_lo, ph_hi; };
struct Grp {
    const float* x; const float* ctx; float* out; float* hc; bf16* A; bf16* S; bf16* H;
    int* toke; float* tokg; int* toks; float* sgate; int* wgcnt; int* panel; float* ssq; int b0;
};

template <bool RP = false> __device__ __forceinline__ void transpose_item(const float* __restrict__ W, int K, int N, bf16* WT, int k0, int n0, int drow0, LAS float* scr, int lane) {
    { f32x4 v[8]; const int r8 = lane >> 3, c4 = lane & 7;
#pragma unroll
      for (int i = 0; i < 8; ++i) v[i] = *(const f32x4*)(W + (size_t)(k0 + 8 * i + r8) * N + n0 + 4 * c4);
#pragma unroll
      for (int i = 0; i < 8; ++i) { LAS float* d = scr + (8 * i + r8) * 33 + 4 * c4; d[0] = v[i].x; d[1] = v[i].y; d[2] = v[i].z; d[3] = v[i].w; } }
    LDS_WAIT(); asm volatile("" ::: "memory");
    const int c = lane & 7;
#pragma unroll
    for (int j = 0; j < 4; ++j) { const int n = (lane >> 3) + 8 * j; const LAS float* s = scr + (8 * c) * 33 + n;
        v4u o; o.x = f2bf(s[0 * 33]) | (f2bf(s[1 * 33]) << 16); o.y = f2bf(s[2 * 33]) | (f2bf(s[3 * 33]) << 16); o.z = f2bf(s[4 * 33]) | (f2bf(s[5 * 33]) << 16); o.w = f2bf(s[6 * 33]) | (f2bf(s[7 * 33]) << 16);
        const int dn = RP ? (8 * ((n & 15) >> 2) + 4 * (n >> 4) + (n & 3)) : n;
        *(GAS v4u*)(WT + (size_t)(drow0 + dn) * K + k0 + 8 * c) = o; }
    LDS_WAIT(); asm volatile("" ::: "memory");
}
__device__ __forceinline__ void transpose_item8(const float* __restrict__ W, int K, int N, unsigned char* WT8, int k0, int n0, int drow0, float sc, LAS float* scr, int lane) {
    { f32x4 v[8]; const int r8 = lane >> 3, c4 = lane & 7;
#pragma unroll
      for (int i = 0; i < 8; ++i) v[i] = *(const f32x4*)(W + (size_t)(k0 + 8 * i + r8) * N + n0 + 4 * c4);
#pragma unroll
      for (int i = 0; i < 8; ++i) { LAS float* d = scr + (8 * i + r8) * 33 + 4 * c4; d[0] = v[i].x; d[1] = v[i].y; d[2] = v[i].z; d[3] = v[i].w; } }
    LDS_WAIT(); asm volatile("" ::: "memory");
    const int c = lane & 7;
#pragma unroll
    for (int j = 0; j < 4; ++j) { const int n = (lane >> 3) + 8 * j; const LAS float* s = scr + (8 * c) * 33 + n;
        v2u o; o.x = pg8::cvt_pk_fp8x4(s[0 * 33] * sc, s[1 * 33] * sc, s[2 * 33] * sc, s[3 * 33] * sc); o.y = pg8::cvt_pk_fp8x4(s[4 * 33] * sc, s[5 * 33] * sc, s[6 * 33] * sc, s[7 * 33] * sc);
        *(GAS v2u*)(WT8 + (size_t)(drow0 + n) * K + k0 + 8 * c) = o; }
    LDS_WAIT(); asm volatile("" ::: "memory");
}
template <int MODE> __device__ __forceinline__ void conv_item8(const float* W, int K, int N, unsigned char* WT8, int r, float sc, LAS float* scr, int lane) {
    const int nblk = N / 32, kb = r / nblk, nb = r % nblk, n0 = nb * 32;
    const int drow = (MODE == 0) ? n0 : ((n0 >> 7) * 256 + (n0 & 127) + (MODE == 2 ? 128 : 0));
    transpose_item8(W, K, N, WT8, kb * 64, n0, drow, sc, scr, lane);
}
template <int MODE> __device__ __forceinline__ void conv_item(const float* W, int K, int N, bf16* WT, int r, LAS float* scr, int lane, int nqk = 0) {
    const int nblk = N / 32, kb = r / nblk, nb = r % nblk, n0 = nb * 32;
    int drow = (MODE == 0) ? n0 : ((n0 >> 7) * 256 + (n0 & 127) + (MODE == 2 ? 128 : 0));
    if (MODE == 4) drow = (n0 < 1024) ? n0 : (1024 + (((n0 - 1024) & 1023) >> 7) * 256 + (n0 >= 2048 ? 128 : 0) + (n0 & 127));
    if (MODE == 3) { drow = (n0 < nqk) ? ((n0 >> 8) * 256 + ((n0 >> 5) & 1) * 128 + ((n0 >> 6) & 3) * 32) : n0;
        if (n0 < nqk) { transpose_item<true>(W, K, N, WT, kb * 64, n0, drow, scr, lane); return; } }
    transpose_item(W, K, N, WT, kb * 64, n0, drow, scr, lane);
}
constexpr bool D0_IN8 = true, D0_H8 = true;
constexpr bool D2_8 = true;
constexpr bool MOE8_L[2] = {true, true};
using pg8::F8_SA; using pg8::F8_SW13; using pg8::F8_SW2; using pg8::F8_SAU;
__device__ __forceinline__ void conv_moe(const Args& a, int f, LAS unsigned char* lds, int gw, int ngw, int wave, int lane, int it_lo = 0, int it_hi = NE * 3 * 1408) {
    LAS float* scr = (LAS float*)(lds + wave * 16384);
    constexpr int PER = 1408;
    bf16* w13 = (bf16*)(a.ws + W_MOE + (size_t)f * W_MOE_STRIDE); bf16* w2 = (bf16*)(a.ws + W_MOE + (size_t)f * W_MOE_STRIDE + 88 * MiB);
    for (int it = it_lo + gw; it < it_hi; it += ngw) {
        const int e = it / (3 * PER), rem = it % (3 * PER), which = rem / PER, r = rem % PER;
        const size_t eo = ((size_t)f * NE + e) * 1024 * 2816;
        if (MOE8_L[f]) {
            unsigned char* w13b = (unsigned char*)w13; unsigned char* w2b = (unsigned char*)w2;
            if (which == 0)      conv_item8<1>(a.in[I_MW1] + eo, 1024, 2816, w13b + (size_t)e * 5632 * 1024, r, F8_SW13, scr, lane);
            else if (which == 1) conv_item8<2>(a.in[I_MW3] + eo, 1024, 2816, w13b + (size_t)e * 5632 * 1024, r, F8_SW13, scr, lane);
            else                 conv_item8<0>(a.in[I_MW2] + eo, 2816, 1024, w2b + (size_t)e * 1024 * 2816, r, F8_SW2, scr, lane);
            continue; }
        if (which == 0)      conv_item<1>(a.in[I_MW1] + eo, 1024, 2816, w13 + (size_t)e * 5632 * 1024, r, scr, lane);
        else if (which == 1) conv_item<2>(a.in[I_MW3] + eo, 1024, 2816, w13 + (size_t)e * 5632 * 1024, r, scr, lane);
        else                 conv_item<0>(a.in[I_MW2] + eo, 2816, 1024, w2 + (size_t)e * 1024 * 2816, r, scr, lane);
    }
}
__device__ __forceinline__ void conv_dense(const Args& a, LAS unsigned char* lds, int gw, int ngw, int wave, int lane) {
    LAS float* scr = (LAS float*)(lds + wave * 16384);
    constexpr int N_SCIN = 16 * 96, N_1K = 16 * 32, N_CMIN = 16 * 128, N_CMOUT = 32 * 32, N_SWQKV = 16 * 48, N_FF = 1408;
    constexpr int TOTAL = N_SCIN + N_1K + N_SCIN + N_1K + N_CMIN + N_CMOUT + N_SWQKV + N_1K + 6 * N_FF;
    unsigned char* ws = a.ws;
    for (int it = gw; it < TOTAL; it += ngw) {
        int r = it;
        if (r < N_SCIN) { conv_item<4>(a.in[I_SCIN], 1024, 3072, (bf16*)(ws + W_SCIN), r, scr, lane); continue; } r -= N_SCIN;
        if (r < N_1K) { conv_item<0>(a.in[I_SCOUT], 1024, 1024, (bf16*)(ws + W_SCOUT), r, scr, lane); continue; } r -= N_1K;
        if (r < N_SCIN) { conv_item<3>(a.in[I_DAQKV], 1024, 3072, (bf16*)(ws + W_DAQKV), r, scr, lane, 2048); continue; } r -= N_SCIN;
        if (r < N_1K) { conv_item<0>(a.in[I_DAOUT], 1024, 1024, (bf16*)(ws + W_DAOUT), r, scr, lane); continue; } r -= N_1K;
        if (r < N_CMIN) { conv_item<0>(a.in[I_CMIN], 1024, 4096, (bf16*)(ws + W_CMIN), r, scr, lane); continue; } r -= N_CMIN;
        if (r < N_CMOUT) { conv_item<0>(a.in[I_CMOUT], 2048, 1024, (bf16*)(ws + W_CMOUT), r, scr, lane); continue; } r -= N_CMOUT;
        if (r < N_SWQKV) { conv_item<3>(a.in[I_SWQKV], 1024, 1536, (bf16*)(ws + W_SWQKV), r, scr, lane, 1280); continue; } r -= N_SWQKV;
        if (r < N_1K) { conv_item<0>(a.in[I_SWOUT], 1024, 1024, (bf16*)(ws + W_SWOUT), r, scr, lane); continue; } r -= N_1K;
        const int f = r / (3 * N_FF), rem = r % (3 * N_FF), which = rem / N_FF, rr = rem % N_FF; const size_t fo = (size_t)f * 1024 * 2816;
        if ((which < 2) ? (f == 0 ? D0_IN8 : D2_8) : (f == 0 ? D0_H8 : D2_8)) {
            unsigned char* w13b = ws + W_F13 + (size_t)f * 5632 * 1024 * 2; unsigned char* w2b = ws + W_F2 + (size_t)f * 1024 * 2816 * 2;
            if (which == 0)      conv_item8<1>(a.in[I_W1] + fo, 1024, 2816, w13b, rr, F8_SW13, scr, lane);
            else if (which == 1) conv_item8<2>(a.in[I_W3] + fo, 1024, 2816, w13b, rr, F8_SW13, scr, lane);
            else                 conv_item8<0>(a.in[I_W2] + fo, 2816, 1024, w2b, rr, F8_SW2, scr, lane);
            continue; }
        if (which == 0)      conv_item<1>(a.in[I_W1] + fo, 1024, 2816, (bf16*)(ws + W_F13) + (size_t)f * 5632 * 1024, rr, scr, lane);
        else if (which == 1) conv_item<2>(a.in[I_W3] + fo, 1024, 2816, (bf16*)(ws + W_F13) + (size_t)f * 5632 * 1024, rr, scr, lane);
        else                 conv_item<0>(a.in[I_W2] + fo, 2816, 1024, (bf16*)(ws + W_F2) + (size_t)f * 1024 * 2816, rr, scr, lane);
    }
}
__device__ __forceinline__ void adaln_phase(const Args& a, LAS unsigned char* lds, int vcu, int G, int tid) {
    LAS float* sl = (LAS float*)lds;
    LAS float* red = sl + 9 * 1024;
    for (int i = tid; i < 9 * 1024; i += NTHR) { const float cv = (i < 8192) ? a.in[I_C][i] : a.in[I_CCTX][i - 8192]; sl[i] = cv / (1.0f + __expf(-cv)); }
    __syncthreads();
    float* MOD = (float*)(a.ws + WS_MOD);
    const int c4 = tid & 63, kg = tid >> 6;
    for (int u = vcu; u < 4 * 24; u += G) {
        const int l = u / 24, n0 = (u % 24) * 256;
        const float* w = a.in[I_ADAW] + (size_t)l * 1024 * 6144 + n0 + 4 * c4;
        f32x4 acc[9];
#pragma unroll
        for (int ci = 0; ci < 9; ++ci) acc[ci] = (f32x4){0.f, 0.f, 0.f, 0.f};
#pragma unroll 1
        for (int k0 = kg * 128; k0 < kg * 128 + 128; k0 += 8) { f32x4 wv[8];
#pragma unroll
            for (int j = 0; j < 8; ++j) wv[j] = *(const f32x4*)(w + (size_t)(k0 + j) * 6144);
#pragma unroll
            for (int j = 0; j < 8; ++j)
#pragma unroll
                for (int ci = 0; ci < 9; ++ci) acc[ci] += wv[j] * sl[ci * 1024 + k0 + j]; }
#pragma unroll
        for (int ci = 0; ci < 9; ++ci) *(LAS f32x4*)(red + (kg * 9 + ci) * 256 + 4 * c4) = acc[ci];
        __syncthreads();
        for (int o = tid; o < 9 * 256; o += NTHR) { const int ci = o >> 8, cc = o & 255; float s = a.in[I_ADAB][l * 6144 + n0 + cc];
#pragma unroll
            for (int k2 = 0; k2 < 8; ++k2) s += red[(k2 * 9 + ci) * 256 + cc];
            MOD[(size_t)(l * 9 + ci) * 6144 + n0 + cc] = s; }
        __syncthreads();
    }
}
__device__ __forceinline__ void rope_table(const Args& a, int tid) {
    float* RT = (float*)(a.ws + WS_RT);
    for (int i = tid; i < 1024; i += NTHR) {
        const int p = i >> 4, f = i & 15;
        double inv = 1.0; for (int j = 0; j < f; ++j) inv *= 0.56234132519034908;
        const float ang = (float)p * (float)inv;
        const double x = (double)ang;
        const double kq = __builtin_rint(x * 0.63661977236758134);
        const double r = (x - kq * 1.5707963267948966) - kq * 6.123233995736766e-17;
        const double r2 = r * r;
        double sn = 1.0, cs = 1.0;
        sn = 1.0 - r2 / (18.0 * 19.0) * sn; sn = 1.0 - r2 / (16.0 * 17.0) * sn; sn = 1.0 - r2 / (14.0 * 15.0) * sn; sn = 1.0 - r2 / (12.0 * 13.0) * sn; sn = 1.0 - r2 / (10.0 * 11.0) * sn;
        sn = 1.0 - r2 / (8.0 * 9.0) * sn; sn = 1.0 - r2 / (6.0 * 7.0) * sn; sn = 1.0 - r2 / (4.0 * 5.0) * sn; sn = 1.0 - r2 / (2.0 * 3.0) * sn; sn *= r;
        cs = 1.0 - r2 / (17.0 * 18.0) * cs; cs = 1.0 - r2 / (15.0 * 16.0) * cs; cs = 1.0 - r2 / (13.0 * 14.0) * cs; cs = 1.0 - r2 / (11.0 * 12.0) * cs; cs = 1.0 - r2 / (9.0 * 10.0) * cs;
        cs = 1.0 - r2 / (7.0 * 8.0) * cs; cs = 1.0 - r2 / (5.0 * 6.0) * cs; cs = 1.0 - r2 / (3.0 * 4.0) * cs; cs = 1.0 - r2 / (1.0 * 2.0) * cs;
        const int q = ((int)kq) & 3;
        const double c = (q == 0) ? cs : (q == 1) ? -sn : (q == 2) ? -cs : sn;
        const double s = (q == 0) ? sn : (q == 1) ? cs : (q == 2) ? -sn : -cs;
        RT[2 * i] = (float)c; RT[2 * i + 1] = (float)s;
    }
}

__device__ __forceinline__ void bias_rows(const bf16* Wt, int N, const float* sh  , float* B, int first, int gw, int ngw, int lane) {
    for (int n = gw - first; n < N; n += ngw) { if (n < 0) continue;
        const v4u w0 = ((const v4u*)(Wt + (size_t)n * 1024))[lane], w1 = ((const v4u*)(Wt + (size_t)n * 1024))[lane + 64];
        const float wf[16] = {bflo(w0.x), bfhi(w0.x), bflo(w0.y), bfhi(w0.y), bflo(w0.z), bfhi(w0.z), bflo(w0.w), bfhi(w0.w), bflo(w1.x), bfhi(w1.x), bflo(w1.y), bfhi(w1.y), bflo(w1.z), bfhi(w1.z), bflo(w1.w), bfhi(w1.w)};
#pragma unroll 1
        for (int ci = 0; ci < 9; ++ci) { const f32x4* sp = (const f32x4*)(sh + (size_t)ci * 6144); const f32x4 a = sp[2 * lane], b = sp[2 * lane + 1], c = sp[128 + 2 * lane], d = sp[128 + 2 * lane + 1];
            float t = (a.x * wf[0] + a.y * wf[1]) + (a.z * wf[2] + a.w * wf[3]) + (b.x * wf[4] + b.y * wf[5]) + (b.z * wf[6] + b.w * wf[7]) + (c.x * wf[8] + c.y * wf[9]) + (c.z * wf[10] + c.w * wf[11]) + (d.x * wf[12] + d.y * wf[13]) + (d.z * wf[14] + d.w * wf[15]);
            t = wave_sum(t); if (lane == 0) B[(size_t)ci * N + n] = t; }
    }
}
__device__ __forceinline__ void bias_rows8(const unsigned char* Wt8, int N, float winv, const float* sh, float* B, int gw, int ngw, int lane) {
    typedef float f32x2_ __attribute__((ext_vector_type(2)));
    for (int n = gw; n < N; n += ngw) {
        const v4u w = ((const v4u*)(Wt8 + (size_t)n * 1024))[lane];
        float wf[16];
#pragma unroll
        for (int q = 0; q < 4; ++q) { const int wd = (int)(q == 0 ? w.x : q == 1 ? w.y : q == 2 ? w.z : w.w);
            const f32x2_ lo = __builtin_amdgcn_cvt_pk_f32_fp8(wd, false), hi = __builtin_amdgcn_cvt_pk_f32_fp8(wd, true); wf[4 * q] = lo.x; wf[4 * q + 1] = lo.y; wf[4 * q + 2] = hi.x; wf[4 * q + 3] = hi.y; }
#pragma unroll 1
        for (int ci = 0; ci < 9; ++ci) { const f32x4* sp = (const f32x4*)(sh + (size_t)ci * 6144); const f32x4 a = sp[4 * lane], b = sp[4 * lane + 1], c = sp[4 * lane + 2], d = sp[4 * lane + 3];
            float t = (a.x * wf[0] + a.y * wf[1]) + (a.z * wf[2] + a.w * wf[3]) + (b.x * wf[4] + b.y * wf[5]) + (b.z * wf[6] + b.w * wf[7]) + (c.x * wf[8] + c.y * wf[9]) + (c.z * wf[10] + c.w * wf[11]) + (d.x * wf[12] + d.y * wf[13]) + (d.z * wf[14] + d.w * wf[15]);
            t = wave_sum(t); if (lane == 0) B[(size_t)ci * N + n] = t * winv; }
    }
}
__device__ __forceinline__ void bias_phase(const Args& a, int gw, int ngw, int lane) {
    const float* MOD = (const float*)(a.ws + WS_MOD);
    if (D0_IN8) bias_rows8(a.ws + W_F13, 5632, 1.0f / F8_SW13, MOD + 0 * 9 * 6144 + 3072, (float*)(a.ws + BIAS_P6), gw, ngw, lane);
    else bias_rows((const bf16*)(a.ws + W_F13), 5632, MOD + 0 * 9 * 6144 + 3072, (float*)(a.ws + BIAS_P6), 0, gw, ngw, lane);
    bias_rows((const bf16*)(a.ws + W_DAQKV), 3072, MOD + 1 * 9 * 6144 + 0, (float*)(a.ws + BIAS_P9), 0, gw, ngw, lane);
    if (D2_8) bias_rows8(a.ws + W_F13 + (size_t)5632 * 1024 * 2, 5632, 1.0f / F8_SW13, MOD + 2 * 9 * 6144 + 3072, (float*)(a.ws + BIAS_P22), gw, ngw, lane);
    else bias_rows((const bf16*)(a.ws + W_F13) + (size_t)5632 * 1024, 5632, MOD + 2 * 9 * 6144 + 3072, (float*)(a.ws + BIAS_P22), 0, gw, ngw, lane);
    bias_rows((const bf16*)(a.ws + W_SWQKV), 1536, MOD + 3 * 9 * 6144 + 0, (float*)(a.ws + BIAS_P25), 0, gw, ngw, lane);
}

template <bool COMBINE, bool NORM, bool ROUTER, bool SRC32, bool OUT32, bool A8 = false>
__device__ __forceinline__ void row_phase(const Args& a, const Grp& c, LAS unsigned char* lds, const void* src_lat, const void* src_ctx, void* dst_lat, void* dst_ctx, int nrows,
                                          const float* gn, const float* mod  , int sh_off  , const float* mod_prev_g2  ,
                                          const float* rw, const float* rb, int vcu, int G, int tid, int wave, int lane) {
    LAS float* wrT = (LAS float*)lds;
    LAS int* hist = (LAS int*)(lds + 32768);
    if (ROUTER) {
        for (int i = tid; i < 8192; i += NTHR) { const int k = i >> 3, e = i & 7; wrT[e * 1024 + k] = rw[i]; }
        if (tid < 8) hist[tid] = 0;
        __syncthreads();
    }
    bf16* A = c.A;
    const bf16* Y = c.S;
    const int* toks = c.toks;
    int* toke = c.toke; float* tokg = c.tokg;
    f32x4 gv[4];
    if (NORM) {
#pragma unroll
        for (int j = 0; j < 4; ++j) gv[j] = ((const f32x4*)gn)[lane + 64 * j];
    }
    const int gw = vcu * NWAVES + wave, ngw = G * NWAVES;
    struct RowRegs { f32x4 v[4]; v2u hraw[4]; v2u q0[4], q1[4]; };
    auto ld = [&](const int m, RowRegs& r) __attribute__((always_inline)) {
        const bool lat = m < TLAT;
        if (SRC32) { const float* hr = lat ? (const float*)src_lat + (size_t)m * 1024 : (const float*)src_ctx + (size_t)(m - TLAT) * 1024;
#pragma unroll
            for (int j = 0; j < 4; ++j) r.v[j] = ((const f32x4*)hr)[lane + 64 * j];
        } else { const bf16* hr = lat ? (const bf16*)src_lat + (size_t)m * HPITCH : (const bf16*)src_ctx + (size_t)(m - TLAT) * HPITCH;
#pragma unroll
            for (int j = 0; j < 4; ++j) r.hraw[j] = ((const v2u*)hr)[lane + 64 * j];
        }
        if (COMBINE) {
            const int s0 = toks[2 * m], s1 = toks[2 * m + 1];
            const v2u* y0 = (const v2u*)(Y + (size_t)s0 * 1024); const v2u* y1 = (const v2u*)(Y + (size_t)s1 * 1024);
#pragma unroll
            for (int j = 0; j < 4; ++j) { r.q0[j] = y0[lane + 64 * j]; r.q1[j] = y1[lane + 64 * j]; }
        }
    };
    auto body = [&](const int m, RowRegs& r) __attribute__((always_inline)) {
        const bool lat = m < TLAT; const int cidx = lat ? c.b0 + (m >> 12) : 8;
        f32x4 (&v)[4] = r.v;
        if (!SRC32) {
#pragma unroll
            for (int j = 0; j < 4; ++j) { const v2u p = r.hraw[j]; v[j] = f32x4{bflo(p.x), bfhi(p.x), bflo(p.y), bfhi(p.y)}; }
        }
        if (COMBINE) {
            const f32x4* g2 = (const f32x4*)(mod_prev_g2 + (size_t)cidx * 6144);
            float* hw32 = (float*)dst_lat + (size_t)m * 1024;
            bf16* hw = lat ? (bf16*)dst_lat + (size_t)m * HPITCH : (bf16*)dst_ctx + (size_t)(m - TLAT) * HPITCH;
            if (OUT32) asm volatile("" ::: "memory");
#pragma unroll
            for (int j = 0; j < 4; ++j) { const v2u p0 = r.q0[j], p1 = r.q1[j]; const f32x4 g = g2[lane + 64 * j];
                f32x4 ys; ys.x = bflo(p0.x) + bflo(p1.x); ys.y = bfhi(p0.x) + bfhi(p1.x); ys.z = bflo(p0.y) + bflo(p1.y); ys.w = bfhi(p0.y) + bfhi(p1.y);
                v[j] = v[j] + g * ys;
                if (OUT32) ((f32x4*)hw32)[lane + 64 * j] = v[j]; else { v2u o; o.x = pk2(v[j].x, v[j].y); o.y = pk2(v[j].z, v[j].w); ((v2u*)hw)[lane + 64 * j] = o; } }
        }
        if (NORM) {
            float ss = 0.f;
#pragma unroll
            for (int j = 0; j < 4; ++j) ss += (v[j].x * v[j].x + v[j].y * v[j].y) + (v[j].z * v[j].z + v[j].w * v[j].w);
            const float rstd = 1.0f / sqrtf(wave_sum(ss) * (1.0f / 1024.0f) + EPS);
            const f32x4* shp = (const f32x4*)(mod + (size_t)cidx * 6144 + sh_off); const f32x4* scp = shp + 256;
            v2u* ar = (v2u*)(A + (size_t)m * 1024);
#pragma unroll
            for (int j = 0; j < 4; ++j) { const f32x4 sh = shp[lane + 64 * j], sc = scp[lane + 64 * j];
                v[j] = (v[j] * rstd * gv[j]) * (sc + 1.0f) + sh;
                if (A8) ((unsigned*)((unsigned char*)A + (size_t)m * 1024))[lane + 64 * j] = pg8::cvt_pk_fp8x4(v[j].x * F8_SA, v[j].y * F8_SA, v[j].z * F8_SA, v[j].w * F8_SA);
                else { v2u o; o.x = pk2(v[j].x, v[j].y); o.y = pk2(v[j].z, v[j].w); ar[lane + 64 * j] = o; } }
            if (ROUTER) {
                float lg[8];
#pragma unroll
                for (int e = 0; e < 8; ++e) { float s = 0.f;
#pragma unroll
                    for (int j = 0; j < 4; ++j) { const f32x4 w = ((const LAS f32x4*)(wrT + e * 1024))[lane + 64 * j]; s += (v[j].x * w.x + v[j].y * w.y) + (v[j].z * w.z + v[j].w * w.w); }
                    lg[e] = wave_sum(s) + rb[e]; }
                int i0 = 0; float v0 = lg[0];
#pragma unroll
                for (int e = 1; e < 8; ++e) if (lg[e] > v0) { v0 = lg[e]; i0 = e; }
                int i1 = -1; float v1 = -INFINITY;
#pragma unroll
                for (int e = 0; e < 8; ++e) if (e != i0 && lg[e] > v1) { v1 = lg[e]; i1 = e; }
                const float ex = __expf(v1 - v0); const float g0 = 1.0f / (1.0f + ex), g1 = ex * g0;
                if (lane == 0) { toke[m] = i0 | (i1 << 8); tokg[2 * m] = g0; tokg[2 * m + 1] = g1; atomicAdd((int*)(hist + i0), 1); atomicAdd((int*)(hist + i1), 1); }
            }
        }
    };
    for (int m = gw; m < nrows; m += 2 * ngw) {
        RowRegs ra, rb; const int mb = m + ngw; const bool hb = mb < nrows;
        ld(m, ra); ld(hb ? mb : m, rb);
        body(m, ra); if (hb) body(mb, rb);
    }
    if (ROUTER) { __syncthreads(); if (tid < 8) c.wgcnt[vcu * 8 + tid] = hist[tid]; }
}

template <bool A8>
__device__ __forceinline__ void moe_scatter_phase(const Grp& c, LAS unsigned char* lds, int nrows, int vcu, int G, int tid, int wave, int lane) {
    LAS int* cnt = (LAS int*)lds;
    LAS int* base = cnt + 2048;
    LAS int* tot = base + 8;
    LAS int* slots = tot + 8;
    const int* wg = c.wgcnt;
    for (int i = tid; i < GG * 8; i += NTHR) cnt[i] = wg[i];
    __syncthreads();
    if (tid < 8) { int t = 0, b = 0; for (int w = 0; w < G; ++w) { const int c = cnt[w * 8 + tid]; if (w < vcu) b += c; t += c; } tot[tid] = t; base[tid] = b; }
    __syncthreads();
    if (tid == 0) { int ps = 0; int* pan = c.panel; int np = 0;
        for (int e = 0; e < 8; ++e) { const int t = tot[e]; base[e] += ps; const int npe = (t + 255) >> 8;
            if (vcu == 0) for (int p = 0; p < npe; ++p) pan[1 + np + p] = e;
            np += npe; ps += npe * 256; }
        if (vcu == 0) pan[0] = np; }
    __syncthreads();
    const int* toke = c.toke; const float* tokg = c.tokg;
    int* toks = c.toks; float* sgate = c.sgate;
    const int ntok = (nrows / (G * NWAVES)) * NWAVES;
    if (wave == 0) {
        int run[8];
#pragma unroll
        for (int e = 0; e < 8; ++e) run[e] = base[e];
        for (int p0 = 0; p0 < ntok; p0 += 64) {
            const int j = p0 + lane; const bool ok = j < ntok; const int m = (vcu * NWAVES + (j & 7)) + (G * NWAVES) * (j >> 3);
            int e0 = -1, e1 = -1; if (ok) { const int ee = toke[m]; e0 = ee & 255; e1 = ee >> 8; }
            int s0 = 0, s1 = 0;
            const unsigned long long below = (lane == 0) ? 0ull : (~0ull >> (64 - lane));
#pragma unroll
            for (int e = 0; e < 8; ++e) { const unsigned long long mk = __ballot(e0 == e || e1 == e); const int rk = __popcll(mk & below);
                if (e0 == e) s0 = run[e] + rk; if (e1 == e) s1 = run[e] + rk; run[e] += __popcll(mk); }
            if (ok) { slots[2 * j] = s0; slots[2 * j + 1] = s1; toks[2 * m] = s0; toks[2 * m + 1] = s1; sgate[s0] = tokg[2 * m]; sgate[s1] = tokg[2 * m + 1]; }
        }
    }
    __syncthreads();
    const bf16* A = c.A; bf16* S = c.S;
    constexpr int RE = A8 ? 512 : 1024;
    for (int j0 = wave; j0 < ntok; j0 += 4 * NWAVES) {
        v4u x[4][2]; int sl[4][2];
#pragma unroll
        for (int r = 0; r < 4; ++r) { const int j = j0 + r * NWAVES; if (j < ntok) { const int m = (vcu * NWAVES + (j & 7)) + (G * NWAVES) * (j >> 3);
            const v4u* src = (const v4u*)(A + (size_t)m * RE); x[r][0] = src[lane]; if (!A8) x[r][1] = src[lane + 64]; sl[r][0] = slots[2 * j]; sl[r][1] = slots[2 * j + 1]; } }
#pragma unroll
        for (int r = 0; r < 4; ++r) { const int j = j0 + r * NWAVES; if (j < ntok) {
            v4u* d0 = (v4u*)(S + (size_t)sl[r][0] * RE); v4u* d1 = (v4u*)(S + (size_t)sl[r][1] * RE);
            d0[lane] = x[r][0]; d1[lane] = x[r][0]; if (!A8) { d0[lane + 64] = x[r][1]; d1[lane + 64] = x[r][1]; } } }
    }
}

__device__ __forceinline__ void conv_phase(const Args& a, const Grp& c, int vcu, int G, int wave, int lane) {
    const bf16* U = c.H; bf16* Z = c.S;
    const float* cw = a.in[I_SCCONV];
    const int gw = vcu * NWAVES + wave, ngw = G * NWAVES;
    for (int it = gw; it < (TTOT / 16) * 2; it += ngw) {
        const int strip = it >> 1, c0 = (it & 1) * 512 + lane * 8, t0 = strip * 16;
        const int seqlen = (t0 < TLAT) ? SEQ : CTXL; const int tin = (t0 < TLAT) ? (t0 & (SEQ - 1)) : ((t0 - TLAT) & (CTXL - 1));
        float w0[8], w1[8], w2[8];
#pragma unroll
        for (int i = 0; i < 8; ++i) { w0[i] = cw[c0 + i]; w1[i] = cw[1024 + c0 + i]; w2[i] = cw[2048 + c0 + i]; }
        float yp[8], yc[8], yn[8];
        auto ld_y = [&](int t, float (&y)[8]) { const v4u yv = *(const v4u*)(U + (size_t)t * 2048 + 1024 + c0);
            y[0] = bflo(yv.x); y[1] = bfhi(yv.x); y[2] = bflo(yv.y); y[3] = bfhi(yv.y); y[4] = bflo(yv.z); y[5] = bfhi(yv.z); y[6] = bflo(yv.w); y[7] = bfhi(yv.w); };
        if (tin > 0) ld_y(t0 - 1, yp); else {
#pragma unroll
            for (int i = 0; i < 8; ++i) yp[i] = 0.f; }
        ld_y(t0, yc);
#pragma unroll 4
        for (int r = 0; r < 16; ++r) {
            const int t = t0 + r;
            if (tin + r + 1 < seqlen) ld_y(t + 1, yn); else {
#pragma unroll
                for (int i = 0; i < 8; ++i) yn[i] = 0.f; }
            const v4u bg = *(const v4u*)(U + (size_t)t * 2048 + c0);
            float b[8] = {bflo(bg.x), bfhi(bg.x), bflo(bg.y), bfhi(bg.y), bflo(bg.z), bfhi(bg.z), bflo(bg.w), bfhi(bg.w)};
            float z[8];
#pragma unroll
            for (int i = 0; i < 8; ++i) z[i] = b[i] * (w0[i] * yp[i] + w1[i] * yc[i] + w2[i] * yn[i]);
            v4u o; o.x = pk2(z[0], z[1]); o.y = pk2(z[2], z[3]); o.z = pk2(z[4], z[5]); o.w = pk2(z[6], z[7]);
            *(v4u*)(Z + (size_t)t * 1024 + c0) = o;
#pragma unroll
            for (int i = 0; i < 8; ++i) { yp[i] = yc[i]; yc[i] = yn[i]; }
        }
    }
}

__device__ __forceinline__ void qknorm_phase(const Args& a, const Grp& c, int ld, int nq, int nk, const float* qg, const float* kg, int vcu, int G, int wave, int lane) {
    bf16* QKV = c.H; const float* RT = (const float*)(a.ws + WS_RT);
    const int j8 = lane & 7;
    const int fb = 8 * (j8 & 1); const bool second = (j8 >> 1) & 1; const bool usecol = j8 >= 4;
    float gq[8], gk[8];
#pragma unroll
    for (int i = 0; i < 8; ++i) { gq[i] = qg[8 * j8 + i] * QSCALE; gk[i] = kg[8 * j8 + i]; }
    const int nch = (nq + nk) * 8;
    const int gw = vcu * NWAVES + wave, ngw = G * NWAVES;
    for (int m = gw; m < TTOT; m += ngw) {
        const bool lat = m < TLAT; const int s = m & (SEQ - 1); const int pos = usecol ? (s & 63) : (s >> 6);
        bf16* rowp = QKV + (size_t)m * ld;
        v4u raw[4];
#pragma unroll
        for (int k = 0; k < 4; ++k) { const int ch = lane + 64 * k; if (ch < nch) raw[k] = *(const v4u*)(rowp + ch * 8); }
        float cs[8], sn[8];
        if (lat) {
#pragma unroll
            for (int i = 0; i < 8; ++i) { const float2 t = *(const float2*)(RT + 2 * (pos * 16 + fb + i)); cs[i] = t.x; sn[i] = t.y; }
        }
#pragma unroll
        for (int k = 0; k < 4; ++k) { const int ch = lane + 64 * k;
            if (ch < nch) {
                const bool isq = (ch >> 3) < nq;
                float x[8] = {bflo(raw[k].x), bfhi(raw[k].x), bflo(raw[k].y), bfhi(raw[k].y), bflo(raw[k].z), bfhi(raw[k].z), bflo(raw[k].w), bfhi(raw[k].w)};
                float ss = 0.f;
#pragma unroll
                for (int i = 0; i < 8; ++i) ss += x[i] * x[i];
                ss += __shfl_xor(ss, 1); ss += __shfl_xor(ss, 2); ss += __shfl_xor(ss, 4);
                const float rstd = 1.0f / sqrtf(ss * (1.0f / 64.0f) + EPS);
#pragma unroll
                for (int i = 0; i < 8; ++i) x[i] = x[i] * rstd * (isq ? gq[i] : gk[i]);
                if (lat) {
#pragma unroll
                    for (int i = 0; i < 8; ++i) { const float o = __shfl_xor(x[i], 2); x[i] = second ? (o * sn[i] + x[i] * cs[i]) : (x[i] * cs[i] - o * sn[i]); }
                }
                v4u w; w.x = pk2(x[0], x[1]); w.y = pk2(x[2], x[3]); w.z = pk2(x[4], x[5]); w.w = pk2(x[6], x[7]);
                *(v4u*)(rowp + ch * 8) = w; } }
    }
}
constexpr int KP = 144;
__device__ __forceinline__ s16x4 vtr(const LAS unsigned char* p) { typedef short v4i16_t __attribute__((ext_vector_type(4)));
    return __builtin_bit_cast(s16x4, __builtin_amdgcn_ds_read_tr16_b64_v4i16((LAS v4i16_t*)p)); }
__device__ __forceinline__ int crow(int r, int hi) { return (r & 3) + 8 * (r >> 2) + 4 * hi; }

template <bool MASK>
__device__ __forceinline__ void attn_qk(const LAS unsigned char* Kb, const bf16x8 (&qr)[4], float nb2, float& lsum, v4u (&pw)[4], int lane, int kpos0, int qpos) {
    const int r32 = lane & 31, hi = lane >> 5;
    const LAS unsigned char* kp = Kb + r32 * KP + hi * 16;
    float acc = 0.f;
#pragma unroll
    for (int h = 0; h < 2; ++h) {
        f32x16 sc;
#pragma unroll
        for (int r = 0; r < 16; ++r) sc[r] = nb2;
#pragma unroll
        for (int d0 = 0; d0 < 4; ++d0) { const bf16x8 a0 = *(const LAS bf16x8*)(kp + h * 32 * KP + d0 * 32); sc = __builtin_amdgcn_mfma_f32_32x32x16_bf16(a0, qr[d0], sc, 0, 0, 0); }
#pragma unroll
        for (int r = 0; r < 16; ++r) { float p = __builtin_amdgcn_exp2f(sc[r]);
            if (MASK) { const int dd = kpos0 + 32 * h + crow(r, hi) - qpos; if (dd < -128 || dd > 128) p = 0.f; }
            sc[r] = p; acc += p; }
#pragma unroll
        for (int i = 0; i < 4; ++i) { pw[2 * h][i] = pk2(sc[2 * i], sc[2 * i + 1]); pw[2 * h + 1][i] = pk2(sc[8 + 2 * i], sc[8 + 2 * i + 1]); }
        asm volatile("" :: "v"(pw[2 * h]), "v"(pw[2 * h + 1]));
    }
    lsum += acc;
}
template <int NDV, int VP>
__device__ __forceinline__ void attn_pv(const LAS unsigned char* Vb, const v4u (&pw)[4], f32x16 (&o)[NDV], int lane) {
    const int hi = lane >> 5, i16 = lane & 15, rh = (lane >> 4) & 1;
    const LAS unsigned char* vp = Vb + (4 * hi + (i16 >> 2)) * VP + rh * 32 + (i16 & 3) * 8;
#pragma unroll
    for (int t = 0; t < NDV; ++t)
#pragma unroll
        for (int ks = 0; ks < 4; ++ks) {
            const s16x4 lo = vtr(vp + (16 * ks) * VP + t * 64), hh = vtr(vp + (16 * ks + 8) * VP + t * 64);
            const bf16x8 vf = (bf16x8){lo[0], lo[1], lo[2], lo[3], hh[0], hh[1], hh[2], hh[3]};
            o[t] = __builtin_amdgcn_mfma_f32_32x32x16_bf16(vf, __builtin_bit_cast(bf16x8, pw[ks]), o[t], 0, 0, 0);
        }
}
template <int NDV  , int VP, bool MASK>
__device__ __forceinline__ void attn_tile(const LAS unsigned char* Kb, const LAS unsigned char* Vb, const bf16x8 (&qr)[4], float nb2, f32x16 (&o)[NDV], float& lsum, int lane, int kpos0, int qpos) {
    const int r32 = lane & 31, hi = lane >> 5;
    f32x16 s0, s1;
#pragma unroll
    for (int r = 0; r < 16; ++r) { s0[r] = nb2; s1[r] = nb2; }
    const LAS unsigned char* kp = Kb + r32 * KP + hi * 16;
#pragma unroll
    for (int d0 = 0; d0 < 4; ++d0) {
        const bf16x8 a0 = *(const LAS bf16x8*)(kp + d0 * 32), a1 = *(const LAS bf16x8*)(kp + 32 * KP + d0 * 32);
        s0 = __builtin_amdgcn_mfma_f32_32x32x16_bf16(a0, qr[d0], s0, 0, 0, 0);
        s1 = __builtin_amdgcn_mfma_f32_32x32x16_bf16(a1, qr[d0], s1, 0, 0, 0);
    }
    float acc = 0.f;
#pragma unroll
    for (int r = 0; r < 16; ++r) {
        float p0 = __builtin_amdgcn_exp2f(s0[r]), p1 = __builtin_amdgcn_exp2f(s1[r]);
        if (MASK) { const int k0 = kpos0 + crow(r, hi), k1 = k0 + 32; const int d0 = k0 - qpos, d1 = k1 - qpos;
            if (d0 < -128 || d0 > 128) p0 = 0.f; if (d1 < -128 || d1 > 128) p1 = 0.f; }
        s0[r] = p0; s1[r] = p1; acc += p0 + p1;
    }
    lsum += acc;
    v4u pw[4];
#pragma unroll
    for (int i = 0; i < 4; ++i) { pw[0][i] = pk2(s0[2 * i], s0[2 * i + 1]); pw[1][i] = pk2(s0[8 + 2 * i], s0[8 + 2 * i + 1]); pw[2][i] = pk2(s1[2 * i], s1[2 * i + 1]); pw[3][i] = pk2(s1[8 + 2 * i], s1[8 + 2 * i + 1]); }
    const int i16 = lane & 15, rh = (lane >> 4) & 1;
    const LAS unsigned char* vp = Vb + (4 * hi + (i16 >> 2)) * VP + rh * 32 + (i16 & 3) * 8;
#pragma unroll
    for (int t = 0; t < NDV; ++t)
#pragma unroll
        for (int ks = 0; ks < 4; ++ks) {
            const s16x4 lo = vtr(vp + (16 * ks) * VP + t * 64), hh = vtr(vp + (16 * ks + 8) * VP + t * 64);
            const bf16x8 vf = (bf16x8){lo[0], lo[1], lo[2], lo[3], hh[0], hh[1], hh[2], hh[3]};
            o[t] = __builtin_amdgcn_mfma_f32_32x32x16_bf16(vf, __builtin_bit_cast(bf16x8, pw[ks]), o[t], 0, 0, 0);
        }
}

__device__ __forceinline__ void diff_attn_phase(const Args& a, const Grp& c, LAS unsigned char* lds, int vcu, int G, int tid, int wave, int lane) {
    constexpr int VP = 320, KBUF = 64 * KP, VBUF = 64 * VP, BUF = KBUF + VBUF;
    const bf16* QKV = c.H; bf16* O = c.S;
    const float* lp = a.in[I_DALAM];
    float l01 = lp[lane] * lp[64 + lane], l23 = lp[128 + lane] * lp[192 + lane];
    l01 = wave_sum(l01); l23 = wave_sum(l23);
    const float lam_init = 0.8f - 0.6f * 0.7408182206817179f;
    const float lam = __expf(l01) - __expf(l23) + lam_init;
    float mq = fabsf(a.in[I_DAQG][lane]), mk = fabsf(a.in[I_DAKG][lane]);
#pragma unroll
    for (int o = 1; o < 64; o <<= 1) { mq = fmaxf(mq, __shfl_xor(mq, o)); mk = fmaxf(mk, __shfl_xor(mk, o)); }
    const float nb2 = -(8.0f * mq * mk * LOG2E * 1.001f + 0.01f);
    const float* subg = a.in[I_DASUB];
    const int r32 = lane & 31, hi = lane >> 5;
    const int krow = tid >> 3, kch = tid & 7;
    const unsigned koff = (unsigned)(krow * 6144 + kch * 16), voff = (unsigned)((tid >> 4) * 6144 + (tid & 15) * 16);
    for (int id = vcu; id < NB * 8 * 16 + NB * 8; id += G) {
        int b, h, nkt; size_t qrow0;
        if (id < NB * 8 * 16) { const int bh = id >> 4, qb = id & 15; b = bh >> 3; h = bh & 7; nkt = 68; qrow0 = (size_t)b * SEQ + qb * 256; }
        else { const int bh = id - NB * 8 * 16; b = bh >> 3; h = bh & 7; nkt = 4; qrow0 = (size_t)TLAT + b * CTXL; }
        const size_t ctx0 = (size_t)TLAT + b * CTXL, lat0 = (size_t)b * SEQ;
        const size_t qrow = qrow0 + wave * 32 + r32;
        v4u* o0l = (v4u*)((unsigned char*)c.A + (size_t)vcu * 65536 + wave * 8192) + lane;
#pragma unroll 1
        for (int map = 0; map < 2; ++map) {
            const int kh = 2 * h + map;
            bf16x8 qr[4];
#pragma unroll
            for (int d0 = 0; d0 < 4; ++d0) qr[d0] = *(const bf16x8*)(QKV + qrow * 3072 + kh * 64 + d0 * 16 + hi * 8);
            f32x16 o[4];
#pragma unroll
            for (int t = 0; t < 4; ++t)
#pragma unroll
                for (int r = 0; r < 16; ++r) o[t][r] = 0.f;
            float lsum = 0.f;
            v4u kreg, vreg0, vreg1;
            auto ld_tile = [&](int t) { const size_t r0 = (t < 4) ? ctx0 + t * 64 : lat0 + (size_t)(t - 4) * 64;
                const char* kb = (const char*)(QKV + r0 * 3072 + 1024 + kh * 64); const char* vb = (const char*)(QKV + r0 * 3072 + 2048 + h * 128);
                kreg = *(const v4u*)(kb + koff); vreg0 = *(const v4u*)(vb + voff); vreg1 = *(const v4u*)(vb + 32 * 6144 + voff); };
            auto st_tile = [&](int buf) { LAS unsigned char* base = lds + buf * BUF;
                *(LAS v4u*)(base + krow * KP + kch * 16) = kreg;
                *(LAS v4u*)(base + KBUF + (tid >> 4) * VP + (tid & 15) * 16) = vreg0;
                *(LAS v4u*)(base + KBUF + (32 + (tid >> 4)) * VP + (tid & 15) * 16) = vreg1; };
            ld_tile(0); st_tile(0); ld_tile(1); __syncthreads();
            if (wave < 4) {
                int bcur = 0;
#pragma unroll 1
                for (int t = 0; t < nkt; ++t) {
                    const int bnext = (bcur == 2) ? 0 : bcur + 1;
                    if (t + 1 < nkt) st_tile(bnext);
                    if (t + 2 < nkt) ld_tile(t + 2);
                    const LAS unsigned char* base = lds + bcur * BUF; v4u pw[4];
                    attn_qk<false>(base, qr, nb2, lsum, pw, lane, 0, 0); attn_pv<4, VP>(base + KBUF, pw, o, lane);
                    asm volatile("s_waitcnt lgkmcnt(0)\n\ts_barrier" ::: "memory");
                    bcur = bnext;
                }
            } else {
                int bcur = 0, bprev = 2; v4u pw[4];
#pragma unroll
                for (int i = 0; i < 4; ++i) pw[i] = (v4u){0u, 0u, 0u, 0u};
#pragma unroll 1
                for (int t = 0; t < nkt; ++t) {
                    const int bnext = (bcur == 2) ? 0 : bcur + 1;
                    if (t + 1 < nkt) st_tile(bnext);
                    if (t + 2 < nkt) ld_tile(t + 2);
                    if (t > 0) attn_pv<4, VP>(lds + bprev * BUF + KBUF, pw, o, lane);
                    attn_qk<false>(lds + bcur * BUF, qr, nb2, lsum, pw, lane, 0, 0);
                    asm volatile("s_waitcnt lgkmcnt(0)\n\ts_barrier" ::: "memory");
                    bprev = bcur; bcur = bnext;
                }
                attn_pv<4, VP>(lds + bprev * BUF + KBUF, pw, o, lane);
            }
            asm volatile("s_waitcnt lgkmcnt(0)\n\ts_barrier" ::: "memory");
            const float l = lsum + __shfl_xor(lsum, 32); const float inv = 1.0f / l;
            if (map == 0) {
#pragma unroll
                for (int t = 0; t < 4; ++t)
#pragma unroll
                    for (int r4 = 0; r4 < 2; ++r4) { v4u w;
#pragma unroll
                        for (int i = 0; i < 4; ++i) w[i] = pk2(o[t][8 * r4 + 2 * i] * inv, o[t][8 * r4 + 2 * i + 1] * inv);
                        o0l[(t * 2 + r4) * 64] = w; }
            } else {
                const float li = lam * inv; float ss = 0.f;
#pragma unroll
                for (int t = 0; t < 4; ++t)
#pragma unroll
                    for (int r4 = 0; r4 < 2; ++r4) { const v4u w = o0l[(t * 2 + r4) * 64];
#pragma unroll
                        for (int i = 0; i < 4; ++i) { const unsigned u = w[i]; const int r = 4 * r4 + i; const float d0 = bflo(u) - li * o[t][2 * r], d1 = bfhi(u) - li * o[t][2 * r + 1]; o[t][2 * r] = d0; o[t][2 * r + 1] = d1; ss += d0 * d0 + d1 * d1; } }
                ss += __shfl_xor(ss, 32);
                const float rs = (1.0f / sqrtf(ss * (1.0f / 128.0f) + EPS)) * (1.0f - lam_init);
                bf16* orow = O + qrow * 1024 + h * 128;
#pragma unroll
                for (int t = 0; t < 4; ++t)
#pragma unroll
                    for (int g = 0; g < 4; ++g) { const int dv = 32 * t + 8 * g + 4 * hi; const f32x4 sg = *(const f32x4*)(subg + dv);
                        v2u w; w.x = pk2(o[t][4 * g] * rs * sg.x, o[t][4 * g + 1] * rs * sg.y); w.y = pk2(o[t][4 * g + 2] * rs * sg.z, o[t][4 * g + 3] * rs * sg.w);
                        *(v2u*)(orow + dv) = w; }
            }
        }
    }
}

__device__ __forceinline__ void swa_attn_phase(const Args& a, const Grp& c, LAS unsigned char* lds, int vcu, int G, int tid, int wave, int lane) {
    constexpr int VP = 192, KBUF = 64 * KP, VBUF = 64 * VP, BUF = KBUF + VBUF;
    const bf16* QKV = c.H; bf16* O = c.S;
    float mq = fabsf(a.in[I_SWQG][lane]), mk = fabsf(a.in[I_SWKG][lane]); float ms = (lane < 16) ? a.in[I_SWSINK][lane] : -INFINITY;
#pragma unroll
    for (int o = 1; o < 64; o <<= 1) { mq = fmaxf(mq, __shfl_xor(mq, o)); mk = fmaxf(mk, __shfl_xor(mk, o)); ms = fmaxf(ms, __shfl_xor(ms, o)); }
    const float b2 = fmaxf(8.0f * mq * mk * 1.001f + 0.01f, ms) * LOG2E; const float nb2 = -b2;
    const int r32 = lane & 31, hi = lane >> 5;
    const int krow = tid >> 3, kch = tid & 7;
    for (int id = vcu; id < NB * 4 * 64; id += G) {
        const int qb = id & 63, kvh = (id >> 6) & 3, b = id >> 8;
        const int q0 = qb * 64; const int qh = kvh * 4 + (wave & 3); const int qpos = q0 + (wave >> 2) * 32 + r32;
        const size_t ctx0 = (size_t)TLAT + b * CTXL, lat0 = (size_t)b * SEQ;
        const size_t qrow = lat0 + qpos;
        int bt_lo = (128 - q0) / 64; if (bt_lo < 0) bt_lo = 0; int bt_hi = (SEQ + 128 - q0) / 64; if (bt_hi > 5) bt_hi = 5;
        const int nkt = 4 + (bt_hi - bt_lo);
        bf16x8 qr[4];
#pragma unroll
        for (int d0 = 0; d0 < 4; ++d0) qr[d0] = *(const bf16x8*)(QKV + qrow * 1536 + qh * 64 + d0 * 16 + hi * 8);
        f32x16 o[2];
#pragma unroll
        for (int t = 0; t < 2; ++t)
#pragma unroll
            for (int r = 0; r < 16; ++r) o[t][r] = 0.f;
        float lsum = 0.f;
        v4u kreg, vreg;
        auto tile_row0 = [&](int t) -> size_t { return (t < 4) ? ctx0 + t * 64 : lat0 + (size_t)(q0 - 128 + (t - 4 + bt_lo) * 64); };
        auto ld_tile = [&](int t) { const size_t r0 = tile_row0(t);
            kreg = *(const v4u*)(QKV + (r0 + krow) * 1536 + 1024 + kvh * 64 + kch * 8);
            vreg = *(const v4u*)(QKV + (r0 + krow) * 1536 + 1280 + kvh * 64 + kch * 8); };
        auto st_tile = [&](int buf) { LAS unsigned char* base = lds + buf * BUF;
            *(LAS v4u*)(base + krow * KP + kch * 16) = kreg;
            *(LAS v4u*)(base + KBUF + krow * VP + kch * 16) = vreg; };
        ld_tile(0); st_tile(0); __syncthreads();
#pragma unroll 1
        for (int t = 0; t < nkt; ++t) {
            if (t + 1 < nkt) ld_tile(t + 1);
            const LAS unsigned char* base = lds + (t & 1) * BUF;
            if (t < 4) attn_tile<2, VP, false>(base, base + KBUF, qr, nb2, o, lsum, lane, 0, 0);
            else attn_tile<2, VP, true>(base, base + KBUF, qr, nb2, o, lsum, lane, q0 - 128 + (t - 4 + bt_lo) * 64, qpos);
            if (t + 1 < nkt) st_tile((t + 1) & 1);
            __syncthreads();
        }
        const float l = lsum + __shfl_xor(lsum, 32) + __builtin_amdgcn_exp2f(a.in[I_SWSINK][qh] * LOG2E - b2); const float inv = 1.0f / l;
        bf16* orow = O + qrow * 1024 + qh * 64;
#pragma unroll
        for (int t = 0; t < 2; ++t)
#pragma unroll
            for (int g = 0; g < 4; ++g) { const int dv = 32 * t + 8 * g + 4 * hi;
                v2u w; w.x = pk2(o[t][4 * g] * inv, o[t][4 * g + 1] * inv); w.y = pk2(o[t][4 * g + 2] * inv, o[t][4 * g + 3] * inv);
                *(v2u*)(orow + dv) = w; }
    }
}

__device__ __forceinline__ void gate_phase(const Args& a, const Grp& c, LAS unsigned char* lds, int vcu, int G, int tid, int wave, int lane) {
    constexpr int WP = 272, VP = 576, TP = 528;
    LAS unsigned char* Wl = lds; LAS unsigned char* Vl = lds + 128 * WP; LAS float* rstd = (LAS float*)(lds + 128 * WP + 128 * VP); LAS float* bsl = rstd + 128;
    const bf16* Zc = c.H; bf16* Gout = c.S;
    const bf16* wsb = (const bf16*)(a.ws + WS_WSB); const float* ssq = c.ssq;
    const float* vg = a.in[I_CMVG];
    const int r32 = lane & 31, hi = lane >> 5, i16 = lane & 15, rh = (lane >> 4) & 1;
    const int q0 = tid >> 5, c8 = tid & 31;
    for (int i = tid; i < 1024; i += NTHR) bsl[i] = a.in[I_CMBS][i];
    const int NU = (TTOT / 128) * 8;
    v4u vraw[8], wraw[4]; f32x4 sq0, sq1;
    auto issue_vw = [&](int id) { const int n = id >> 3, g = id & 7; const size_t row0 = (size_t)n * 128;
        const bf16* zb = Zc + (row0 + q0) * 4096 + g * 256 + c8 * 8 + 2048;
#pragma unroll
        for (int i = 0; i < 8; ++i) vraw[i] = *(const v4u*)(zb + (size_t)i * 16 * 4096);
#pragma unroll
        for (int i = 0; i < 4; ++i) { const int ch = tid + NTHR * i, p = ch >> 4, c16 = ch & 15; wraw[i] = *(const v4u*)(wsb + ((size_t)g * 128 + p) * 128 + c16 * 8); }
        const f32x4* sp = (const f32x4*)(ssq + (row0 + (tid >> 2)) * 32 + (tid & 3) * 8); sq0 = sp[0]; sq1 = sp[1]; };
    if (vcu < NU) issue_vw(vcu);
    for (int id = vcu; id < NU; id += G) {
        const int n = id >> 3, g = id & 7; const size_t row0 = (size_t)n * 128;
        const f32x4 g0 = *(const f32x4*)(vg + g * 256 + c8 * 8), g1 = *(const f32x4*)(vg + g * 256 + c8 * 8 + 4);
        { float t = ((sq0.x + sq0.y) + (sq0.z + sq0.w)) + ((sq1.x + sq1.y) + (sq1.z + sq1.w)); t += __shfl_xor(t, 1); t += __shfl_xor(t, 2);
          if ((tid & 3) == 0) rstd[tid >> 2] = 1.0f / sqrtf(t * (1.0f / 2048.0f) + EPS); }
#pragma unroll
        for (int i = 0; i < 4; ++i) { const int ch = tid + NTHR * i, p = ch >> 4, c16 = ch & 15; *(LAS v4u*)(Wl + p * WP + c16 * 16) = wraw[i]; }
        __syncthreads();
#pragma unroll
        for (int i = 0; i < 8; ++i) { const int q = q0 + 16 * i; const float rs = rstd[q]; const v4u raw = vraw[i];
            v4u w; w.x = pk2(bflo(raw.x) * rs * g0.x, bfhi(raw.x) * rs * g0.y); w.y = pk2(bflo(raw.y) * rs * g0.z, bfhi(raw.y) * rs * g0.w);
            w.z = pk2(bflo(raw.z) * rs * g1.x, bfhi(raw.z) * rs * g1.y); w.w = pk2(bflo(raw.w) * rs * g1.z, bfhi(raw.w) * rs * g1.w);
            *(LAS v4u*)(Vl + q * VP + c8 * 16) = w; }
        __syncthreads();
        v4u uraw[8];
        { const bf16* zb = Zc + (row0 + q0) * 4096 + g * 256 + c8 * 8;
#pragma unroll
          for (int i = 0; i < 8; ++i) uraw[i] = *(const v4u*)(zb + (size_t)i * 16 * 4096); }
        if (id + G < NU) issue_vw(id + G);
        f32x16 d[4];
#pragma unroll
        for (int t = 0; t < 4; ++t)
#pragma unroll
            for (int r = 0; r < 16; ++r) d[t][r] = bsl[g * 128 + 32 * t + crow(r, hi)];
        const LAS unsigned char* vp = Vl + (8 * hi + (i16 >> 2)) * VP + (wave * 32 + rh * 16 + (i16 & 3) * 4) * 2;
        const LAS unsigned char* wp = Wl + r32 * WP + hi * 16;
#pragma unroll
        for (int ks = 0; ks < 8; ++ks) {
            const s16x4 lo = vtr(vp + (16 * ks) * VP), hh = vtr(vp + (16 * ks + 4) * VP);
            const bf16x8 bfr = (bf16x8){lo[0], lo[1], lo[2], lo[3], hh[0], hh[1], hh[2], hh[3]};
#pragma unroll
            for (int t = 0; t < 4; ++t) { const bf16x8 af = *(const LAS bf16x8*)(wp + (32 * t) * WP + ks * 32);
                d[t] = __builtin_amdgcn_mfma_f32_32x32x16_bf16(af, bfr, d[t], 0, 0, 0); }
        }
        asm volatile("s_waitcnt lgkmcnt(0)\n\ts_barrier" ::: "memory");
        { LAS bf16* T = (LAS bf16*)Vl; const int cc = wave * 32 + r32;
#pragma unroll
          for (int t = 0; t < 4; ++t)
#pragma unroll
            for (int r = 0; r < 16; ++r) { const int p = 32 * t + crow(r, hi); T[p * (TP / 2) + cc] = (bf16)f2bf(d[t][r]); } }
        asm volatile("s_waitcnt lgkmcnt(0)\n\ts_barrier" ::: "memory");
        bf16* gb = Gout + (row0 + q0) * 2048 + g * 256 + c8 * 8;
#pragma unroll
        for (int i = 0; i < 8; ++i) { const int p = q0 + 16 * i; const v4u sv = *(const LAS v4u*)(Vl + p * TP + c8 * 16); const v4u u = uraw[i];
            v4u w; w.x = pk2(bflo(u.x) * bflo(sv.x), bfhi(u.x) * bfhi(sv.x)); w.y = pk2(bflo(u.y) * bflo(sv.y), bfhi(u.y) * bfhi(sv.y));
            w.z = pk2(bflo(u.z) * bflo(sv.z), bfhi(u.z) * bfhi(sv.z)); w.w = pk2(bflo(u.w) * bflo(sv.w), bfhi(u.w) * bfhi(sv.w));
            *(v4u*)(gb + (size_t)i * 16 * 2048) = w; }
        asm volatile("s_waitcnt lgkmcnt(0)\n\ts_barrier" ::: "memory");
    }
}

constexpr int N_PHASES = 34;
__device__ __forceinline__ void wait_flag(gu32* flag) {
    if (threadIdx.x == 0) { unsigned sp = 0; while (__hip_atomic_load(flag, RLX_AGENT) == 0u) { __builtin_amdgcn_s_sleep(4); if (++sp > (1u << 22)) break; }
        __builtin_amdgcn_fence(__ATOMIC_ACQUIRE, "agent"); asm volatile("s_waitcnt vmcnt(0)" ::: "memory"); }
    __syncthreads();
}
__global__ void __launch_bounds__(NTHR, 2) mk_fwd(Args args) {
    extern __shared__ __attribute__((aligned(16))) unsigned char lds_raw[];
    LAS unsigned char* lds = (LAS unsigned char*)lds_raw;
    volatile LAS unsigned* MISC = (volatile LAS unsigned*)(lds + MISC_OFF);
#define PH_IDS int tid = threadIdx.x; asm volatile("" : "+v"(tid)); const int lane = tid & 63, wave = __builtin_amdgcn_readfirstlane(tid >> 6); const int gw = vcu * NWAVES + wave; (void)gw; (void)lane; \
        unsigned char* ws = args.ws; asm volatile("" : "+s"(ws));   \
        float* const MOD = (float*)(ws + WS_MOD); \
        Grp c; \
        c.b0 = grp * NB; \
        c.x = args.in[I_X] + (size_t)grp * TLAT * 1024; c.ctx = args.in[I_CTX] + (size_t)grp * TCTX * 1024; c.out = args.out + (size_t)grp * TLAT * 1024; c.hc = (float*)(ws + WS_HC) + (size_t)grp * TCTX * 1024; \
        c.S = (bf16*)(ws + WS_S + grp * S_STRIDE); c.H = (bf16*)(ws + WS_H + grp * H_STRIDE); c.A = (bf16*)(ws + WS_H + grp * H_STRIDE + A_IN_H); \
        { unsigned char* t = ws + WS_TOK + grp * TOK_STRIDE; c.toke = (int*)t; c.tokg = (float*)(t + T_TOKG); c.toks = (int*)(t + T_TOKS); c.sgate = (float*)(t + T_SGATE); c.wgcnt = (int*)(t + T_WGCNT); c.panel = (int*)(t + T_PANEL); } \
        c.ssq = (float*)(ws + WS_SSQ + grp * SSQ_STRIDE); \
        bf16* const HL = (bf16*)c.out; bf16* const HCX = (bf16*)c.hc; bf16* const ABUF = c.A; bf16* const SBUF = c.S; bf16* const HBUF = c.H; \
        const int b0 = c.b0; (void)MOD; (void)HL; (void)HCX; (void)ABUF; (void)SBUF; (void)HBUF; (void)b0
    const int bx = blockIdx.x; const int grp = (NGRP == 2) ? ((bx >> 2) & 1) : 0;
    const int G = GG; const int vcu = (NGRP == 2) ? ((bx & 3) * 32 + (bx >> 3)) : ((bx & 7) * 32 + (bx >> 3));
    const int oid = (NGRP == 2) ? ((bx >> 3) * 4 + (bx & 3)) : bx;
    gu32* ctl = (gu32*)(args.ws + WS_CTL);
    for (int u = threadIdx.x; u < (LDS_BYTES - PERS_OFF) / 4; u += NTHR) ((LAS unsigned*)(lds + PERS_OFF))[u] = 0u;
    __syncthreads();
    const int lo = args.ph_lo, hi = args.ph_hi;
    XcdBarrier bar = xcd_barrier_post((unsigned*)(ctl + CW_BAR) + grp * XCD_BAR_WORDS, MISC + 8, (unsigned)GG);
#ifndef PH_LO
#define PH_LO 0
#define PH_HI 99
#endif
#define IN(k) ((k) >= PH_LO && (k) < PH_HI && lo <= (k) && (k) < hi)
#define SEAM(k) do { if (IN(k) && IN((k) + 1)) xcd_barrier(bar); } while (0)
    const int ngw = G * NWAVES;
    LAS int* const ptab = (LAS int*)(lds + PERS_OFF);

    constexpr int CM_ALL = NE * 3 * 1408, CM0_A = CM_ALL * 18 / 100, CM0_B = CM_ALL * 82 / 100, CM1_A = CM_ALL * 35 / 100;
#define PG8_ER(n, s) pg8::EpiResid<n, s>
#define PG8_ER4(n, s, n8, a8) pg8::EpiResid<n, s, n8, a8>
#define GEMM_GRID8(Abuf, Wt, nM_, nN_, K_, EpiT, Eobj) do { pg8::Gemm g{(const pg8::bf16_t*)(Abuf), (const pg8::bf16_t*)(Wt), (nM_) * 256, (nN_) * 256, (K_)}; pg8::GridOrder S; S.init((nM_), (nN_), G, oid); \
        pg8::gemm_phase<EpiT, pg8::GridOrder, true, true, true>(lds, g, S, (Eobj)); } while (0)
#define GEMM_GRID(Abuf, Wt, nM_, nN_, K_, EpiT, Eobj) do { pg8::Gemm g{(const pg8::bf16_t*)(Abuf), (const pg8::bf16_t*)(Wt), (nM_) * 256, (nN_) * 256, (K_)}; pg8::GridOrder S; S.init((nM_), (nN_), G, oid); \
        pg8::gemm_phase<EpiT, pg8::GridOrder, true, true>(lds, g, S, (Eobj)); } while (0)
#define GEMM_MOE(Abuf, Wt, nNe_, K_, EpiT, Eobj) do { const int* pan = c.panel; const int np = pan[0]; \
        for (int i = tid; i < np; i += NTHR) ptab[i] = pan[1 + i]; __syncthreads(); \
        pg8::Gemm g{(const pg8::bf16_t*)(Abuf), (const pg8::bf16_t*)(Wt), np * 256, (nNe_) * 256, (K_)}; pg8::MoeOrder S; S.g.init(np, (nNe_), G, oid); S.pexp = ptab; S.nNe = (nNe_); \
        pg8::gemm_phase<EpiT, pg8::MoeOrder, true, true>(lds, g, S, (Eobj)); } while (0)
#define GEMM_MOE8(Abuf, Wt, nNe_, K_, EpiT, Eobj) do { const int* pan = c.panel; const int np = pan[0]; \
        for (int i = tid; i < np; i += NTHR) ptab[i] = pan[1 + i]; __syncthreads(); \
        pg8::Gemm g{(const pg8::bf16_t*)(Abuf), (const pg8::bf16_t*)(Wt), np * 256, (nNe_) * 256, (K_)}; pg8::MoeOrderC<(nNe_)> S; S.nM = np; S.c = oid; S.pexp = ptab; \
        pg8::gemm_phase<EpiT, pg8::MoeOrderC<(nNe_)>, true, true, true>(lds, g, S, (Eobj)); } while (0)
    constexpr int NMA = TTOT / 256, NML = TLAT / 256;

    if (IN(0)) {
        if (grp == 0) {
            { PH_IDS; adaln_phase(args, lds, vcu, G, tid);
              if (vcu == 0) rope_table(args, tid);
              { const float* w = args.in[I_CMWS]; bf16* o = (bf16*)(ws + WS_WSB); for (int i = gw * 64 + lane; i < 131072 / 4; i += ngw * 64) { const f32x4 v = ((const f32x4*)w)[i]; v2u p; p.x = pk2(v.x, v.y); p.y = pk2(v.z, v.w); ((v2u*)o)[i] = p; } }
              conv_dense(args, lds, gw, ngw, wave, lane);
            }
            xcd_barrier(bar);
            if (NGRP == 1) { PH_IDS; bias_phase(args, gw, ngw, lane); }
            else { { PH_IDS; bias_phase(args, gw, ngw, lane); } xcd_barrier(bar); }
            if (NGRP == 2 && vcu == 0 && threadIdx.x == 0) { __builtin_amdgcn_fence(__ATOMIC_RELEASE, "agent"); asm volatile("s_waitcnt vmcnt(0)" ::: "memory"); __hip_atomic_store(ctl + CW_FLAG_DENSE, 1u, RLX_AGENT); }
        } else {
            { PH_IDS; conv_moe(args, 0, lds, gw, ngw, wave, lane); conv_moe(args, 1, lds, gw, ngw, wave, lane); }
            xcd_barrier(bar);
            if (vcu == 0 && threadIdx.x == 0) { __builtin_amdgcn_fence(__ATOMIC_RELEASE, "agent"); asm volatile("s_waitcnt vmcnt(0)" ::: "memory"); __hip_atomic_store(ctl + CW_FLAG_MOE, 1u, RLX_AGENT); }
            wait_flag(ctl + CW_FLAG_DENSE);
        }
    }
    if (IN(1)) { PH_IDS; row_phase<false, true, false, true, false>(args, c, lds, c.x, c.ctx, nullptr, nullptr, TTOT, args.in[I_NMIX] + 0 * 1024, MOD + 0 * 9 * 6144, 0, nullptr, nullptr, nullptr, vcu, G, tid, wave, lane); }
    SEAM(1);
    if (IN(2)) { PH_IDS; { pg8::EpiConvIn E{(pg8::bf16_t*)HBUF}; GEMM_GRID(ABUF, ws + W_SCIN, NMA, 12, 1024, pg8::EpiConvIn, E); } }
    SEAM(2);
    if (IN(3)) { PH_IDS; conv_phase(args, c, vcu, G, wave, lane); }
    SEAM(3);
    if (IN(4)) { PH_IDS; { pg8::EpiResid<true, true, D0_IN8, false> E{c.x, c.ctx, (pg8::bf16_t*)HL, (pg8::bf16_t*)HCX, MOD + 0 * 9 * 6144 + 2048, (pg8::bf16_t*)ABUF, args.in[I_NFFN] + 0 * 1024, MOD + 0 * 9 * 6144 + 4096, c.ssq, b0}; GEMM_GRID(SBUF, ws + W_SCOUT, NMA, 4, 1024, PG8_ER4(true, true, D0_IN8, false), E); } }
    if (IN(4)) { if (NGRP == 1 && bx >= 32) { PH_IDS; conv_moe(args, 0, lds, (bx - 32) * NWAVES + wave, 224 * NWAVES, wave, lane, 0, CM0_A); } }
    SEAM(4);
#define PG8_SG(n, a) pg8::EpiSwiGLU<n, a>
#define PG8_SG8(n, g) pg8::EpiSwiGLU8<n, g>
    if (IN(6)) { PH_IDS;
        if (D0_IN8 && D0_H8) { pg8::EpiSwiGLU8<true> E{(unsigned char*)HBUF, c.ssq, (const float*)(ws + BIAS_P6), b0}; GEMM_GRID8(ABUF, ws + W_F13, NMA, 22, 512, pg8::EpiSwiGLU8<true>, E); }
        else if (D0_IN8) { pg8::EpiSwiGLU<true, true> E{(pg8::bf16_t*)HBUF, FF, c.ssq, (const float*)(ws + BIAS_P6), b0}; GEMM_GRID8(ABUF, ws + W_F13, NMA, 22, 512, PG8_SG(true, true), E); }
        else if (D0_H8) { pg8::EpiSwiGLU8<true, false> E{(unsigned char*)HBUF, c.ssq, (const float*)(ws + BIAS_P6), b0}; GEMM_GRID(ABUF, ws + W_F13, NMA, 22, 1024, PG8_SG8(true, false), E); }
        else { pg8::EpiSwiGLU<true> E{(pg8::bf16_t*)HBUF, FF, c.ssq, (const float*)(ws + BIAS_P6), b0}; GEMM_GRID(ABUF, ws + W_F13, NMA, 22, 1024, pg8::EpiSwiGLU<true>, E); } }
    SEAM(6);
    if (IN(7)) { PH_IDS; if (D0_H8) { pg8::EpiResid<true, false, false, true> E{HL, HCX, (pg8::bf16_t*)HL, (pg8::bf16_t*)HCX, MOD + 0 * 9 * 6144 + 5120, (pg8::bf16_t*)ABUF, args.in[I_NMIX] + 1 * 1024, MOD + 1 * 9 * 6144 + 1024, c.ssq, b0}; GEMM_GRID8(HBUF, ws + W_F2, NMA, 4, FF / 2, PG8_ER4(true, false, false, true), E); }
                        else { pg8::EpiResid<true, false> E{HL, HCX, (pg8::bf16_t*)HL, (pg8::bf16_t*)HCX, MOD + 0 * 9 * 6144 + 5120, (pg8::bf16_t*)ABUF, args.in[I_NMIX] + 1 * 1024, MOD + 1 * 9 * 6144 + 1024, c.ssq, b0}; GEMM_GRID(HBUF, ws + W_F2, NMA, 4, FF, PG8_ER(true, false), E); }
               }
    if (IN(7)) { if (NGRP == 1 && bx >= 32) { PH_IDS; conv_moe(args, 0, lds, (bx - 32) * NWAVES + wave, 224 * NWAVES, wave, lane, CM0_A, CM0_B); } }
    SEAM(7);
    if (IN(9)) { PH_IDS; { pg8::EpiQKV E{(pg8::bf16_t*)HBUF, 3072, c.ssq, (const float*)(ws + BIAS_P9), 3072, 4, 4, args.in[I_DAQG], args.in[I_DAKG], (const float*)(ws + WS_RT), QSCALE, b0}; GEMM_GRID(ABUF, ws + W_DAQKV, NMA, 12, 1024, pg8::EpiQKV, E); } }
    SEAM(9);
    if (IN(11)) { PH_IDS; diff_attn_phase(args, c, lds, vcu, G, tid, wave, lane); }
    SEAM(11);
    if (IN(12)) { PH_IDS; { pg8::EpiResid<false, false> E{HL, HCX, (pg8::bf16_t*)HL, (pg8::bf16_t*)HCX, MOD + 1 * 9 * 6144 + 2048, nullptr, nullptr, nullptr, nullptr, b0}; GEMM_GRID(SBUF, ws + W_DAOUT, NMA, 4, 1024, PG8_ER(false, false), E); } }
    if (IN(12)) { if (NGRP == 1 && bx >= 32) { PH_IDS; conv_moe(args, 0, lds, (bx - 32) * NWAVES + wave, 224 * NWAVES, wave, lane, CM0_B, NE * 3 * 1408); } }
    SEAM(12);
    if (IN(13)) { PH_IDS; row_phase<false, true, true, false, false, true>(args, c, lds, HL, HCX, nullptr, nullptr, TTOT, args.in[I_NFFN] + 1 * 1024, MOD + 1 * 9 * 6144, 3072, nullptr, args.in[I_RW] + 0 * 8192, args.in[I_RB] + 0 * 8, vcu, G, tid, wave, lane); }
    SEAM(13);
    if (IN(14)) { PH_IDS; moe_scatter_phase<true>(c, lds, TTOT, vcu, G, tid, wave, lane); }
    if (NGRP == 2 && IN(14) && grp == 0) wait_flag(ctl + CW_FLAG_MOE);
    SEAM(14);
    if (IN(15)) { PH_IDS; { pg8::EpiSwiGLU8<false> E{(unsigned char*)HBUF, nullptr, nullptr, 0}; GEMM_MOE8(SBUF, ws + W_MOE, 22, 512, pg8::EpiSwiGLU8<false>, E); } }
    SEAM(15);
    if (IN(16)) { PH_IDS; { pg8::EpiMoeDown<true> E{(pg8::bf16_t*)SBUF, c.sgate}; GEMM_MOE8(HBUF, ws + W_MOE + 88 * MiB, 4, FF / 2, pg8::EpiMoeDown<true>, E); } }
    SEAM(16);
    if (IN(17)) { PH_IDS; row_phase<true, true, false, false, false>(args, c, lds, HL, HCX, HL, HCX, TTOT, args.in[I_NMIX] + 2 * 1024, MOD + 2 * 9 * 6144, 0, MOD + 1 * 9 * 6144 + 5120, nullptr, nullptr, vcu, G, tid, wave, lane); }
    SEAM(17);
    if (IN(18)) { PH_IDS; { pg8::EpiStore<1> E{(pg8::bf16_t*)HBUF, 4096, args.in[I_CMINB], c.ssq, 8}; GEMM_GRID(ABUF, ws + W_CMIN, NMA, 16, 1024, pg8::EpiStore<1>, E); } }
    SEAM(18);
    if (IN(19)) { PH_IDS; gate_phase(args, c, lds, vcu, G, tid, wave, lane); }
    SEAM(19);
    if (IN(20)) { PH_IDS; { pg8::EpiResid<true, false, true, false> E{HL, HCX, (pg8::bf16_t*)HL, (pg8::bf16_t*)HCX, MOD + 2 * 9 * 6144 + 2048, (pg8::bf16_t*)ABUF, args.in[I_NFFN] + 2 * 1024, MOD + 2 * 9 * 6144 + 4096, c.ssq, b0}; GEMM_GRID(SBUF, ws + W_CMOUT, NMA, 4, 2048, PG8_ER4(true, false, true, false), E); } }
    if (IN(20)) { if (NGRP == 1 && bx >= 32) { PH_IDS; conv_moe(args, 1, lds, (bx - 32) * NWAVES + wave, 224 * NWAVES, wave, lane, 0, CM1_A); } }
    SEAM(20);
    if (IN(22)) { PH_IDS; { pg8::EpiSwiGLU8<true> E{(unsigned char*)HBUF, c.ssq, (const float*)(ws + BIAS_P22), b0}; GEMM_GRID8(ABUF, ws + W_F13 + (size_t)5632 * 1024 * 2, NMA, 22, 512, pg8::EpiSwiGLU8<true>, E); } }
    SEAM(22);
    if (IN(23)) { PH_IDS; { pg8::EpiResid<true, false, false, true> E{HL, HCX, (pg8::bf16_t*)HL, (pg8::bf16_t*)HCX, MOD + 2 * 9 * 6144 + 5120, (pg8::bf16_t*)ABUF, args.in[I_NMIX] + 3 * 1024, MOD + 3 * 9 * 6144 + 1024, c.ssq, b0}; GEMM_GRID8(HBUF, ws + W_F2 + (size_t)1024 * 2816 * 2, NMA, 4, FF / 2, PG8_ER4(true, false, false, true), E); }
               }
    if (IN(23)) { if (NGRP == 1 && bx >= 32) { PH_IDS; conv_moe(args, 1, lds, (bx - 32) * NWAVES + wave, 224 * NWAVES, wave, lane, CM1_A, NE * 3 * 1408); } }
    SEAM(23);
    if (IN(25)) { PH_IDS; { pg8::EpiQKV E{(pg8::bf16_t*)HBUF, 1536, c.ssq, (const float*)(ws + BIAS_P25), 1536, 4, 1, args.in[I_SWQG], args.in[I_SWKG], (const float*)(ws + WS_RT), QSCALE, b0}; GEMM_GRID(ABUF, ws + W_SWQKV, NMA, 6, 1024, pg8::EpiQKV, E); } }
    SEAM(25);
    if (IN(27)) { PH_IDS; swa_attn_phase(args, c, lds, vcu, G, tid, wave, lane); }
    SEAM(27);
    if (IN(28)) { PH_IDS; { pg8::EpiResid<false, false> E{HL, HCX, (pg8::bf16_t*)HL, (pg8::bf16_t*)HCX, MOD + 3 * 9 * 6144 + 2048, nullptr, nullptr, nullptr, nullptr, b0}; GEMM_GRID(SBUF, ws + W_SWOUT, NML, 4, 1024, PG8_ER(false, false), E); } }
    SEAM(28);
    if (IN(29)) { PH_IDS; row_phase<false, true, true, false, false, true>(args, c, lds, HL, HCX, nullptr, nullptr, TLAT, args.in[I_NFFN] + 3 * 1024, MOD + 3 * 9 * 6144, 3072, nullptr, args.in[I_RW] + 1 * 8192, args.in[I_RB] + 1 * 8, vcu, G, tid, wave, lane); }
    SEAM(29);
    if (IN(30)) { PH_IDS; moe_scatter_phase<true>(c, lds, TLAT, vcu, G, tid, wave, lane); }
    SEAM(30);
    if (IN(31)) { PH_IDS; { pg8::EpiSwiGLU8<false> E{(unsigned char*)HBUF, nullptr, nullptr, 0}; GEMM_MOE8(SBUF, ws + W_MOE + W_MOE_STRIDE, 22, 512, pg8::EpiSwiGLU8<false>, E); } }
    SEAM(31);
    if (IN(32)) { PH_IDS; { pg8::EpiMoeDown<true> E{(pg8::bf16_t*)SBUF, c.sgate}; GEMM_MOE8(HBUF, ws + W_MOE + W_MOE_STRIDE + 88 * MiB, 4, FF / 2, pg8::EpiMoeDown<true>, E); } }
    SEAM(32);
    if (IN(33)) { PH_IDS; row_phase<true, false, false, false, true>(args, c, lds, HL, HCX, c.out, nullptr, TLAT, nullptr, nullptr, 0, MOD + 3 * 9 * 6144 + 5120, nullptr, nullptr, vcu, G, tid, wave, lane); }
#undef IN
#undef SEAM
}

extern "C" void kernel_launch(void* const* d_in, const int* in_sizes, int n_in, void* d_out, int out_size, void* d_ws, size_t ws_size, hipStream_t stream) {
    static int grid = 0;
    if (grid == 0) {
        if (n_in != N_IN || in_sizes[0] != NGRP * TLAT * D || out_size != NGRP * TLAT * D || ws_size < WS_END) { fprintf(stderr, "kernel_launch: unexpected shapes / workspace (n_in %d, ws %zu < %zu)\n", n_in, ws_size, (size_t)WS_END); grid = -1; return; }
        int dev = 0, cus = 0;
        if (hipGetDevice(&dev) != hipSuccess || hipDeviceGetAttribute(&cus, hipDeviceAttributeMultiprocessorCount, dev) != hipSuccess) { grid = -1; return; }
        if (hipFuncSetAttribute((const void*)mk_fwd, hipFuncAttributeMaxDynamicSharedMemorySize, LDS_BYTES) != hipSuccess) { fprintf(stderr, "kernel_launch: hipFuncSetAttribute failed\n"); grid = -1; return; }
        int per_cu = 0;
        if (hipOccupancyMaxActiveBlocksPerMultiprocessor(&per_cu, (const void*)mk_fwd, NTHR, LDS_BYTES) != hipSuccess || per_cu < 1) fprintf(stderr, "kernel_launch: occupancy query reports %d\n", per_cu);
        (void)hipGetLastError();
        grid = cus;
        if (grid != NGRP * GG) { fprintf(stderr, "kernel_launch: built for 256 CUs, found %d\n", cus); grid = -1; return; }
    }
    if (grid < 0) return;
    (void)hipMemsetAsync((char*)d_ws + WS_CTL, 0, CTL_ZERO_BYTES, stream);
    Args a{};
    for (int i = 0; i < N_IN; ++i) a.in[i] = (const float*)d_in[i];
    a.out = (float*)d_out; a.ws = (unsigned char*)d_ws;
    a.ph_lo = 0; a.ph_hi = N_PHASES; hipLaunchKernelGGL(mk_fwd, dim3(grid), dim3(NTHR), LDS_BYTES, stream, a);
}
```
